# Optimizing an MI355X kernel written in HIP

```python
import jax, jax.numpy as jnp
from jax import lax
import numpy as np


D_MODEL = 1024
BATCH = 8
SEQ = 2048
DEPTH = 2

N_META = 16
Q_BLOCK = 128
SB_HEADS = 4
SB_HEAD_DIM = 64
SB_WIDTH = SB_HEADS * SB_HEAD_DIM
MLA_HEADS = 8
MLA_NOPE_DIM = 64
MLA_ROPE_DIM = 32
MLA_V_DIM = 64
MLA_Q_RANK = 256
MLA_KV_RANK = 128
MLA_WIDTH = MLA_HEADS * MLA_V_DIM
ROPE_THETA = 10000.0
CONV_CH = 256
CONV_K = 31
MIX_WIDTH = SB_WIDTH + MLA_WIDTH + CONV_CH
IN_SIZES = (SB_WIDTH, SB_WIDTH, SB_WIDTH, MLA_Q_RANK, MLA_KV_RANK, MLA_ROPE_DIM, CONV_CH, CONV_CH)
N_IN = sum(IN_SIZES)
N_EXPERTS = 32
TOP_K = 4
D_FF = D_MODEL
SWIGLU_LIMIT = 7.0
SWIGLU_ALPHA = 1.702
EXPERT_BLOCK = 128
DEEPNORM_ALPHA = (2 * DEPTH) ** 0.25
DEEPNORM_BETA = (8 * DEPTH) ** -0.25
LN_EPS = 1e-5
RMS_EPS = 1e-6

kernel_name = "hymba_style_sb_mla_conformer_moe_deepnorm"


def layer_norm(x, g, b):
    xf = x.astype(jnp.float32)
    mu = jnp.mean(xf, axis=-1, keepdims=True)
    var = jnp.mean(jnp.square(xf - mu), axis=-1, keepdims=True)
    y = (xf - mu) * lax.rsqrt(var + LN_EPS) * g.astype(jnp.float32) + b.astype(jnp.float32)
    return y.astype(x.dtype)


def rms_norm(x, g):
    xf = x.astype(jnp.float32)
    y = xf * lax.rsqrt(jnp.mean(jnp.square(xf), axis=-1, keepdims=True) + RMS_EPS) * g.astype(jnp.float32)
    return y.astype(x.dtype)


def rope_tables(length, dtype):
    inv = 1.0 / (ROPE_THETA ** (jnp.arange(0, MLA_ROPE_DIM, 2, dtype=jnp.float32) / MLA_ROPE_DIM))
    ang = jnp.arange(length, dtype=jnp.float32)[:, None] * inv[None, :]
    return jnp.cos(ang).astype(dtype), jnp.sin(ang).astype(dtype)


def rotary(x, cos, sin):
    x1, x2 = jnp.split(x, 2, axis=-1)
    c = cos[None, :, None, :]
    s = sin[None, :, None, :]
    return jnp.concatenate([x1 * c - x2 * s, x1 * s + x2 * c], axis=-1)


def sweep_query_blocks(attend, q):
    b, nh, total, dq = q.shape
    s = total - N_META
    nb = s // Q_BLOCK
    out_meta = attend(q[:, :, :N_META], jnp.arange(N_META))
    q_blocks = q[:, :, N_META:].reshape(b, nh, nb, Q_BLOCK, dq).transpose(2, 0, 1, 3, 4)
    pos_blocks = (N_META + jnp.arange(s)).reshape(nb, Q_BLOCK)
    out_blocks = lax.map(lambda qp: attend(qp[0], qp[1]), (q_blocks, pos_blocks))
    dv = out_blocks.shape[-1]
    out_real = out_blocks.transpose(1, 2, 0, 3, 4).reshape(b, nh, s, dv)
    return jnp.concatenate([out_meta, out_real], axis=2)


def stick_breaking_attend(q, k, v, q_pos):
    k_pos = jnp.arange(k.shape[2])
    z = jnp.einsum('bhqd,bhkd->bhqk', q, k).astype(jnp.float32) * (SB_HEAD_DIM ** -0.5)
    mask = k_pos[None, :] < q_pos[:, None]
    log_stay = jnp.where(mask, jax.nn.log_sigmoid(-z), 0.0)
    log_stay_after = lax.cumsum(log_stay, axis=3, reverse=True) - log_stay
    w = jnp.where(mask, jnp.exp(jax.nn.log_sigmoid(z) + log_stay_after), 0.0)
    return jnp.einsum('bhqk,bhkd->bhqd', w.astype(v.dtype), v)


def causal_softmax_attend(q, k, v, q_pos):
    k_pos = jnp.arange(k.shape[2])
    s = jnp.einsum('bhqd,bhkd->bhqk', q, k).astype(jnp.float32) * ((MLA_NOPE_DIM + MLA_ROPE_DIM) ** -0.5)
    s = jnp.where(k_pos[None, :] <= q_pos[:, None], s, -jnp.inf)
    p = jax.nn.softmax(s, axis=-1)
    return jnp.einsum('bhqk,bhkd->bhqd', p.astype(v.dtype), v)


def causal_depthwise_conv(u, w, b):
    out = lax.conv_general_dilated(u, w[:, None, :].astype(u.dtype), window_strides=(1,),
                                   padding=[(CONV_K - 1, 0)],
                                   dimension_numbers=('NWC', 'WIO', 'NWC'),
                                   feature_group_count=u.shape[-1])
    return out + b.astype(u.dtype)


def hybrid_mixer(h, w_in, q_norm_g, w_uq, kv_norm_g, w_ukv, conv_w, conv_b, conv_ln_g, conv_ln_b,
                 grp_norm_g, w_out, cos, sin):
    B, L, _ = h.shape
    proj = h @ w_in
    sb_q, sb_k, sb_v, c_q, c_kv, k_pe, conv_a, conv_g = jnp.split(
        proj, np.cumsum(IN_SIZES)[:-1].tolist(), axis=-1)

    def heads(t, n):
        return t.reshape(B, L, n, -1).transpose(0, 2, 1, 3)

    q, k, v = heads(sb_q, SB_HEADS), heads(sb_k, SB_HEADS), heads(sb_v, SB_HEADS)
    sb_out = sweep_query_blocks(lambda qb, pos: stick_breaking_attend(qb, k, v, pos), q)
    sb_out = sb_out.transpose(0, 2, 1, 3).reshape(B, L, SB_WIDTH)

    qm = (rms_norm(c_q, q_norm_g) @ w_uq).reshape(B, L, MLA_HEADS, MLA_NOPE_DIM + MLA_ROPE_DIM)
    qm = jnp.concatenate([qm[..., :MLA_NOPE_DIM], rotary(qm[..., MLA_NOPE_DIM:], cos, sin)], axis=-1)
    kvm = (rms_norm(c_kv, kv_norm_g) @ w_ukv).reshape(B, L, MLA_HEADS, MLA_NOPE_DIM + MLA_V_DIM)
    k_nope, vm = kvm[..., :MLA_NOPE_DIM], kvm[..., MLA_NOPE_DIM:]
    k_rot = rotary(k_pe[:, :, None, :], cos, sin)
    km = jnp.concatenate([k_nope, jnp.broadcast_to(k_rot, (B, L, MLA_HEADS, MLA_ROPE_DIM))], axis=-1)
    qm, km, vm = qm.transpose(0, 2, 1, 3), km.transpose(0, 2, 1, 3), vm.transpose(0, 2, 1, 3)
    mla_out = sweep_query_blocks(lambda qb, pos: causal_softmax_attend(qb, km, vm, pos), qm)
    mla_out = mla_out.transpose(0, 2, 1, 3).reshape(B, L, MLA_WIDTH)

    u = conv_a * jax.nn.sigmoid(conv_g)
    c = causal_depthwise_conv(u, conv_w, conv_b)
    c = jax.nn.silu(layer_norm(c, conv_ln_g, conv_ln_b))

    g_sb, g_mla, g_conv = jnp.split(grp_norm_g, [SB_WIDTH, SB_WIDTH + MLA_WIDTH])
    y = jnp.concatenate([rms_norm(sb_out, g_sb), rms_norm(mla_out, g_mla), rms_norm(c, g_conv)], axis=-1)
    return y @ w_out


def moe_ffn(h, router_w, router_b, w_gate_up, b_gate_up, w_down, b_down):
    B, L, D = h.shape
    xt = h.reshape(-1, D)
    T = xt.shape[0]
    logits = (xt @ router_w + router_b).astype(jnp.float32)
    top_val, top_idx = lax.top_k(logits, TOP_K)
    gate = jax.nn.softmax(top_val, axis=-1)
    n_assign = T * TOP_K
    flat_e = top_idx.reshape(-1)
    flat_tok = jnp.arange(n_assign) // TOP_K
    flat_g = gate.reshape(-1)
    order = jnp.argsort(flat_e)
    e_sorted = flat_e[order]
    counts = jnp.bincount(flat_e, length=N_EXPERTS)
    padded = (counts + EXPERT_BLOCK - 1) // EXPERT_BLOCK * EXPERT_BLOCK
    start = jnp.cumsum(counts) - counts
    pend = jnp.cumsum(padded)
    pstart = pend - padded
    dest = pstart[e_sorted] + (jnp.arange(n_assign) - start[e_sorted])
    n_rows = -(-n_assign // EXPERT_BLOCK) * EXPERT_BLOCK + N_EXPERTS * EXPERT_BLOCK
    n_blk = n_rows // EXPERT_BLOCK
    row_tok = jnp.zeros((n_rows,), jnp.int32).at[dest].set(flat_tok[order])
    row_g = jnp.zeros((n_rows,), jnp.float32).at[dest].set(flat_g[order])
    blk_e = jnp.minimum(jnp.searchsorted(pend, jnp.arange(n_blk) * EXPERT_BLOCK, side='right'), N_EXPERTS - 1)
    xs = xt[row_tok].reshape(n_blk, EXPERT_BLOCK, D)

    def expert_block(args):
        xb, e = args
        gu = xb @ w_gate_up[e] + b_gate_up[e]
        g, up = gu[:, :D_FF], gu[:, D_FF:]
        g = jnp.minimum(g, SWIGLU_LIMIT)
        up = jnp.clip(up, -SWIGLU_LIMIT, SWIGLU_LIMIT)
        act = (up + 1.0) * (g * jax.nn.sigmoid(SWIGLU_ALPHA * g))
        return act @ w_down[e] + b_down[e]

    ys = lax.map(expert_block, (xs, blk_e)).reshape(n_rows, D)
    out = jnp.zeros_like(xt).at[row_tok].add(ys * row_g[:, None].astype(ys.dtype))
    return out.reshape(B, L, D)


def setup_inputs(seed: int = 0) -> dict:
    key = jax.random.key(seed)
    ks = jax.random.split(key, 25)
    f32 = jnp.float32

    def nrm(k, shape, scale):
        return jax.random.normal(k, shape, f32) * scale

    def gain(k, shape):
        return 1.0 + 0.05 * jax.random.normal(k, shape, f32)

    def bias(k, shape, scale=0.02):
        return scale * jax.random.normal(k, shape, f32)

    return {
        "x": nrm(ks[0], (BATCH, SEQ, D_MODEL), 1.0),
        "meta_tokens": nrm(ks[1], (N_META, D_MODEL), 1.0),
        "ln_in_g": gain(ks[2], (D_MODEL,)),
        "ln_in_b": bias(ks[3], (D_MODEL,)),
        "w_in": nrm(ks[4], (DEPTH, D_MODEL, N_IN), D_MODEL ** -0.5),
        "q_norm_g": gain(ks[5], (DEPTH, MLA_Q_RANK)),
        "w_uq": nrm(ks[6], (DEPTH, MLA_Q_RANK, MLA_HEADS * (MLA_NOPE_DIM + MLA_ROPE_DIM)), MLA_Q_RANK ** -0.5),
        "kv_norm_g": gain(ks[7], (DEPTH, MLA_KV_RANK)),
        "w_ukv": nrm(ks[8], (DEPTH, MLA_KV_RANK, MLA_HEADS * (MLA_NOPE_DIM + MLA_V_DIM)), MLA_KV_RANK ** -0.5),
        "conv_w": nrm(ks[9], (DEPTH, CONV_K, CONV_CH), CONV_K ** -0.5),
        "conv_b": bias(ks[10], (DEPTH, CONV_CH)),
        "conv_ln_g": gain(ks[11], (DEPTH, CONV_CH)),
        "conv_ln_b": bias(ks[12], (DEPTH, CONV_CH)),
        "grp_norm_g": gain(ks[13], (DEPTH, MIX_WIDTH)),
        "w_out": nrm(ks[14], (DEPTH, MIX_WIDTH, D_MODEL), MIX_WIDTH ** -0.5 * DEEPNORM_BETA),
        "ln_mix_g": gain(ks[15], (DEPTH, D_MODEL)),
        "ln_mix_b": bias(ks[16], (DEPTH, D_MODEL)),
        "router_w": nrm(ks[17], (DEPTH, D_MODEL, N_EXPERTS), D_MODEL ** -0.5),
        "router_b": bias(ks[18], (DEPTH, N_EXPERTS), 0.01),
        "w_gate_up": nrm(ks[19], (DEPTH, N_EXPERTS, D_MODEL, 2 * D_FF), D_MODEL ** -0.5),
        "b_gate_up": bias(ks[20], (DEPTH, N_EXPERTS, 2 * D_FF)),
        "w_down": nrm(ks[21], (DEPTH, N_EXPERTS, D_FF, D_MODEL), D_FF ** -0.5 * DEEPNORM_BETA),
        "b_down": bias(ks[22], (DEPTH, N_EXPERTS, D_MODEL)),
        "ln_ffn_g": gain(ks[23], (DEPTH, D_MODEL)),
        "ln_ffn_b": bias(ks[24], (DEPTH, D_MODEL)),
    }


def reference(x, meta_tokens, ln_in_g, ln_in_b, w_in, q_norm_g, w_uq, kv_norm_g, w_ukv, conv_w, conv_b,
              conv_ln_g, conv_ln_b, grp_norm_g, w_out, ln_mix_g, ln_mix_b, router_w, router_b,
              w_gate_up, b_gate_up, w_down, b_down, ln_ffn_g, ln_ffn_b):
    B = x.shape[0]
    meta = jnp.broadcast_to(meta_tokens[None].astype(x.dtype), (B, N_META, D_MODEL))
    h = layer_norm(jnp.concatenate([meta, x], axis=1), ln_in_g, ln_in_b)
    cos, sin = rope_tables(h.shape[1], h.dtype)
    for l in range(DEPTH):
        mix = hybrid_mixer(h, w_in[l], q_norm_g[l], w_uq[l], kv_norm_g[l], w_ukv[l], conv_w[l], conv_b[l],
                           conv_ln_g[l], conv_ln_b[l], grp_norm_g[l], w_out[l], cos, sin)
        h = layer_norm(DEEPNORM_ALPHA * h + mix, ln_mix_g[l], ln_mix_b[l])
        ffn = moe_ffn(h, router_w[l], router_b[l], w_gate_up[l], b_gate_up[l], w_down[l], b_down[l])
        h = layer_norm(DEEPNORM_ALPHA * h + ffn, ln_ffn_g[l], ln_ffn_b[l])
    return h[:, N_META:, :]
```

```cpp
#include <hip/hip_runtime.h>
#include <cstdio>
#include <cstdint>
#include <cmath>
#define MK_DEBUG 0
#define MK_TOL 1e-3f
#define MK_REP 0
namespace pg8 {
#define PG8_LAS __attribute__((address_space(3)))
typedef unsigned short bf16_t;
typedef short bf16x8 __attribute__((ext_vector_type(8)));
typedef float f32x4 __attribute__((ext_vector_type(4)));
typedef float f32x2 __attribute__((ext_vector_type(2)));
typedef unsigned u32x4 __attribute__((ext_vector_type(4)));
typedef unsigned u32x2 __attribute__((ext_vector_type(2)));
constexpr int BM = 256, BK = 64, HALF = 128, HTB = HALF * BK * 2  , STAGE_BYTES = 8 * HTB, NXCD = 8, WGM = 8;

__host__ __device__ __forceinline__ int lds_byte(int r, int c) { const int st = (r >> 4) * 2 + (c >> 5), rr = r & 15, cc = c & 31, ob = rr * 64 + cc * 2; return st * 1024 + (ob ^ (((ob >> 9) & 1) << 5)); }
__host__ __device__ __forceinline__ void stage_rc(int b, int& R, int& C) { const int st = b / 1024, sb = b % 1024, swz = sb ^ (((sb >> 9) & 1) << 5); R = (st >> 1) * 16 + swz / 64; C = (st & 1) * 32 + (swz % 64) / 2; }
__host__ __device__ __forceinline__ int perm32(int rho) { const int n = rho >> 4, i = rho & 15; return 8 * (i >> 2) + 4 * n + (i & 3); }

struct Unit { int pm, pn, pb, ko, kind; };
struct Gemm { const bf16_t* A; const bf16_t* Bt; int M, N, K; int ld = 0; const bf16_t* A2 = nullptr; const bf16_t* Bt2 = nullptr; };

struct StaticOrder {
    int nM, nN, nwg, G, c;
    __host__ __device__ void init(int M, int N, int G_, int c_) { nM = M / BM; nN = N / BM; nwg = nM * nN; G = G_; c = c_; }
    __host__ __device__ bool next(int i, Unit& u) const {
        const long L = (long)i * G + c; if (L >= nwg) return false;
        int wgid = (int)L; { const int q = nwg / NXCD, r = nwg % NXCD, xcd = wgid % NXCD, off = wgid / NXCD; wgid = (xcd < r ? xcd * (q + 1) : r * (q + 1) + (xcd - r) * q) + off; }
        const int nig = WGM * nN, gid = wgid / nig, fm = gid * WGM, gsz = (nM - fm) < WGM ? (nM - fm) : WGM;
        u.pm = fm + ((wgid % nig) % gsz); u.pn = (wgid % nig) / gsz; u.pb = u.pn; u.ko = 0; u.kind = 0; return true;
    }
    __device__ __forceinline__ const PG8_LAS int* rowlist(int) const { return nullptr; }
    __device__ __forceinline__ void a_ready(const Unit&) const {}
};

struct ListOrder {
    const PG8_LAS int* tab; const PG8_LAS int* rows; int n;
    unsigned* rdy = nullptr; unsigned need = 0;
    __device__ __forceinline__ bool next(int i, Unit& u) const { if (i >= n) return false;
        u.pm = __builtin_amdgcn_readfirstlane(tab[4 * i]); u.pn = __builtin_amdgcn_readfirstlane(tab[4 * i + 1]); u.pb = __builtin_amdgcn_readfirstlane(tab[4 * i + 2]); u.kind = __builtin_amdgcn_readfirstlane(tab[4 * i + 3]); u.ko = 0; return true; }
    __device__ __forceinline__ const PG8_LAS int* rowlist(int ui) const { return rows + ui * 256; }
    __device__ __forceinline__ void a_ready(const Unit& u) const {
        if (u.kind != 1 || rdy == nullptr) return;
        if (threadIdx.x < 64) {
            unsigned sp = 0;
            while ((unsigned)__builtin_amdgcn_readfirstlane(__hip_atomic_load(rdy + 16 * u.pm, __ATOMIC_RELAXED, __HIP_MEMORY_SCOPE_AGENT)) < need) { __builtin_amdgcn_s_sleep(2); if (++sp > (1u << 20)) break; }
            __builtin_amdgcn_fence(__ATOMIC_ACQUIRE, "agent");
            asm volatile("s_waitcnt vmcnt(0)" ::: "memory");
        }
        asm volatile("" ::: "memory"); __builtin_amdgcn_s_barrier(); asm volatile("" ::: "memory");
    }
};
template <class Sched> __device__ __forceinline__ ListOrder make_list(const Sched& S, PG8_LAS int* tab, const PG8_LAS int* rows) {
    if (threadIdx.x == 0) { Unit u; int n = 0; while (n < 24 && S.next(n, u)) { tab[4 * n] = u.pm; tab[4 * n + 1] = u.pn; tab[4 * n + 2] = u.pb; tab[4 * n + 3] = u.kind; ++n; } tab[127] = n; }
    __syncthreads();
    ListOrder Lo; Lo.tab = tab; Lo.rows = rows; Lo.n = __builtin_amdgcn_readfirstlane(tab[127]); return Lo;
}
__device__ __forceinline__ unsigned cvt_pk_bf16(float lo, float hi) { unsigned r; asm volatile("v_cvt_pk_bf16_f32 %0, %1, %2" : "=v"(r) : "v"(lo), "v"(hi)); return r; }

template <class Epi, class Sched, bool ALIGN_EPI, bool GATHER>
__device__ __forceinline__ void gemm_phase(PG8_LAS unsigned char* lds, const Gemm g, const Sched& S, const Epi& E) {
    int tid = threadIdx.x; asm volatile("" : "+v"(tid));
    const int wid = __builtin_amdgcn_readfirstlane(tid >> 6), wr = wid >> 2, wc = wid & 3;
    int K = g.K; asm volatile("" : "+s"(K));
    const int nt = K / BK;
    int LD = g.ld ? g.ld : g.K; asm volatile("" : "+s"(LD));
    unsigned voffA[2], voffB[2];
#pragma unroll
    for (int i = 0; i < 2; ++i) { int R, C; stage_rc(tid * 16 + i * 8192, R, C); const int Rb = Epi::PERM ? ((R & ~31) + perm32(R & 31)) : R;
        voffA[i] = (unsigned)(R * LD + C) * 2u; voffB[i] = (unsigned)(Rb * LD + C) * 2u; }
    unsigned voffG[2][2] = {{0u, 0u}, {0u, 0u}};
#define PG8_LOADG(ui_, u_) do { const PG8_LAS int* rl_ = S.rowlist(ui_); _Pragma("unroll") for (int i_ = 0; i_ < 2; ++i_) { int R_, C_; stage_rc(tid * 16 + i_ * 8192, R_, C_);     \
        _Pragma("unroll") for (int h_ = 0; h_ < 2; ++h_) voffG[h_][i_] = (unsigned)((u_).kind ? (u_).pm * BM + h_ * HALF + R_ : rl_[h_ * HALF + R_]) * (unsigned)(LD * 2) + (unsigned)C_ * 2u; } } while (0)
    const size_t kstep = (size_t)(BK * 2);
    const size_t hstep = (size_t)HALF * LD * 2;
    const size_t tstep = 2 * hstep;
    const unsigned ldsw = (unsigned)wid * 1024u;
    const int aoff = lds_byte(wr * 64 + (tid & 15), ((tid & 63) >> 4) * 8), boff = lds_byte(wc * 32 + (tid & 15), ((tid & 63) >> 4) * 8);
#define PG8_SA(b, h) (((b) * 2 + (h)) * HTB)
#define PG8_SB(b, h) ((4 + (b) * 2 + (h)) * HTB)
#define PG8_STAGE(bufoff, gbase, voff) do { _Pragma("unroll") for (int _i = 0; _i < 2; ++_i) \
        __builtin_amdgcn_global_load_lds((const unsigned*)((const char*)(gbase) + (voff)[_i]), (PG8_LAS unsigned*)(lds + (bufoff) + ldsw + _i * 8192), 16, 0, 0); } while (0)
#define PG8_STAGE_A(bufoff, kptr, h) do { if constexpr (GATHER) { PG8_STAGE(bufoff, kptr, voffG[h]); } else { PG8_STAGE(bufoff, (kptr) + (h) * hstep, voffA); } } while (0)
#define PG8_LDA(dst, b, h) do { _Pragma("unroll") for (int m = 0; m < 4; ++m) _Pragma("unroll") for (int k = 0; k < 2; ++k) dst[m][k] = *(const PG8_LAS bf16x8*)(lds + PG8_SA(b, h) + aoff + m * 2048 + k * 1024); } while (0)
#define PG8_LDB(dst, b, h) do { _Pragma("unroll") for (int n = 0; n < 2; ++n) _Pragma("unroll") for (int k = 0; k < 2; ++k) dst[n][k] = *(const PG8_LAS bf16x8*)(lds + PG8_SB(b, h) + boff + n * 2048 + k * 1024); } while (0)
#define PG8_MMA(ai, bj, At, Bt) do { __builtin_amdgcn_s_setprio(1); _Pragma("unroll") for (int m = 0; m < 4; ++m) _Pragma("unroll") for (int n = 0; n < 2; ++n) _Pragma("unroll") for (int k = 0; k < 2; ++k) \
        acc[ai][bj][m][n] = __builtin_amdgcn_mfma_f32_16x16x32_bf16(Bt[n][k], At[m][k], acc[ai][bj][m][n], 0, 0, 0); __builtin_amdgcn_s_setprio(0); } while (0)
#define PG8_WAIT_V(n) asm volatile("s_waitcnt vmcnt(" #n ")" ::: "memory")
#define PG8_WAIT_L(n) asm volatile("s_waitcnt lgkmcnt(" #n ")" ::: "memory")
#define PG8_BAR __builtin_amdgcn_s_barrier()
#define PG8_SCHED __builtin_amdgcn_sched_barrier(0)
    Unit cur, nxt; int ui = 0;
    if (!S.next(0, cur)) return;
    f32x4 acc[2][2][4][2];
#pragma unroll
    for (int a = 0; a < 2; ++a)
#pragma unroll
        for (int b = 0; b < 2; ++b)
#pragma unroll
            for (int m = 0; m < 4; ++m)
#pragma unroll
                for (int n = 0; n < 2; ++n) acc[a][b][m][n] = (f32x4){0.f, 0.f, 0.f, 0.f};
    bf16x8 At[4][2], B0[2][2], B1[2][2];
#define PG8_BASEA(u_) ((const char*)((u_).kind ? g.A2 : g.A) + (GATHER ? (size_t)0 : (size_t)(u_).pm * tstep) + (size_t)(u_).ko * 2)
#define PG8_BASEB(u_) ((const char*)((u_).kind ? g.Bt2 : g.Bt) + (size_t)(u_).pb * tstep + (size_t)(u_).ko * 2)
    const char* cA = PG8_BASEA(cur); const char* cB = PG8_BASEB(cur);
    S.a_ready(cur);
    if constexpr (GATHER) { PG8_LOADG(0, cur); }
    PG8_STAGE(PG8_SB(0, 0), cB, voffB); PG8_STAGE(PG8_SB(0, 1), cB + hstep, voffB); PG8_STAGE_A(PG8_SA(0, 0), cA, 0); PG8_STAGE_A(PG8_SA(0, 1), cA, 1);
    if (wr == 1) PG8_BAR;
    PG8_WAIT_V(2); PG8_BAR;
    PG8_STAGE(PG8_SB(1, 0), cB + kstep, voffB); PG8_STAGE_A(PG8_SA(1, 0), cA + kstep, 0); PG8_STAGE(PG8_SB(1, 1), cB + hstep + kstep, voffB);
    PG8_WAIT_V(6); PG8_BAR;
    for (;;) {
        const bool has_next = S.next(ui + 1, nxt);
        const char* nA = has_next ? PG8_BASEA(nxt) : cA; const char* nB = has_next ? PG8_BASEB(nxt) : cB;
        for (int t = 0; t < nt; t += 2) {
            const bool last = (t == nt - 2);
            const char* a1 = cA + (size_t)(t + 1) * kstep;
            const char* a2 = last ? nA : cA + (size_t)(t + 2) * kstep; const char* b2 = last ? nB : cB + (size_t)(t + 2) * kstep;
            const char* a3 = a2 + kstep; const char* b3 = b2 + kstep;
            if (last && has_next) S.a_ready(nxt);
            PG8_LDB(B0, 0, 0); PG8_LDB(B1, 0, 1); PG8_SCHED; PG8_LDA(At, 0, 0); PG8_STAGE_A(PG8_SA(1, 1), a1, 1);
            if constexpr (GATHER) { if (last && has_next) { PG8_LOADG(ui + 1, nxt); } }
            PG8_WAIT_V(8); PG8_WAIT_L(0); PG8_BAR; PG8_MMA(0, 0, At, B0); PG8_MMA(0, 1, At, B1); PG8_BAR; PG8_SCHED;
            PG8_LDA(At, 0, 1); PG8_STAGE(PG8_SB(0, 0), b2, voffB); PG8_STAGE(PG8_SB(0, 1), b2 + hstep, voffB); PG8_STAGE_A(PG8_SA(0, 0), a2, 0);
            PG8_WAIT_V(8); PG8_WAIT_L(0); PG8_BAR; PG8_MMA(1, 0, At, B0); PG8_MMA(1, 1, At, B1); PG8_BAR; PG8_SCHED;
            PG8_LDB(B0, 1, 0); PG8_LDB(B1, 1, 1); PG8_SCHED; PG8_LDA(At, 1, 0); PG8_STAGE_A(PG8_SA(0, 1), a2, 1);
            PG8_WAIT_V(8); PG8_WAIT_L(0); PG8_BAR; PG8_MMA(0, 0, At, B0); PG8_MMA(0, 1, At, B1); PG8_BAR; PG8_SCHED;
            PG8_LDA(At, 1, 1); PG8_STAGE(PG8_SB(1, 0), b3, voffB); PG8_STAGE(PG8_SB(1, 1), b3 + hstep, voffB); PG8_STAGE_A(PG8_SA(1, 0), a3, 0);
            PG8_WAIT_V(8); PG8_WAIT_L(0); PG8_BAR; PG8_MMA(1, 0, At, B0); PG8_MMA(1, 1, At, B1); PG8_BAR; PG8_SCHED;
        }
        if constexpr (ALIGN_EPI) { if (wr == 0) PG8_BAR; }
        { int t2 = tid; asm volatile("" : "+v"(t2)); E(acc, cur, wr, wc, t2 & 15, (t2 & 63) >> 4); }
        if (!has_next) break;
#pragma unroll
        for (int a = 0; a < 2; ++a)
#pragma unroll
            for (int b = 0; b < 2; ++b)
#pragma unroll
                for (int m = 0; m < 4; ++m)
#pragma unroll
                    for (int n = 0; n < 2; ++n) acc[a][b][m][n] = (f32x4){0.f, 0.f, 0.f, 0.f};
        cur = nxt; cA = nA; cB = nB; ++ui;
        if constexpr (ALIGN_EPI) { if (wr == 1) PG8_BAR; }
    }
    PG8_WAIT_V(0);
    if constexpr (!ALIGN_EPI) { if (wr == 0) PG8_BAR; }
    PG8_BAR;
#undef PG8_LOADG
#undef PG8_BASEA
#undef PG8_BASEB
#undef PG8_SA
#undef PG8_SB
#undef PG8_STAGE
#undef PG8_STAGE_A
#undef PG8_LDA
#undef PG8_LDB
#undef PG8_MMA
#undef PG8_WAIT_V
#undef PG8_WAIT_L
#undef PG8_BAR
#undef PG8_SCHED
}
}
namespace mk {
constexpr int NWAVES = 8;
constexpr int D = 1024, BATCH = 8, SEQ = 2048, NMETA = 16, L = SEQ + NMETA, T = BATCH * L, TP = 16640;
constexpr int LP = 2112, PADF = 48;
constexpr int DEPTH = 2, NE = 32, TOPK = 4, FF = 1024, CONVK = 31, NIN = 1696, NINP = 1792;
constexpr int RP = 74240;
constexpr float ALPHA = 1.4142135623730951f, LN_EPS = 1e-5f, RMS_EPS = 1e-6f;
constexpr float LOG2E = 1.4426950408889634f;
constexpr float SBQ_SCALE = 0.125f * LOG2E;
constexpr float MLAQ_SCALE = 0.10206207261596575f * LOG2E;

constexpr size_t MiB = 1u << 20;
constexpr size_t WS_CTL = 0, CTL_ZERO_BYTES = 1 * MiB;
constexpr size_t WS_WIN = 2 * MiB, WS_WUQ = 9 * MiB, WS_WUKV = 10 * MiB, WS_WOUT = 11 * MiB, WS_BGU = 15 * MiB, WS_ROPE = 16 * MiB, WS_STQ = 17 * MiB, WS_STKV = 17 * MiB + 512 * 1024;
constexpr size_t WS_TOKE = 18 * MiB, WS_TOKP = 18 * MiB + 512 * 1024, WS_TOKG = 19 * MiB, WS_LIST = 20 * MiB, WS_RWT = 24 * MiB, WS_ZP = 26 * MiB;
constexpr size_t WS_WGU = 32 * MiB, WS_WD = 288 * MiB, WS_HL = 416 * MiB  , WS_HB = 481 * MiB, WS_Z = 514 * MiB;
constexpr size_t WS_SBQ = 579 * MiB, WS_SBK = 588 * MiB, WS_SBV = 597 * MiB, WS_CQ = 606 * MiB, WS_CKV = 615 * MiB, WS_U = 620 * MiB;
constexpr size_t WS_QM = 637 * MiB, WS_KM = 662 * MiB, WS_VM = 687 * MiB, WS_OATT = 704 * MiB, WS_Y = 753 * MiB, WS_ACT = 786 * MiB, WS_YS = 931 * MiB, WS_MEGA_END = 1076 * MiB;
constexpr size_t WS_CKV2 = 1077 * MiB  , WS_WUKV2 = 1086 * MiB  ;
static_assert(WS_WIN + (size_t)DEPTH * NINP * D * 2 <= WS_WUQ && WS_WOUT + (size_t)DEPTH * D * D * 2 <= WS_BGU && WS_BGU + (size_t)DEPTH * NE * 2 * FF * 4 <= WS_ROPE, "ws map 1");
static_assert(WS_ROPE + (size_t)L * 16 * 8 <= WS_STQ && WS_STQ + (size_t)TP * 16 <= WS_STKV && WS_STKV + (size_t)TP * 16 <= WS_TOKE && WS_TOKE + (size_t)T * 16 <= WS_TOKP && WS_LIST + (size_t)NE * T * 4 <= WS_WGU, "ws map 2");
static_assert(WS_WGU + (size_t)DEPTH * NE * 2 * FF * D * 2 <= WS_WD && WS_WD + (size_t)DEPTH * NE * FF * D * 2 <= WS_HL && WS_HL + (size_t)TP * D * 2 <= WS_HB && WS_HB + (size_t)TP * D * 2 <= WS_Z && WS_Z + (size_t)T * D * 4 <= WS_SBQ, "ws map 3");
static_assert(WS_SBQ + (size_t)BATCH * LP * 256 * 2 <= WS_SBK && WS_SBV + (size_t)BATCH * LP * 256 * 2 <= WS_CQ && WS_CQ + (size_t)TP * 256 * 2 <= WS_CKV && WS_CKV + (size_t)TP * 128 * 2 <= WS_U && WS_U + (size_t)T * 256 * 4 <= WS_QM, "ws map 4");
static_assert(WS_QM + (size_t)BATCH * LP * 768 * 2 <= WS_KM && WS_KM + (size_t)BATCH * LP * 768 * 2 <= WS_VM && WS_VM + (size_t)BATCH * LP * 512 * 2 <= WS_OATT && WS_OATT + (size_t)T * 768 * 4 <= WS_Y && WS_Y + (size_t)TP * D * 2 <= WS_ACT, "ws map 5");
static_assert(WS_ACT + (size_t)RP * FF * 2 <= WS_YS && WS_YS + (size_t)RP * D * 2 <= WS_MEGA_END, "ws map 6");
constexpr int CW_CNT = 1024;
constexpr int CW_CONV = 1536;
constexpr int CW_TAIL = 1600;
constexpr int CW_AQ = 2048;
constexpr int CW_BAR = 4096;
constexpr int CW_RDY = 8192;

constexpr int RING_OFF = 0, RING_BYTES = 131072;
constexpr int LDSCTL_OFF = RING_BYTES, MISC_OFF = LDSCTL_OFF + 320;
constexpr int TAIL_OFF = RING_BYTES + 1024;
constexpr int LDS_BYTES = 147456;

#define GAS __attribute__((address_space(1)))
#define LAS __attribute__((address_space(3)))
typedef unsigned short bf16;
typedef unsigned v4u __attribute__((ext_vector_type(4)));
typedef unsigned v2u __attribute__((ext_vector_type(2)));
typedef float f32x4 __attribute__((ext_vector_type(4)));
typedef float f32x2 __attribute__((ext_vector_type(2)));
typedef short bf16x8 __attribute__((ext_vector_type(8)));
typedef GAS unsigned gu32;
#define RLX_AGENT __ATOMIC_RELAXED, __HIP_MEMORY_SCOPE_AGENT
#define LDS_WAIT() asm volatile("s_waitcnt lgkmcnt(0)" ::: "memory")
#define VM_WAIT() asm volatile("s_waitcnt vmcnt(0)" ::: "memory")
__device__ __forceinline__ unsigned f2bf(float f) { unsigned u = __builtin_bit_cast(unsigned, f); return (u + 0x7fffu + ((u >> 16) & 1u)) >> 16; }
__device__ __forceinline__ unsigned pk2(float lo, float hi) { return f2bf(lo) | (f2bf(hi) << 16); }
__device__ __forceinline__ unsigned cvtpk_rne(float lo, float hi) { typedef float f2_ __attribute__((ext_vector_type(2))); typedef __bf16 b2_ __attribute__((ext_vector_type(2))); f2_ v = {lo, hi}; b2_ b = __builtin_convertvector(v, b2_); return __builtin_bit_cast(unsigned, b); }
__device__ __forceinline__ float bf2f(unsigned short b) { return __builtin_bit_cast(float, (unsigned)b << 16); }
__device__ __forceinline__ float bflo(unsigned w) { return __builtin_bit_cast(float, w << 16); }
__device__ __forceinline__ float bfhi(unsigned w) { return __builtin_bit_cast(float, w & 0xffff0000u); }

#define XB_TMO      128
#define XB_XCNT(j)  (256  + 64 * (j))
#define XB_XSUB(j)  (1280 + 64 * (j))
#define XB_XGEN(j)  (2304 + 64 * (j))
#define XB_TOP      3328
#define XB_TOPGEN   3392
#define XCD_BAR_WORDS 3456
#define XB_SPIN_CAP (1u << 18)

__device__ __forceinline__ unsigned xb_ld(unsigned* p)              { return __hip_atomic_load(p, __ATOMIC_RELAXED, __HIP_MEMORY_SCOPE_AGENT); }
__device__ __forceinline__ unsigned xb_add(unsigned* p, unsigned v) { return __hip_atomic_fetch_add(p, v, __ATOMIC_RELAXED, __HIP_MEMORY_SCOPE_AGENT); }
__device__ __forceinline__ unsigned xb_xcc_id() { return (unsigned)__builtin_amdgcn_s_getreg((3 << 11) | 20) & 0xFu; }
#define XB_SPIN(cond, bar) do { unsigned _sp = 0; while (cond) { __builtin_amdgcn_s_sleep(1); \
    if ((++_sp & 255u) == 0u) { if (xb_ld(&(bar)[XB_TMO])) break; if (_sp > XB_SPIN_CAP) { atomicAdd(&(bar)[XB_TMO], 1u); break; } } } } while (0)

struct XcdBarrier {
    unsigned* bar; unsigned x;
    volatile LAS unsigned* st;
};
__device__ __forceinline__ XcdBarrier xcd_barrier_post(unsigned* bar, volatile LAS unsigned* st) {
    XcdBarrier b; b.bar = bar; b.x = xb_xcc_id(); b.st = st;
    if (threadIdx.x == 0) (void)xb_add(&bar[XB_XCNT(b.x)], 1u);
    return b;
}
__device__ __forceinline__ void xcd_barrier_complete(unsigned* bar, unsigned x, unsigned& nloc, unsigned& nx) {
    const unsigned G = gridDim.x * gridDim.y * gridDim.z;
    unsigned sum, cnt, mine, sp = 0u;
    for (;;) {
        sum = 0u; cnt = 0u; mine = 0u;
#pragma unroll 1
        for (unsigned j = 0; j < 16; ++j) { const unsigned c = xb_ld(&bar[XB_XCNT(j)]); sum += c; cnt += (c > 0u) ? 1u : 0u; mine = (j == x) ? c : mine; }
        if (sum == G) break;
        __builtin_amdgcn_s_sleep(1);
        if ((++sp & 255u) == 0u) { if (xb_ld(&bar[XB_TMO])) break; if (sp > XB_SPIN_CAP) { atomicAdd(&bar[XB_TMO], 1u); break; } }
    }
    nloc = mine > 0u ? mine : 1u; nx = cnt > 0u ? cnt : 1u;
}
__device__ __forceinline__ void xcd_barrier(const XcdBarrier& b) {
    asm volatile("s_waitcnt vmcnt(0)" ::: "memory");
    __syncthreads();
    if (threadIdx.x == 0) {
        unsigned* bar = b.bar;
        __builtin_amdgcn_s_waitcnt(0);
        unsigned nloc = b.st[0], nx = b.st[1];
        if (nloc == 0u) { xcd_barrier_complete(bar, b.x, nloc, nx); b.st[0] = nloc; b.st[1] = nx; }
        const unsigned old = xb_add(&bar[XB_XSUB(b.x)], 1u);
        const unsigned gen = old / nloc;
        if (old + 1u == (gen + 1u) * nloc) {
            __builtin_amdgcn_fence(__ATOMIC_RELEASE, "agent");
            asm volatile("s_waitcnt vmcnt(0)" ::: "memory");
            const unsigned og = xb_add(&bar[XB_TOP], 1u);
            const unsigned tg = og / nx;
            if (og + 1u == (tg + 1u) * nx) xb_add(&bar[XB_TOPGEN], 1u);
            else XB_SPIN(xb_ld(&bar[XB_TOPGEN]) == tg, bar);
            __builtin_amdgcn_fence(__ATOMIC_ACQUIRE, "agent");
            xb_add(&bar[XB_XGEN(b.x)], 1u);
            asm volatile("s_waitcnt vmcnt(0)" ::: "memory");
        } else {
            XB_SPIN(xb_ld(&bar[XB_XGEN(b.x)]) == gen, bar);
            __builtin_amdgcn_fence(__ATOMIC_ACQUIRE, "agent");
            asm volatile("s_waitcnt vmcnt(0)" ::: "memory");
        }
    }
    __syncthreads();
}

__device__ __forceinline__ float wave_sum(float v) {
#pragma unroll
    for (int o = 1; o < 64; o <<= 1) v += __shfl_xor(v, o);
    return v;
}

struct Frame {
    LAS unsigned char* lds;
    volatile LAS unsigned* MISC;
    gu32* ctl;
    unsigned char* ws;
    int tid, lane, wave;
    int vcu, G;
    const float* in[25];
    float* out;
};
}
#if MK_DEBUG
namespace nv {
using namespace mk;
constexpr int R = T * TOPK;

struct GemmP {
    const float* A; const int* arow;
    const float* B; const float* bias; float* C;
    const int* cnt; const int* base;
    long strideB, strideBias;
    int lda, ldb, ldc, M, N, K;
    int swiglu, pad;
};
__global__ void __launch_bounds__(256) sgemm_k(GemmP p) {
    const int e = blockIdx.z;
    const int M = p.cnt ? p.cnt[e] : p.M;
    const int rbase = p.cnt ? p.base[e] : 0;
    const int m0 = blockIdx.y * 64, n0 = blockIdx.x * 64;
    if (m0 >= M) return;
    const float* B = p.B + (size_t)e * p.strideB;
    const float* bias = p.bias ? p.bias + (size_t)e * p.strideBias : nullptr;
    __shared__ float As[16][68], Bs[16][68], Bs2[16][68];
    const int tid = threadIdx.x, tx = tid & 15, ty = tid >> 4;
    const int ar = tid >> 2, ak = (tid & 3) * 4;
    const int bk = tid >> 4, bn = (tid & 15) * 4;
    long arow_idx = -1;
    if (m0 + ar < M) arow_idx = p.arow ? (long)p.arow[rbase + m0 + ar] : (long)(rbase + m0 + ar);
    const bool bvalid = (n0 + bn) < p.N;
    float acc[4][4] = {}, acc2[4][4] = {};
    for (int k0 = 0; k0 < p.K; k0 += 16) {
        float4 av = make_float4(0.f, 0.f, 0.f, 0.f), bv = make_float4(0.f, 0.f, 0.f, 0.f);
        if (arow_idx >= 0) av = *(const float4*)(p.A + (size_t)arow_idx * p.lda + k0 + ak);
        if (bvalid) bv = *(const float4*)(B + (size_t)(k0 + bk) * p.ldb + n0 + bn);
        As[ak + 0][ar] = av.x; As[ak + 1][ar] = av.y; As[ak + 2][ar] = av.z; As[ak + 3][ar] = av.w;
        *(float4*)&Bs[bk][bn] = bv;
        if (p.swiglu) { float4 bv2 = make_float4(0.f, 0.f, 0.f, 0.f); if (bvalid) bv2 = *(const float4*)(B + (size_t)(k0 + bk) * p.ldb + p.N + n0 + bn); *(float4*)&Bs2[bk][bn] = bv2; }
        __syncthreads();
#pragma unroll
        for (int k = 0; k < 16; ++k) {
            const float4 a4 = *(const float4*)&As[k][ty * 4];
            const float4 b4 = *(const float4*)&Bs[k][tx * 4];
            const float a[4] = {a4.x, a4.y, a4.z, a4.w}, b[4] = {b4.x, b4.y, b4.z, b4.w};
#pragma unroll
            for (int i = 0; i < 4; ++i)
#pragma unroll
                for (int j = 0; j < 4; ++j) acc[i][j] = fmaf(a[i], b[j], acc[i][j]);
            if (p.swiglu) { const float4 c4 = *(const float4*)&Bs2[k][tx * 4]; const float c[4] = {c4.x, c4.y, c4.z, c4.w};
#pragma unroll
                for (int i = 0; i < 4; ++i)
#pragma unroll
                    for (int j = 0; j < 4; ++j) acc2[i][j] = fmaf(a[i], c[j], acc2[i][j]); }
        }
        __syncthreads();
    }
#pragma unroll
    for (int i = 0; i < 4; ++i) {
        const int m = m0 + ty * 4 + i;
        if (m >= M) continue;
#pragma unroll
        for (int j = 0; j < 4; ++j) {
            const int n = n0 + tx * 4 + j;
            if (n < p.N) { float v = acc[i][j] + (bias ? bias[n] : 0.f);
                if (p.swiglu) { float g = fminf(v, 7.f), up = acc2[i][j] + (bias ? bias[p.N + n] : 0.f); up = fminf(fmaxf(up, -7.f), 7.f); v = (up + 1.f) * (g / (1.f + expf(-1.702f * g))); }
                p.C[(size_t)(rbase + m) * p.ldc + n] = v; }
        }
    }
}

__device__ __forceinline__ float block_sum256(float v, float* red) {
#pragma unroll
    for (int o = 32; o > 0; o >>= 1) v += __shfl_xor(v, o);
    __syncthreads();
    if ((threadIdx.x & 63) == 0) red[threadIdx.x >> 6] = v;
    __syncthreads();
    return red[0] + red[1] + red[2] + red[3];
}
__global__ void __launch_bounds__(256) ln_in_k(const float* x, const float* meta, const float* g, const float* b, float* H) {
    __shared__ float red[4];
    const int r = blockIdx.x, bb = r / L, p = r % L;
    const float* src = p < NMETA ? meta + (size_t)p * D : x + ((size_t)bb * SEQ + (p - NMETA)) * D;
    float v[4]; float s = 0.f;
#pragma unroll
    for (int i = 0; i < 4; ++i) { v[i] = src[threadIdx.x + 256 * i]; s += v[i]; }
    const float mu = block_sum256(s, red) * (1.f / D);
    float q = 0.f;
#pragma unroll
    for (int i = 0; i < 4; ++i) { v[i] -= mu; q += v[i] * v[i]; }
    const float rstd = 1.0f / sqrtf(block_sum256(q, red) * (1.f / D) + 1e-5f);
#pragma unroll
    for (int i = 0; i < 4; ++i) { const int c = threadIdx.x + 256 * i; H[(size_t)r * D + c] = v[i] * rstd * g[c] + b[c]; }
}
__global__ void __launch_bounds__(256) res_ln_k(float* H, const float* add, const float* g, const float* b, float* out) {
    __shared__ float red[4];
    const int r = blockIdx.x;
    float v[4]; float s = 0.f;
#pragma unroll
    for (int i = 0; i < 4; ++i) { const int c = threadIdx.x + 256 * i; v[i] = ALPHA * H[(size_t)r * D + c] + add[(size_t)r * D + c]; s += v[i]; }
    const float mu = block_sum256(s, red) * (1.f / D);
    float q = 0.f;
#pragma unroll
    for (int i = 0; i < 4; ++i) { v[i] -= mu; q += v[i] * v[i]; }
    const float rstd = 1.0f / sqrtf(block_sum256(q, red) * (1.f / D) + 1e-5f);
    const int bb = r / L, p = r % L;
#pragma unroll
    for (int i = 0; i < 4; ++i) {
        const int c = threadIdx.x + 256 * i; const float o = v[i] * rstd * g[c] + b[c];
        H[(size_t)r * D + c] = o;
        if (out && p >= NMETA) out[((size_t)bb * SEQ + (p - NMETA)) * D + c] = o;
    }
}
__global__ void __launch_bounds__(256) rms_cols_k(const float* P, int ldp, int col0, int W, const float* g, float* O) {
    __shared__ float red[4];
    const int r = blockIdx.x, c = threadIdx.x;
    const float v = c < W ? P[(size_t)r * ldp + col0 + c] : 0.f;
    const float ss = block_sum256(v * v, red);
    const float rstd = 1.0f / sqrtf(ss / (float)W + 1e-6f);
    if (c < W) O[(size_t)r * W + c] = v * rstd * g[c];
}
__global__ void __launch_bounds__(256) rotary_k(float* QM, const float* P, float* KROT) {
    const int r = blockIdx.x, p = r % L, t = threadIdx.x;
    if (t < 128 + 16) {
        const int i = t & 15;
        const float inv = 1.0f / powf(10000.0f, (float)(2 * i) / 32.0f);
        const float ang = (float)p * inv;
        const float c = cosf(ang), s = sinf(ang);
        if (t < 128) {
            const int h = t >> 4; float* q = QM + (size_t)r * 768 + h * 96 + 64;
            const float x1 = q[i], x2 = q[i + 16];
            q[i] = x1 * c - x2 * s; q[i + 16] = x1 * s + x2 * c;
        } else {
            const float* k = P + (size_t)r * NIN + 1152;
            const float x1 = k[i], x2 = k[i + 16];
            KROT[(size_t)r * 32 + i] = x1 * c - x2 * s; KROT[(size_t)r * 32 + i + 16] = x1 * s + x2 * c;
        }
    }
}

template <int MODE>
__global__ void __launch_bounds__(256) attn_k(const float* P, const float* QM, const float* KVM, const float* KROT, float* O) {
    __shared__ float sc[4][L + 16];
    __shared__ float qs[4][96];
    const int w = threadIdx.x >> 6, lane = threadIdx.x & 63;
    const int t = blockIdx.x * 4 + w, h = blockIdx.y, b = blockIdx.z;
    if (t >= L) return;
    const size_t row = (size_t)b * L + t;
    const int n = MODE == 0 ? t : t + 1;
    float* s = sc[w]; float* q = qs[w];
    if (MODE == 0) { q[lane] = P[row * NIN + h * 64 + lane]; }
    else { q[lane] = QM[row * 768 + h * 96 + lane]; if (lane < 32) q[64 + lane] = QM[row * 768 + h * 96 + 64 + lane]; }
    __syncthreads();
    const float scale = MODE == 0 ? 0.125f : 0.10206207261596575f;
    for (int j = lane; j < n; j += 64) {
        const size_t kr = (size_t)b * L + j; float a = 0.f;
        if (MODE == 0) { const float4* k = (const float4*)(P + kr * NIN + 256 + h * 64);
            for (int d = 0; d < 16; ++d) { const float4 kv = k[d]; a = fmaf(q[4 * d], kv.x, a); a = fmaf(q[4 * d + 1], kv.y, a); a = fmaf(q[4 * d + 2], kv.z, a); a = fmaf(q[4 * d + 3], kv.w, a); } }
        else { const float4* k = (const float4*)(KVM + kr * 1024 + h * 128);
            for (int d = 0; d < 16; ++d) { const float4 kv = k[d]; a = fmaf(q[4 * d], kv.x, a); a = fmaf(q[4 * d + 1], kv.y, a); a = fmaf(q[4 * d + 2], kv.z, a); a = fmaf(q[4 * d + 3], kv.w, a); }
            const float4* kp = (const float4*)(KROT + kr * 32);
            for (int d = 0; d < 8; ++d) { const float4 kv = kp[d]; a = fmaf(q[64 + 4 * d], kv.x, a); a = fmaf(q[64 + 4 * d + 1], kv.y, a); a = fmaf(q[64 + 4 * d + 2], kv.z, a); a = fmaf(q[64 + 4 * d + 3], kv.w, a); } }
        s[j] = a * scale;
    }
    __syncthreads();
    if (MODE == 1) {
        float m = -INFINITY; for (int j = lane; j < n; j += 64) m = fmaxf(m, s[j]);
#pragma unroll
        for (int o = 32; o > 0; o >>= 1) m = fmaxf(m, __shfl_xor(m, o));
        float sum = 0.f; for (int j = lane; j < n; j += 64) { const float e = expf(s[j] - m); s[j] = e; sum += e; }
#pragma unroll
        for (int o = 32; o > 0; o >>= 1) sum += __shfl_xor(sum, o);
        const float inv = 1.0f / sum;
        for (int j = lane; j < n; j += 64) s[j] *= inv;
    } else {
        const int C = (n + 63) / 64, j0 = lane * C, j1 = min(n, j0 + C);
        float cs = 0.f;
        for (int j = j0; j < j1; ++j) { const float z = s[j]; const float a = -(fmaxf(z, 0.f) + log1pf(expf(-fabsf(z)))); cs += a; }
        float incl = cs;
#pragma unroll
        for (int o = 1; o < 64; o <<= 1) { const float v = __shfl_down(incl, o); if (lane + o < 64) incl += v; }
        float run = incl - cs;
        for (int j = j1 - 1; j >= j0; --j) { const float z = s[j]; const float a = -(fmaxf(z, 0.f) + log1pf(expf(-fabsf(z)))); run += a; s[j] = expf(z + run); }
    }
    __syncthreads();
    float o = 0.f;
    if (MODE == 0) { const float* v = P + (size_t)b * L * NIN + 512 + h * 64 + lane; for (int j = 0; j < n; ++j) o = fmaf(s[j], v[(size_t)j * NIN], o); O[row * 256 + h * 64 + lane] = o; }
    else { const float* v = KVM + (size_t)b * L * 1024 + h * 128 + 64 + lane; for (int j = 0; j < n; ++j) o = fmaf(s[j], v[(size_t)j * 1024], o); O[row * 512 + h * 64 + lane] = o; }
}

__global__ void __launch_bounds__(256) mix_norm_k(const float* P, const float* SBO, const float* MLAO, const float* cw, const float* cb, const float* clg, const float* clb,
                                                  const float* gg, float* Y) {
    __shared__ float red[4];
    const int r = blockIdx.x, p = r % L, c = threadIdx.x;
    float acc = cb[c];
    for (int k = 0; k < CONVK; ++k) {
        const int pp = p - (CONVK - 1) + k;
        if (pp >= 0) { const float* pr = P + (size_t)(r - (CONVK - 1) + k) * NIN; const float a = pr[1184 + c], g = pr[1440 + c]; acc = fmaf(a / (1.f + expf(-g)), cw[k * 256 + c], acc); }
    }
    const float mu = block_sum256(acc, red) * (1.f / 256.f);
    const float dv = acc - mu;
    const float var = block_sum256(dv * dv, red) * (1.f / 256.f);
    float y = dv * (1.0f / sqrtf(var + 1e-5f)) * clg[c] + clb[c];
    y = y / (1.f + expf(-y));
    const float ssc = block_sum256(y * y, red);
    Y[(size_t)r * D + 768 + c] = y * (1.0f / sqrtf(ssc / 256.f + 1e-6f)) * gg[768 + c];
    const float sb = SBO[(size_t)r * 256 + c];
    const float sss = block_sum256(sb * sb, red);
    Y[(size_t)r * D + c] = sb * (1.0f / sqrtf(sss / 256.f + 1e-6f)) * gg[c];
    const float m0 = MLAO[(size_t)r * 512 + c], m1 = MLAO[(size_t)r * 512 + 256 + c];
    const float ssm = block_sum256(m0 * m0 + m1 * m1, red);
    const float rm = 1.0f / sqrtf(ssm / 512.f + 1e-6f);
    Y[(size_t)r * D + 256 + c] = m0 * rm * gg[256 + c];
    Y[(size_t)r * D + 512 + c] = m1 * rm * gg[512 + c];
}

__global__ void route_k(const float* LOG, int* cnt, int* te, int* tp, float* tg) {
    const int t = blockIdx.x * blockDim.x + threadIdx.x;
    if (t >= T) return;
    float v[NE];
#pragma unroll
    for (int e = 0; e < NE; ++e) v[e] = LOG[(size_t)t * NE + e];
    float tv[TOPK]; int ti[TOPK];
#pragma unroll
    for (int k = 0; k < TOPK; ++k) {
        float bv = -INFINITY; int bi = 0;
#pragma unroll
        for (int e = 0; e < NE; ++e) if (v[e] > bv) { bv = v[e]; bi = e; }
        tv[k] = bv; ti[k] = bi;
#pragma unroll
        for (int e = 0; e < NE; ++e) if (e == bi) v[e] = -INFINITY;
    }
    float sum = 0.f, ex[TOPK];
#pragma unroll
    for (int k = 0; k < TOPK; ++k) { ex[k] = expf(tv[k] - tv[0]); sum += ex[k]; }
#pragma unroll
    for (int k = 0; k < TOPK; ++k) { te[t * TOPK + k] = ti[k]; tg[t * TOPK + k] = ex[k] / sum; tp[t * TOPK + k] = atomicAdd(&cnt[ti[k]], 1); }
}
__global__ void prefix_k(const int* cnt, int* base) { if (threadIdx.x == 0) { int s = 0; for (int e = 0; e < NE; ++e) { base[e] = s; s += cnt[e]; } } }
__global__ void scatter_k(const int* te, const int* tp, const int* base, int* list, int* slot) {
    const int i = blockIdx.x * blockDim.x + threadIdx.x;
    if (i >= R) return;
    const int s = base[te[i]] + tp[i]; list[s] = i / TOPK; slot[i] = s;
}
__global__ void swiglu_k(const float* GU, float* ACT) {
    const size_t i = (size_t)blockIdx.x * blockDim.x + threadIdx.x;
    if (i >= (size_t)R * FF) return;
    const size_t r = i / FF; const int c = (int)(i % FF);
    float g = GU[r * 2 * FF + c], up = GU[r * 2 * FF + FF + c];
    g = fminf(g, 7.f); up = fminf(fmaxf(up, -7.f), 7.f);
    ACT[i] = (up + 1.f) * (g / (1.f + expf(-1.702f * g)));
}
__global__ void __launch_bounds__(256) combine_k(const float* YS, const int* slot, const float* tg, float* FFN) {
    const int t = blockIdx.x;
#pragma unroll
    for (int i = 0; i < 4; ++i) {
        const int c = threadIdx.x + 256 * i; float a = 0.f;
#pragma unroll
        for (int k = 0; k < TOPK; ++k) a += YS[(size_t)slot[t * TOPK + k] * D + c] * tg[t * TOPK + k];
        FFN[(size_t)t * D + c] = a;
    }
}
}
#endif
namespace mk {
struct MapId { __device__ __forceinline__ int operator()(int n) const { return n; } };
struct MapIn {
    __device__ __forceinline__ int operator()(int n) const {
        if (n < 1184) return n;
        if (n < 1280) return -1;
        const int t = n - 1280, tile = t >> 8, j = t & 255, ch = tile * 128 + (j & 127);
        return (j < 128 ? 1184 : 1440) + ch;
    }
};
struct MapGU {
    __device__ __forceinline__ int operator()(int n) const { const int pn = n >> 8, j = n & 255; return (j < 128 ? 0 : FF) + pn * 128 + (j & 127); }
};
template <class Map>
__device__ __forceinline__ void p0_transpose_item(const float* W, int K, int N, int nblk, bf16* WT, const float* gain, LAS float* scr, int item, int lane, Map map, int ldt = 0) {
    if (ldt == 0) ldt = K;
    const int kb = item / nblk, nb = item % nblk, k0 = 64 * kb, n0 = 32 * nb;
    const int src = map(n0 + (lane & 31));
#pragma unroll 8
    for (int i = 0; i < 32; ++i) { const int kk = 2 * i + (lane >> 5); float v = 0.f; if (src >= 0) v = W[(size_t)(k0 + kk) * N + src]; if (gain) v *= gain[k0 + kk]; scr[kk * 33 + (lane & 31)] = v; }
    LDS_WAIT(); asm volatile("" ::: "memory");
    const int c = lane & 7;
#pragma unroll
    for (int j = 0; j < 4; ++j) { const int n = (lane >> 3) + 8 * j; const LAS float* s = scr + (8 * c) * 33 + n;
        v4u o; o.x = pk2(s[0 * 33], s[1 * 33]); o.y = pk2(s[2 * 33], s[3 * 33]); o.z = pk2(s[4 * 33], s[5 * 33]); o.w = pk2(s[6 * 33], s[7 * 33]);
        *(GAS v4u*)(WT + (size_t)(n0 + n) * ldt + k0 + 8 * c) = o; }
    LDS_WAIT(); asm volatile("" ::: "memory");
}
template <class Map>
__device__ __forceinline__ void p0_tr64_load(const float* W, int N, int nblk, int item, int lane, Map map, f32x4 (&v)[8]) {
    const int kb = item / nblk, nb = item - kb * nblk; const float* src = W + (size_t)(32 * kb + (lane >> 4)) * N + map(64 * nb) + (lane & 15) * 4;
#pragma unroll
    for (int i = 0; i < 8; ++i) v[i] = __builtin_nontemporal_load((const f32x4*)(src + (size_t)(4 * i) * N));
}
__device__ __forceinline__ void p0_tr64_store(const f32x4 (&v)[8], int K, int nblk, int item, bf16* WT, LAS float* scr, int lane) {
    const int kb = item / nblk, nb = item - kb * nblk, k0 = 32 * kb, n0 = 64 * nb;
#pragma unroll
    for (int i = 0; i < 8; ++i) { LAS float* d = scr + (4 * i + (lane >> 4)) * 65 + (lane & 15) * 4; d[0] = v[i].x; d[1] = v[i].y; d[2] = v[i].z; d[3] = v[i].w; }
    LDS_WAIT(); asm volatile("" ::: "memory");
    const int c = lane & 3;
#pragma unroll
    for (int j = 0; j < 4; ++j) { const int n = (lane >> 2) + 16 * j; const LAS float* s = scr + (8 * c) * 65 + n;
        v4u o; o.x = cvtpk_rne(s[0 * 65], s[1 * 65]); o.y = cvtpk_rne(s[2 * 65], s[3 * 65]); o.z = cvtpk_rne(s[4 * 65], s[5 * 65]); o.w = cvtpk_rne(s[6 * 65], s[7 * 65]);
        *(GAS v4u*)(WT + (size_t)(n0 + n) * K + k0 + 8 * c) = o; }
    LDS_WAIT(); asm volatile("" ::: "memory");
}
struct Args { const float* in[25]; float* out; unsigned char* ws; int ph_lo, ph_hi; };
typedef const Args __attribute__((address_space(4)))* KArgs;
__device__ __forceinline__ KArgs kargs() { KArgs p = (KArgs)__builtin_amdgcn_kernarg_segment_ptr(); asm volatile("" : "+s"(p)); return p; }
enum { I_X = 0, I_META, I_LNIN_G, I_LNIN_B, I_WIN, I_QNG, I_WUQ, I_KVNG, I_WUKV, I_CONVW, I_CONVB, I_CLNG, I_CLNB, I_GRPG, I_WOUT, I_LNMIX_G, I_LNMIX_B, I_RW, I_RB, I_WGU, I_BGU, I_WD, I_BD, I_LNFFN_G, I_LNFFN_B };

__device__ __forceinline__ void ln_row16(f32x4 (&v)[4], const float* g, const float* b, int lane) {
    float s = 0.f;
#pragma unroll
    for (int j = 0; j < 4; ++j) s += (v[j].x + v[j].y) + (v[j].z + v[j].w);
    const float mean = wave_sum(s) * (1.f / D); float s2 = 0.f;
#pragma unroll
    for (int j = 0; j < 4; ++j) { v[j] = v[j] - mean; s2 += (v[j].x * v[j].x + v[j].y * v[j].y) + (v[j].z * v[j].z + v[j].w * v[j].w); }
    const float rstd = __builtin_amdgcn_rsqf(wave_sum(s2) * (1.f / D) + LN_EPS);
#pragma unroll
    for (int j = 0; j < 4; ++j) { const f32x4 gg = *(const f32x4*)(g + 4 * lane + 256 * j), bb = *(const f32x4*)(b + 4 * lane + 256 * j); v[j] = v[j] * rstd * gg + bb; }
}
__device__ __forceinline__ void store_row16(const f32x4 (&v)[4], float* hf, bf16* hb, int lane) {
#pragma unroll
    for (int j = 0; j < 4; ++j) {
        if (hf) *(f32x4*)(hf + 4 * lane + 256 * j) = v[j];
        if (hb) *(v2u*)(hb + 4 * lane + 256 * j) = (v2u){pk2(v[j].x, v[j].y), pk2(v[j].z, v[j].w)};
    }
}

__device__ __forceinline__ void p0_prologue(Frame& F, KArgs A) {
    LAS float* scr = (LAS float*)(F.lds + RING_OFF + F.wave * 16384);
    const int gw = F.vcu * NWAVES + F.wave, NGW = F.G * NWAVES, lane = F.lane;
    unsigned char* ws = F.ws;
    constexpr int I_IN = 16 * (NINP / 32), I_UQ = 4 * 24, I_UKV = 2 * 32, I_OUT = 16 * 32, I_GU = 32 * 32, I_DN = 32 * 16;
    constexpr int S0 = DEPTH * I_IN, S1 = S0 + DEPTH * I_UQ, S2 = S1 + DEPTH * I_UKV, S3 = S2 + DEPTH * I_OUT;
    for (int it = gw; it < S3; it += NGW) {
        if (it >= S2) { const int r = it - S2, l = r / I_OUT, i = r % I_OUT;
            p0_transpose_item(A->in[I_WOUT] + (size_t)l * D * D, D, D, D / 32, (bf16*)(ws + WS_WOUT) + (size_t)l * D * D, A->in[I_GRPG] + l * D, scr, i, lane, MapId()); }
        else if (it >= S1) { const int r = it - S1, l = r / I_UKV, i = r % I_UKV;
            p0_transpose_item(A->in[I_WUKV] + (size_t)l * 128 * 1024, 128, 1024, 1024 / 32, (bf16*)(ws + WS_WUKV2) + (size_t)l * 1024 * 256, A->in[I_KVNG] + l * 128, scr, i, lane, MapId(), 256); }
        else if (it >= S0) { const int r = it - S0, l = r / I_UQ, i = r % I_UQ;
            p0_transpose_item(A->in[I_WUQ] + (size_t)l * 256 * 768, 256, 768, 768 / 32, (bf16*)(ws + WS_WUQ) + (size_t)l * 768 * 256, A->in[I_QNG] + l * 256, scr, i, lane, MapId()); }
        else { const int l = it / I_IN, i = it % I_IN;
            p0_transpose_item(A->in[I_WIN] + (size_t)l * D * NIN, D, NIN, NINP / 32, (bf16*)(ws + WS_WIN) + (size_t)l * NINP * D, nullptr, scr, i, lane, MapIn()); }
    }
    const int gt = gw * 64 + lane, NGT = NGW * 64;
    for (int i = gt; i < DEPTH * NE * 2 * FF; i += NGT) { const int m = i / (2 * FF), n = i % (2 * FF); ((float*)(ws + WS_BGU))[i] = A->in[I_BGU][(size_t)m * 2 * FF + MapGU()(n)]; }
    for (int i = gt; i < L * 16; i += NGT) { const int p = i >> 4, k = i & 15; const float inv = 1.0f / powf(10000.0f, (float)(2 * k) / 32.0f); const float ang = (float)p * inv;
        ((f32x2*)(ws + WS_ROPE))[i] = (f32x2){cosf(ang), sinf(ang)}; }
    for (int i = gt; i < DEPTH * NE * D; i += NGT) { const int ll = i / (NE * D), e = (i / D) % NE, k = i % D; const float w = A->in[I_RW][((size_t)ll * D + k) * NE + e]; const unsigned h = f2bf(w);
        bf16* o = (bf16*)(ws + WS_RWT) + (size_t)ll * 2 * NE * D + (size_t)e * D + k; o[0] = (bf16)h; o[NE * D] = (bf16)f2bf(w - bf2f((bf16)h)); }
    for (int i = gt; i < DEPTH * 1024 * 128; i += NGT) ((bf16*)(ws + WS_WUKV2))[(size_t)(i >> 7) * 256 + 128 + (i & 127)] = 0;
    for (int i = gt; i < BATCH * PADF * 256; i += NGT) { const int b = i / (PADF * 256), r = i % (PADF * 256); ((bf16*)(ws + WS_SBV))[(size_t)b * LP * 256 + r] = 0; ((bf16*)(ws + WS_SBK))[(size_t)b * LP * 256 + r] = 0; }
    for (int i = gt; i < BATCH * PADF * 512; i += NGT) { const int b = i / (PADF * 512), r = i % (PADF * 512); ((bf16*)(ws + WS_VM))[(size_t)b * LP * 512 + r] = 0; }
    for (int i = gt; i < BATCH * PADF * 768; i += NGT) { const int b = i / (PADF * 768), r = i % (PADF * 768); ((bf16*)(ws + WS_KM))[(size_t)b * LP * 768 + r] = 0; }
    for (int r = gw; r < TP; r += NGW) {
        bf16* hb = (bf16*)(ws + WS_HB) + (size_t)r * D;
        if (r >= T) { *(v4u*)(hb + 8 * lane) = (v4u){0u, 0u, 0u, 0u}; *(v4u*)(hb + 512 + 8 * lane) = (v4u){0u, 0u, 0u, 0u}; continue; }
        const int bb = r / L, p = r - bb * L;
        const float* src = p < NMETA ? A->in[I_META] + (size_t)p * D : A->in[I_X] + ((size_t)bb * SEQ + (p - NMETA)) * D;
        f32x4 v[4];
#pragma unroll
        for (int j = 0; j < 4; ++j) v[j] = *(const f32x4*)(src + 4 * lane + 256 * j);
        ln_row16(v, A->in[I_LNIN_G], A->in[I_LNIN_B], lane);
        store_row16(v, nullptr, hb, lane);
    }
}


constexpr int CONV_IGU = 32 * 32, CONV_IDN = 32 * 16, CONV_NGU = NE * CONV_IGU, CONV_ITEMS = CONV_NGU + NE * CONV_IDN, CONV_CHUNK = 32, CONV_NCHUNK = CONV_ITEMS / CONV_CHUNK;
__device__ __forceinline__ void conv_chunk(Frame& F, KArgs A, int l, int ch, LAS float* scr) {
    unsigned char* ws = F.ws; int tid = F.tid; asm volatile("" : "+v"(tid)); const int lane = tid & 63;
    const float* wgu = A->in[I_WGU] + (size_t)l * NE * D * 2 * FF; const float* wdn = A->in[I_WD] + (size_t)l * NE * FF * D;
    bf16* tgu = (bf16*)(ws + WS_WGU) + (size_t)l * NE * 2 * FF * D; bf16* tdn = (bf16*)(ws + WS_WD) + (size_t)l * NE * D * FF;
    const bool isgu = ch < CONV_NGU / CONV_CHUNK; const int chl = isgu ? ch : ch - CONV_NGU / CONV_CHUNK;
    const int nblk = isgu ? 2 * FF / 64 : D / 64, cpe = nblk * 32 / CONV_CHUNK, m = chl / cpe, cl = chl - m * cpe, ngr = nblk / 16, kbp = cl / ngr, ng = cl - kbp * ngr;
    const float* src = isgu ? wgu + (size_t)m * D * 2 * FF : wdn + (size_t)m * FF * D; bf16* dst = isgu ? tgu + (size_t)m * 2 * FF * D : tdn + (size_t)m * D * FF;
    const int N = isgu ? 2 * FF : D;
#define CV_ITEM(k_) ((2 * kbp + ((k_) & 1)) * nblk + ng * 16 + F.wave + 8 * ((k_) >> 1))
#define CV_LOAD(k_, v_) do { if (isgu) p0_tr64_load(src, N, nblk, CV_ITEM(k_), lane, MapGU(), v_); else p0_tr64_load(src, N, nblk, CV_ITEM(k_), lane, MapId(), v_); } while (0)
#define CV_STORE(k_, v_) p0_tr64_store(v_, 1024, nblk, CV_ITEM(k_), dst, scr, lane)
    f32x4 va[8], vb[8], vc[8], vd[8];
    CV_LOAD(0, va); CV_LOAD(1, vb); CV_LOAD(2, vc); CV_LOAD(3, vd);
    CV_STORE(0, va); CV_STORE(1, vb); CV_STORE(2, vc); CV_STORE(3, vd);
#undef CV_ITEM
#undef CV_LOAD
#undef CV_STORE
}

typedef pg8::f32x4 (AccT)[2][2][4][2];
__device__ __forceinline__ v2u pk4(f32x4 v) { return (v2u){cvtpk_rne(v.x, v.y), cvtpk_rne(v.z, v.w)}; }
__device__ __forceinline__ float sigmoidf_(float x) { return __builtin_amdgcn_rcpf(1.0f + __builtin_amdgcn_exp2f(x * -LOG2E)); }

struct EpiInProj {
    static constexpr bool PERM = false;
    bf16 *SBQ, *SBK, *SBV, *CQ, *CKV, *KM; float *U, *STQ, *STKV; const f32x2* ROPE;
    __device__ __forceinline__ void operator()(const AccT& acc, const pg8::Unit& u, int wr, int wc, int fr, int fq) const {
        const int pn = u.pn;
#pragma unroll
        for (int ai = 0; ai < 2; ++ai) {
            if (u.pm * 256 + ai * 128 >= T) continue;
#pragma unroll
            for (int m = 0; m < 4; ++m) {
                const int r = u.pm * 256 + ai * 128 + wr * 64 + m * 16 + fr;
                const int bb = r / L, p = r - bb * L; const size_t ar = (size_t)bb * LP + p + PADF;
                if (pn <= 2) {
                    bf16* dst = (pn == 0 ? SBQ : pn == 1 ? SBK : SBV) + ar * 256 + wc * 32 + 4 * fq; const float sc = pn == 0 ? SBQ_SCALE : 1.0f;
#pragma unroll
                    for (int bj = 0; bj < 2; ++bj)
#pragma unroll
                        for (int n = 0; n < 2; ++n) *(v2u*)(dst + bj * 128 + n * 16) = pk4(acc[ai][bj][m][n] * sc);
                } else if (pn == 3) {
                    float ss = 0.f;
#pragma unroll
                    for (int bj = 0; bj < 2; ++bj)
#pragma unroll
                        for (int n = 0; n < 2; ++n) { const f32x4 v = acc[ai][bj][m][n]; ss += (v.x * v.x + v.y * v.y) + (v.z * v.z + v.w * v.w); *(v2u*)(CQ + (size_t)r * 256 + bj * 128 + wc * 32 + n * 16 + 4 * fq) = pk4(v); }
                    ss += __shfl_xor(ss, 16); ss += __shfl_xor(ss, 32);
                    if (fq == 0) STQ[(size_t)r * 4 + wc] = ss;
                } else if (pn == 4) {
                    float ss = 0.f;
#pragma unroll
                    for (int n = 0; n < 2; ++n) { const f32x4 v = acc[ai][0][m][n]; ss += (v.x * v.x + v.y * v.y) + (v.z * v.z + v.w * v.w); *(v2u*)(CKV + (size_t)r * 256 + wc * 32 + n * 16 + 4 * fq) = pk4(v); *(v2u*)(CKV + (size_t)r * 256 + 128 + wc * 32 + n * 16 + 4 * fq) = (v2u){0u, 0u}; }
                    ss += __shfl_xor(ss, 16); ss += __shfl_xor(ss, 32);
                    if (fq == 0) STKV[(size_t)r * 4 + wc] = ss;
                    if (wc == 0) {
                        const f32x4 x1 = acc[ai][1][m][0], x2 = acc[ai][1][m][1]; f32x4 y1, y2;
#pragma unroll
                        for (int j = 0; j < 4; ++j) { const f32x2 cs = ROPE[p * 16 + 4 * fq + j]; y1[j] = x1[j] * cs.x - x2[j] * cs.y; y2[j] = x1[j] * cs.y + x2[j] * cs.x; }
                        const v2u w1 = pk4(y1), w2 = pk4(y2);
#pragma unroll
                        for (int h = 0; h < 8; ++h) { bf16* kd = KM + ar * 768 + h * 96 + 64 + 4 * fq; *(v2u*)kd = w1; *(v2u*)(kd + 16) = w2; }
                    }
                } else {
#pragma unroll
                    for (int n = 0; n < 2; ++n) { const f32x4 a = acc[ai][0][m][n], g = acc[ai][1][m][n]; f32x4 o;
#pragma unroll
                        for (int j = 0; j < 4; ++j) o[j] = a[j] * sigmoidf_(g[j]);
                        *(f32x4*)(U + (size_t)r * 256 + (pn - 5) * 128 + wc * 32 + n * 16 + 4 * fq) = o; }
                }
                asm volatile("" ::: "memory");
            }
        }
    }
};
struct EpiMlaQ {
    static constexpr bool PERM = false;
    bf16* QM; const float* STQ; const f32x2* ROPE;
    __device__ __forceinline__ void operator()(const AccT& acc, const pg8::Unit& u, int wr, int wc, int fr, int fq) const {
#pragma unroll
        for (int ai = 0; ai < 2; ++ai) {
            if (u.pm * 256 + ai * 128 >= T) continue;
#pragma unroll
            for (int m = 0; m < 4; ++m) {
                const int r = u.pm * 256 + ai * 128 + wr * 64 + m * 16 + fr;
                const int bb = r / L, p = r - bb * L; const size_t ar = (size_t)bb * LP + p + PADF;
                const f32x4 st = *(const f32x4*)(STQ + (size_t)r * 4);
                const float rs = MLAQ_SCALE * __builtin_amdgcn_rsqf(((st.x + st.y) + (st.z + st.w)) * (1.f / 256.f) + RMS_EPS);
#pragma unroll
                for (int bj = 0; bj < 2; ++bj) {
                    const int G = 8 * u.pn + 4 * bj + wc, head = G / 3, part = G - 3 * head;
                    f32x4 v0 = acc[ai][bj][m][0] * rs, v1 = acc[ai][bj][m][1] * rs;
                    if (part == 2) {
#pragma unroll
                        for (int j = 0; j < 4; ++j) { const f32x2 cs = ROPE[p * 16 + 4 * fq + j]; const float x1 = v0[j], x2 = v1[j]; v0[j] = x1 * cs.x - x2 * cs.y; v1[j] = x1 * cs.y + x2 * cs.x; }
                    }
                    bf16* dst = QM + ar * 768 + head * 96 + part * 32 + 4 * fq;
                    *(v2u*)dst = pk4(v0); *(v2u*)(dst + 16) = pk4(v1);
                }
                asm volatile("" ::: "memory");
            }
        }
    }
};
struct EpiMlaKV {
    static constexpr bool PERM = false;
    bf16 *KM, *VM; const float* STKV;
    __device__ __forceinline__ void operator()(const AccT& acc, const pg8::Unit& u, int wr, int wc, int fr, int fq) const {
#pragma unroll
        for (int ai = 0; ai < 2; ++ai) {
            if (u.pm * 256 + ai * 128 >= T) continue;
#pragma unroll
            for (int m = 0; m < 4; ++m) {
                const int r = u.pm * 256 + ai * 128 + wr * 64 + m * 16 + fr;
                const int bb = r / L, p = r - bb * L; const size_t ar = (size_t)bb * LP + p + PADF;
                const f32x4 st = *(const f32x4*)(STKV + (size_t)r * 4);
                const float rs = __builtin_amdgcn_rsqf(((st.x + st.y) + (st.z + st.w)) * (1.f / 128.f) + RMS_EPS);
#pragma unroll
                for (int bj = 0; bj < 2; ++bj) {
                    const int G = 8 * u.pn + 4 * bj + wc, head = G >> 2, part = G & 3;
                    bf16* dst = part < 2 ? KM + ar * 768 + head * 96 + part * 32 + 4 * fq : VM + ar * 512 + head * 64 + (part - 2) * 32 + 4 * fq;
                    *(v2u*)dst = pk4(acc[ai][bj][m][0] * rs); *(v2u*)(dst + 16) = pk4(acc[ai][bj][m][1] * rs);
                }
                asm volatile("" ::: "memory");
            }
        }
    }
};
struct EpiMla {
    static constexpr bool PERM = false;
    EpiMlaQ q; EpiMlaKV kv;
    __device__ __forceinline__ void operator()(const AccT& acc, const pg8::Unit& u, int wr, int wc, int fr, int fq) const { if (u.kind == 0) q(acc, u, wr, wc, fr, fq); else kv(acc, u, wr, wc, fr, fq); }
};
struct MlaOrder {
    pg8::StaticOrder sq, sk; int G, c;
    __device__ __forceinline__ bool next(int i, pg8::Unit& u) const {
        const int Lx = i * G + c;
        if (Lx < sq.nwg) { pg8::StaticOrder s = sq; s.G = 1; s.c = 0; const bool ok = s.next(Lx, u); u.kind = 0; return ok; }
        if (Lx - sq.nwg < sk.nwg) { pg8::StaticOrder s = sk; s.G = 1; s.c = 0; const bool ok = s.next(Lx - sq.nwg, u); u.kind = 1; return ok; }
        return false;
    }
};
struct EpiOut {
    static constexpr bool PERM = false;
    const bf16* HBr; float* Z;
    __device__ __forceinline__ void operator()(const AccT& acc, const pg8::Unit& u, int wr, int wc, int fr, int fq) const {
#pragma unroll
        for (int ai = 0; ai < 2; ++ai) {
            if (u.pm * 256 + ai * 128 >= T) continue;
#pragma unroll
            for (int m = 0; m < 4; ++m) {
                const size_t off = (size_t)(u.pm * 256 + ai * 128 + wr * 64 + m * 16 + fr) * D + u.pn * 256 + wc * 32 + 4 * fq;
#pragma unroll
                for (int bj = 0; bj < 2; ++bj)
#pragma unroll
                    for (int n = 0; n < 2; ++n) { const v2u hw = *(const v2u*)(HBr + off + bj * 128 + n * 16); const f32x4 h = (f32x4){bflo(hw.x), bfhi(hw.x), bflo(hw.y), bfhi(hw.y)}; *(f32x4*)(Z + off + bj * 128 + n * 16) = h * ALPHA + acc[ai][bj][m][n]; }
                asm volatile("" ::: "memory");
            }
        }
    }
};
struct EpiOutTail {
    static constexpr bool PERM = false;
    float* ZP;
    __device__ __forceinline__ void operator()(const AccT& acc, const pg8::Unit& u, int wr, int wc, int fr, int fq) const {
        float* base = ZP + (size_t)(u.ko >> 8) * 128 * D;
#pragma unroll
        for (int m = 0; m < 4; ++m) {
            const size_t off = (size_t)(wr * 64 + m * 16 + fr) * D + u.pn * 256 + wc * 32 + 4 * fq;
#pragma unroll
            for (int bj = 0; bj < 2; ++bj)
#pragma unroll
                for (int n = 0; n < 2; ++n) *(f32x4*)(base + off + bj * 128 + n * 16) = acc[0][bj][m][n];
        }
    }
};
struct TailOrder {
    int vcu;
    __device__ __forceinline__ bool next(int i, pg8::Unit& u) const { if (i > 0 || (vcu & 15) != 0) return false; const int j = vcu >> 4; u.pm = 64; u.pn = j & 3; u.pb = j & 3; u.ko = (j >> 2) * 256; u.kind = 0; return true; }
    __device__ __forceinline__ void a_ready(const pg8::Unit&) const {}
    __device__ __forceinline__ const LAS int* rowlist(int) const { return nullptr; }
};
__device__ __forceinline__ void store16_wt(void* p, v4u v) { asm volatile("global_store_dwordx4 %0, %1, off sc1\n\ts_nop 1" :: "v"(p), "v"(v) : "memory"); }
struct EpiMoe1 {
    static constexpr bool PERM = true;
    bf16* ACT; const float* BGU; unsigned* rdy;
    mutable int pend = -1;
    __device__ __forceinline__ void flush(int fr, int fq, bool drain_all) const {
        if (pend < 0) return;
        if (drain_all) asm volatile("s_waitcnt vmcnt(0)" ::: "memory"); else asm volatile("s_waitcnt vmcnt(8)" ::: "memory");
        if (fr == 0 && fq == 0) __hip_atomic_fetch_add(rdy + 16 * pend, 1u, __ATOMIC_RELAXED, __HIP_MEMORY_SCOPE_AGENT);
        pend = -1;
    }
    __device__ __forceinline__ void operator()(const AccT& acc, const pg8::Unit& u, int wr, int wc, int fr, int fq) const {
        flush(fr, fq, false);
        const int c8 = wc * 32 + 8 * fq; const float* bp = BGU + (size_t)u.pb * 256 + c8;
        f32x4 bg[2], bu[2];
#pragma unroll
        for (int n = 0; n < 2; ++n) { bg[n] = *(const f32x4*)(bp + 4 * n); bu[n] = *(const f32x4*)(bp + 128 + 4 * n); }
#pragma unroll
        for (int ai = 0; ai < 2; ++ai)
#pragma unroll
            for (int m = 0; m < 4; ++m) {
                bf16* dst = ACT + (size_t)(u.pm * 256 + ai * 128 + wr * 64 + m * 16 + fr) * FF + u.pn * 128 + c8;
                f32x4 o[2];
#pragma unroll
                for (int n = 0; n < 2; ++n) { const f32x4 g = acc[ai][0][m][n] + bg[n], up = acc[ai][1][m][n] + bu[n];
#pragma unroll
                    for (int j = 0; j < 4; j += 2) { f32x2 gg, uu; gg.x = fminf(g[j], 7.0f); gg.y = fminf(g[j + 1], 7.0f); uu.x = __builtin_amdgcn_fmed3f(up[j], -7.0f, 7.0f); uu.y = __builtin_amdgcn_fmed3f(up[j + 1], -7.0f, 7.0f);
                        const f32x2 t = gg * (-1.702f * LOG2E); f32x2 e; e.x = __builtin_amdgcn_exp2f(t.x); e.y = __builtin_amdgcn_exp2f(t.y);
                        const f32x2 d = e + 1.0f; f32x2 r; r.x = __builtin_amdgcn_rcpf(d.x); r.y = __builtin_amdgcn_rcpf(d.y);
                        const f32x2 res = (uu + 1.0f) * (gg * r); o[n][j] = res.x; o[n][j + 1] = res.y; } }
                v4u w; w.x = cvtpk_rne(o[0].x, o[0].y); w.y = cvtpk_rne(o[0].z, o[0].w); w.z = cvtpk_rne(o[1].x, o[1].y); w.w = cvtpk_rne(o[1].z, o[1].w);
                store16_wt(dst, w);
            }
        pend = u.pm;
    }
};
struct EpiMoe2 {
    static constexpr bool PERM = true;
    bf16* YS; const float* BD;
    __device__ __forceinline__ void operator()(const AccT& acc, const pg8::Unit& u, int wr, int wc, int fr, int fq) const {
        const int c8 = wc * 32 + 8 * fq; const float* bp = BD + (size_t)u.pb * 256 + c8;
        f32x4 bv[2][2];
#pragma unroll
        for (int bj = 0; bj < 2; ++bj)
#pragma unroll
            for (int n = 0; n < 2; ++n) bv[bj][n] = *(const f32x4*)(bp + bj * 128 + 4 * n);
#pragma unroll
        for (int ai = 0; ai < 2; ++ai)
#pragma unroll
            for (int m = 0; m < 4; ++m) {
                bf16* dst = YS + (size_t)(u.pm * 256 + ai * 128 + wr * 64 + m * 16 + fr) * D + u.pn * 256 + c8;
#pragma unroll
                for (int bj = 0; bj < 2; ++bj) { const f32x4 v0 = acc[ai][bj][m][0] + bv[bj][0], v1 = acc[ai][bj][m][1] + bv[bj][1];
                    v4u w; w.x = cvtpk_rne(v0.x, v0.y); w.y = cvtpk_rne(v0.z, v0.w); w.z = cvtpk_rne(v1.x, v1.y); w.w = cvtpk_rne(v1.z, v1.w);
                    *(v4u*)(dst + bj * 128) = w; }
                asm volatile("" ::: "memory");
            }
    }
};

struct EpiMoe12 {
    static constexpr bool PERM = true;
    EpiMoe1 e1; EpiMoe2 e2;
    __device__ __forceinline__ void operator()(const AccT& acc, const pg8::Unit& u, int wr, int wc, int fr, int fq) const { if (u.kind == 0) e1(acc, u, wr, wc, fr, fq); else { e1.flush(fr, fq, false); e2(acc, u, wr, wc, fr, fq); } }
};
#ifndef MOE_GM
#define MOE_GM 4
#endif
struct MoeOrder {
    const LAS int* tb; int G, vcu;
    __device__ __forceinline__ bool next(int i, pg8::Unit& u) const {
        const int TM = tb[NE]; int Lx = i * G + vcu; if (Lx >= TM * 12) return false;
        const int kind = Lx >= TM * 8 ? 1 : 0, NT = kind ? 4 : 8; if (kind) Lx -= TM * 8;
        constexpr int GM = MOE_GM;
        const int grp = Lx / (GM * NT), rem = Lx - grp * GM * NT, gs = (TM - GM * grp) < GM ? (TM - GM * grp) : GM;
        const int pn = rem / gs, pm = GM * grp + (rem - pn * gs);
        int e = 0;
#pragma unroll 1
        for (int k = 1; k < NE; ++k) e += (tb[k] <= pm) ? 1 : 0;
        u.pm = pm; u.pn = pn; u.pb = e * NT + pn; u.ko = 0; u.kind = kind; return true;
    }
};
__device__ __forceinline__ void moe_tile_prefix(Frame& F, int l, LAS int* tb) {
    if (F.tid == 0) { int s = 0; for (int e = 0; e < NE; ++e) { tb[e] = s; s += ((int)__hip_atomic_load(F.ctl + CW_CNT + l * 64 + e, RLX_AGENT) + 255) >> 8; } tb[NE] = s; }
    __syncthreads();
}

constexpr int CONV_RUN = 9;
__device__ __forceinline__ void phase_norm_conv(Frame& F, KArgs A, int l) {
    unsigned char* ws = F.ws; int lane = F.lane; asm volatile("" : "+v"(lane));
    LAS float* cw = (LAS float*)(F.lds + RING_OFF);
    const float* cwg = A->in[I_CONVW] + (size_t)l * CONVK * 256;
    for (int i = F.wave * 64 + lane; i < 47 * 256; i += NWAVES * 64) { const int k = (i >> 8) - 8; cw[i] = (k >= 0 && k < CONVK) ? cwg[k * 256 + (i & 255)] : 0.f; }
    __syncthreads();
    const bf16* OATT = (const bf16*)(ws + WS_OATT); const float* U = (const float*)(ws + WS_U); bf16* Y = (bf16*)(ws + WS_Y);
    const f32x4 cb = *(const f32x4*)(A->in[I_CONVB] + l * 256 + 4 * lane), lg = *(const f32x4*)(A->in[I_CLNG] + l * 256 + 4 * lane), lb = *(const f32x4*)(A->in[I_CLNB] + l * 256 + 4 * lane);
    const int gw = F.vcu * NWAVES + F.wave, wpb = (F.G * NWAVES) / BATCH;
    const LAS f32x4* cwl = (const LAS f32x4*)(cw + 4 * lane);
    if (gw < wpb * BATCH) {
        const int b = gw / wpb, wi = gw - b * wpb, ps = (wi * L) / wpb, pe = ((wi + 1) * L) / wpb;
        const size_t rb = (size_t)b * L;
#pragma unroll 1
        for (int p0 = ps; p0 < pe; p0 += CONV_RUN) {
            const int n = (pe - p0) < CONV_RUN ? (pe - p0) : CONV_RUN;
            f32x4 acc[CONV_RUN];
#pragma unroll
            for (int i = 0; i < CONV_RUN; ++i) acc[i] = cb;
#pragma unroll 1
            for (int c = 0; c < 3; ++c) {
                f32x4 u[13];
#pragma unroll
                for (int jj = 0; jj < 13; ++jj) { const int j = -(CONVK - 1) + c * 13 + jj; int pr = p0 + j; const bool ok = pr >= 0; pr = pr < 0 ? 0 : (pr > L - 1 ? L - 1 : pr);
                    u[jj] = *(const f32x4*)(U + (rb + pr) * 256 + 4 * lane); if (!ok) u[jj] = (f32x4){0.f, 0.f, 0.f, 0.f}; }
                const LAS f32x4* wc = cwl + (c * 13) * 64;
#pragma unroll
                for (int jj = 0; jj < 13; ++jj)
#pragma unroll
                    for (int i = 0; i < CONV_RUN; ++i) acc[i] += u[jj] * wc[(jj - i + 8) * 64];
            }
#pragma unroll
            for (int i0 = 0; i0 < CONV_RUN; i0 += 3) {
                f32x4 o[3][3];
#pragma unroll
                for (int ii = 0; ii < 3; ++ii) { const int i = (i0 + ii) < n ? (i0 + ii) : 0;
#pragma unroll
                    for (int j = 0; j < 3; ++j) { const v2u w = *(const v2u*)(OATT + (rb + p0 + i) * 768 + 4 * lane + 256 * j); o[ii][j] = (f32x4){bflo(w.x), bfhi(w.x), bflo(w.y), bfhi(w.y)}; } }
#pragma unroll
                for (int ii = 0; ii < 3; ++ii) {
                    const int i = i0 + ii; const size_t r = rb + p0 + i;
                    f32x4 c = acc[i];
                    const float mu = wave_sum((c.x + c.y) + (c.z + c.w)) * (1.f / 256.f); c = c - mu;
                    const float var = wave_sum((c.x * c.x + c.y * c.y) + (c.z * c.z + c.w * c.w)) * (1.f / 256.f);
                    c = c * __builtin_amdgcn_rsqf(var + LN_EPS) * lg + lb;
#pragma unroll
                    for (int j = 0; j < 4; ++j) c[j] = c[j] * sigmoidf_(c[j]);
                    const float rc = __builtin_amdgcn_rsqf(wave_sum((c.x * c.x + c.y * c.y) + (c.z * c.z + c.w * c.w)) * (1.f / 256.f) + RMS_EPS);
                    const f32x4 o0 = o[ii][0], o1 = o[ii][1], o2 = o[ii][2];
                    const float s0 = wave_sum((o0.x * o0.x + o0.y * o0.y) + (o0.z * o0.z + o0.w * o0.w));
                    const float s1 = wave_sum(((o1.x * o1.x + o1.y * o1.y) + (o1.z * o1.z + o1.w * o1.w)) + ((o2.x * o2.x + o2.y * o2.y) + (o2.z * o2.z + o2.w * o2.w)));
                    const float r0s = __builtin_amdgcn_rsqf(s0 * (1.f / 256.f) + RMS_EPS), r1s = __builtin_amdgcn_rsqf(s1 * (1.f / 512.f) + RMS_EPS);
                    if (i < n) {
                        *(v2u*)(Y + r * D + 768 + 4 * lane) = pk4(c * rc);
                        *(v2u*)(Y + r * D + 4 * lane) = pk4(o0 * r0s);
                        *(v2u*)(Y + r * D + 256 + 4 * lane) = pk4(o1 * r1s);
                        *(v2u*)(Y + r * D + 512 + 4 * lane) = pk4(o2 * r1s);
                    }
                }
            }
        }
    }
    __syncthreads();
}

#ifndef RT_ROWS
#define RT_ROWS 4
#endif
__device__ __forceinline__ void phase_router(Frame& F, KArgs A, int l, bool dry = false) {
    typedef __attribute__((ext_vector_type(16))) float f32x16;
    unsigned char* ws = F.ws; int tid = F.tid; asm volatile("" : "+v"(tid)); const int lane = tid & 63, wave = F.wave;
    LAS float* PART = (LAS float*)(F.lds + RING_OFF);
    LAS int* lcnt = (LAS int*)(F.lds + TAIL_OFF); LAS int* lbase = lcnt + 32; LAS int* sel = lbase + 32;
    if (tid < 32) lcnt[tid] = 0;
    const int start = (int)(((long)F.vcu * T) / F.G), end = (int)(((long)(F.vcu + 1) * T) / F.G);
    const float* Z = (const float*)(ws + WS_Z); bf16* HL = (bf16*)(ws + WS_HL); bf16* HB = (bf16*)(ws + WS_HB);
    int* TOKE = (int*)(ws + WS_TOKE); int* TOKP = (int*)(ws + WS_TOKP); float* TOKG = (float*)(ws + WS_TOKG); int* LIST = (int*)(ws + WS_LIST);
    const float* lng = A->in[I_LNMIX_G] + l * D; const float* lnb = A->in[I_LNMIX_B] + l * D;
#pragma unroll 1
    for (int t0 = start + wave; t0 < end; t0 += RT_ROWS * NWAVES) {
        f32x4 v[RT_ROWS][4];
#pragma unroll
        for (int s = 0; s < RT_ROWS; ++s) { const int t = (t0 + s * NWAVES) < end ? (t0 + s * NWAVES) : t0;
#pragma unroll
            for (int j = 0; j < 4; ++j) v[s][j] = *(const f32x4*)(Z + (size_t)t * D + 4 * lane + 256 * j); }
#pragma unroll
        for (int s = 0; s < RT_ROWS; ++s) { ln_row16(v[s], lng, lnb, lane); const int t = t0 + s * NWAVES;
            if (t < end) {
#pragma unroll
                for (int j = 0; j < 4; ++j) { const v2u hw = (v2u){pk2(v[s][j].x, v[s][j].y), pk2(v[s][j].z, v[s][j].w)};
                    *(v2u*)(HB + (size_t)t * D + 4 * lane + 256 * j) = hw;
                    *(v2u*)(HL + (size_t)t * D + 4 * lane + 256 * j) = (v2u){pk2(v[s][j].x - bflo(hw.x), v[s][j].y - bfhi(hw.x)), pk2(v[s][j].z - bflo(hw.y), v[s][j].w - bfhi(hw.y))}; } } }
    }
    asm volatile("s_waitcnt vmcnt(0)" ::: "memory");
    __syncthreads();
    const bf16* rwh = (const bf16*)(ws + WS_RWT) + (size_t)l * 2 * NE * D; const bf16* rwl = rwh + NE * D;
    const int r32 = lane & 31, hi = lane >> 5;
#pragma unroll 1
    for (int g0 = start; g0 < end; g0 += 96) {
        const int ng = (end - g0) < 96 ? (end - g0) : 96;
        f32x16 acc[3]; acc[0] = f32x16{}; acc[1] = f32x16{}; acc[2] = f32x16{};
        int tok[3];
#pragma unroll
        for (int g = 0; g < 3; ++g) tok[g] = g0 + ((32 * g + r32) < ng ? (32 * g + r32) : 0);
#pragma unroll 2
        for (int ks = 0; ks < 8; ++ks) {
            const int kk = 128 * wave + 16 * ks + 8 * hi;
            const bf16x8 bh = *(const bf16x8*)(rwh + (size_t)r32 * D + kk), bl = *(const bf16x8*)(rwl + (size_t)r32 * D + kk);
#pragma unroll
            for (int g = 0; g < 3; ++g) {
                const v4u aw = *(const v4u*)(HB + (size_t)tok[g] * D + kk), lw = *(const v4u*)(HL + (size_t)tok[g] * D + kk);
                const bf16x8 ah = __builtin_bit_cast(bf16x8, aw), al = __builtin_bit_cast(bf16x8, lw);
                acc[g] = __builtin_amdgcn_mfma_f32_32x32x16_bf16(ah, bh, acc[g], 0, 0, 0);
                acc[g] = __builtin_amdgcn_mfma_f32_32x32x16_bf16(ah, bl, acc[g], 0, 0, 0);
                acc[g] = __builtin_amdgcn_mfma_f32_32x32x16_bf16(al, bh, acc[g], 0, 0, 0);
            }
        }
#pragma unroll
        for (int g = 0; g < 3; ++g)
#pragma unroll
            for (int r = 0; r < 16; ++r) PART[(wave * 96 + 32 * g + (r & 3) + 8 * (r >> 2) + 4 * hi) * 33 + r32] = acc[g][r];
        __syncthreads();
        if (tid < ng) {
            const int t = g0 + tid; float v[32];
#pragma unroll
            for (int e = 0; e < 32; ++e) { float s = A->in[I_RB][l * NE + e];
#pragma unroll
                for (int w = 0; w < 8; ++w) s += PART[(w * 96 + tid) * 33 + e];
                v[e] = s; }
            float tv[4]; int ti[4];
#pragma unroll
            for (int k = 0; k < 4; ++k) {
                float bv = -INFINITY; int bi = 0;
#pragma unroll
                for (int e = 0; e < 32; ++e) if (v[e] > bv) { bv = v[e]; bi = e; }
                tv[k] = bv; ti[k] = bi;
#pragma unroll
                for (int e = 0; e < 32; ++e) if (e == bi) v[e] = -INFINITY;
            }
            float ex[4], sum = 0.f;
#pragma unroll
            for (int k = 0; k < 4; ++k) { ex[k] = __expf(tv[k] - tv[0]); sum += ex[k]; }
            const float inv = 1.0f / sum;
            *(v4u*)(TOKE + t * 4) = (v4u){(unsigned)ti[0], (unsigned)ti[1], (unsigned)ti[2], (unsigned)ti[3]};
            *(f32x4*)(TOKG + t * 4) = (f32x4){ex[0] * inv, ex[1] * inv, ex[2] * inv, ex[3] * inv};
#pragma unroll
            for (int k = 0; k < 4; ++k) { const int rank = __hip_atomic_fetch_add(lcnt + ti[k], 1, __ATOMIC_RELAXED, __HIP_MEMORY_SCOPE_WORKGROUP);
                sel[((t - start) * 4 + k) * 2] = ti[k]; sel[((t - start) * 4 + k) * 2 + 1] = rank; }
        }
        __syncthreads();
    }
    if (tid < 32) lbase[tid] = (int)__hip_atomic_fetch_add(F.ctl + CW_CNT + (dry ? 128 : 0) + l * 64 + tid, (unsigned)lcnt[tid], RLX_AGENT);
    __syncthreads();
    if (!dry) for (int i = tid; i < (end - start) * 4; i += NWAVES * 64) { const int e = sel[i * 2], pos = lbase[e] + sel[i * 2 + 1]; TOKP[(start + (i >> 2)) * 4 + (i & 3)] = pos; LIST[(size_t)e * T + pos] = start + (i >> 2); }
    __syncthreads();
}

__device__ __forceinline__ void phase_combine(Frame& F, KArgs A, int l, bool dry = false) {
    unsigned char* ws = F.ws; int lane = F.lane; asm volatile("" : "+v"(lane));
    bf16* HB = (bf16*)(ws + WS_HB); const bf16* YS = (const bf16*)(ws + WS_YS);
    const int* TOKE = (const int*)(ws + WS_TOKE); const int* TOKP = (const int*)(ws + WS_TOKP); const float* TOKG = (const float*)(ws + WS_TOKG);
    int tiles = 0; if (lane < NE) tiles = ((int)__hip_atomic_load(F.ctl + CW_CNT + l * 64 + lane, RLX_AGENT) + 255) >> 8;
    int incl = tiles;
#pragma unroll
    for (int o = 1; o < 32; o <<= 1) { const int v = __shfl_up(incl, o); if (lane >= o) incl += v; }
    const int tbl = incl - tiles;
    const float* lng = A->in[I_LNFFN_G] + l * D; const float* lnb = A->in[I_LNFFN_B] + l * D;
    f32x4 gg[4], bb[4];
#pragma unroll
    for (int q = 0; q < 4; ++q) { const int c = 8 * lane + 512 * (q >> 1) + 4 * (q & 1); gg[q] = *(const f32x4*)(lng + c); bb[q] = *(const f32x4*)(lnb + c); }
    const int gw = F.vcu * NWAVES + F.wave, NGW = F.G * NWAVES;
#pragma unroll 1
    for (int t0 = gw; t0 < T; t0 += 2 * NGW) {
        int tt[2]; tt[0] = t0; tt[1] = (t0 + NGW) < T ? (t0 + NGW) : t0; const bool ok1 = (t0 + NGW) < T;
        f32x4 v[2][4]; v4u y[2][4][2]; float g[2][4];
#pragma unroll
        for (int s = 0; s < 2; ++s) {
            const int t = tt[s];
            const v4u e4 = *(const v4u*)(TOKE + t * 4), p4 = *(const v4u*)(TOKP + t * 4); const f32x4 g4 = *(const f32x4*)(TOKG + t * 4);
#pragma unroll
            for (int jj = 0; jj < 2; ++jj) { const v4u hw = *(const v4u*)(HB + (size_t)t * D + 8 * lane + 512 * jj); v[s][2 * jj] = (f32x4){bflo(hw.x), bfhi(hw.x), bflo(hw.y), bfhi(hw.y)}; v[s][2 * jj + 1] = (f32x4){bflo(hw.z), bfhi(hw.z), bflo(hw.w), bfhi(hw.w)}; }
#pragma unroll
            for (int k = 0; k < 4; ++k) { const size_t row = (size_t)__shfl(tbl, (int)e4[k]) * 256 + p4[k]; g[s][k] = g4[k];
#pragma unroll
                for (int jj = 0; jj < 2; ++jj) y[s][k][jj] = *(const v4u*)(YS + row * D + 8 * lane + 512 * jj); }
        }
#pragma unroll
        for (int s = 0; s < 2; ++s) {
#pragma unroll
            for (int q = 0; q < 4; ++q) v[s][q] = v[s][q] * ALPHA;
#pragma unroll
            for (int k = 0; k < 4; ++k)
#pragma unroll
                for (int jj = 0; jj < 2; ++jj) { const v4u w = y[s][k][jj]; const float gk = g[s][k];
                    v[s][2 * jj] += (f32x4){bflo(w.x), bfhi(w.x), bflo(w.y), bfhi(w.y)} * gk; v[s][2 * jj + 1] += (f32x4){bflo(w.z), bfhi(w.z), bflo(w.w), bfhi(w.w)} * gk; }
            float sm = 0.f;
#pragma unroll
            for (int q = 0; q < 4; ++q) sm += (v[s][q].x + v[s][q].y) + (v[s][q].z + v[s][q].w);
            const float mean = wave_sum(sm) * (1.f / D); float s2 = 0.f;
#pragma unroll
            for (int q = 0; q < 4; ++q) { v[s][q] = v[s][q] - mean; s2 += (v[s][q].x * v[s][q].x + v[s][q].y * v[s][q].y) + (v[s][q].z * v[s][q].z + v[s][q].w * v[s][q].w); }
            const float rstd = __builtin_amdgcn_rsqf(wave_sum(s2) * (1.f / D) + LN_EPS);
#pragma unroll
            for (int q = 0; q < 4; ++q) v[s][q] = v[s][q] * rstd * gg[q] + bb[q];
            if (s == 0 || ok1) {
                const int t = tt[s];
                if (dry) { bf16* ob = (bf16*)(ws + WS_Z) + (size_t)t * D + 8 * lane;
#pragma unroll
                    for (int jj = 0; jj < 2; ++jj) *(v4u*)(ob + 512 * jj) = (v4u){pk2(v[s][2 * jj].x, v[s][2 * jj].y), pk2(v[s][2 * jj].z, v[s][2 * jj].w), pk2(v[s][2 * jj + 1].x, v[s][2 * jj + 1].y), pk2(v[s][2 * jj + 1].z, v[s][2 * jj + 1].w)};
                } else if (l == DEPTH - 1) {
                    const int bi = t / L, pp = t - bi * L;
                    if (pp >= NMETA) { float* o = F.out + ((size_t)bi * SEQ + (pp - NMETA)) * D + 8 * lane;
#pragma unroll
                        for (int q = 0; q < 4; ++q) *(f32x4*)(o + 512 * (q >> 1) + 4 * (q & 1)) = v[s][q]; }
                } else {
                    bf16* ob = HB + (size_t)t * D + 8 * lane;
#pragma unroll
                    for (int jj = 0; jj < 2; ++jj) *(v4u*)(ob + 512 * jj) = (v4u){pk2(v[s][2 * jj].x, v[s][2 * jj].y), pk2(v[s][2 * jj].z, v[s][2 * jj].w), pk2(v[s][2 * jj + 1].x, v[s][2 * jj + 1].y), pk2(v[s][2 * jj + 1].z, v[s][2 * jj + 1].w)};
                }
            }
        }
    }
}
}
namespace att {
using namespace mk;
typedef __attribute__((ext_vector_type(4))) short s16x4;
typedef __attribute__((ext_vector_type(16))) float f32x16;
typedef short v4i16_t __attribute__((ext_vector_type(4)));
typedef LAS const char* lds_cptr;
constexpr int KSLOT = 12288, VSLOT = 8192;
constexpr int NSLOT = 3;
constexpr int A_K = 0, A_V = NSLOT * KSLOT, A_WS = A_V + NSLOT * VSLOT, A_Q = A_WS + NWAVES * 256, A_BYTES = A_Q + 64;
constexpr float NEGBIG = -1.0e30f;
__device__ __forceinline__ int crow(int r, int hi) { return (r & 3) + 8 * (r >> 2) + 4 * hi; }
__device__ __forceinline__ void glds16(const void* gsrc, unsigned lds_dst) { unsigned keep;
    asm volatile("s_mov_b32 %0, m0\n\ts_mov_b32 m0, %2\n\ts_nop 0\n\tglobal_load_lds_dwordx4 %1, off\n\ts_mov_b32 m0, %0" : "=&s"(keep) : "v"(gsrc), "s"(lds_dst) : "memory"); }
__device__ __forceinline__ s16x4 vtr(lds_cptr p) { return __builtin_bit_cast(s16x4, __builtin_amdgcn_ds_read_tr16_b64_v4i16((LAS v4i16_t*)p)); }
__device__ __forceinline__ unsigned cvtpk(float lo, float hi) { typedef float f2 __attribute__((ext_vector_type(2))); typedef __bf16 b2 __attribute__((ext_vector_type(2))); f2 v = {lo, hi}; b2 b = __builtin_convertvector(v, b2); return __builtin_bit_cast(unsigned, b); }
__device__ __forceinline__ float max3f(float a, float b, float c) { float r; asm("v_max3_f32 %0, %1, %2, %3" : "=v"(r) : "v"(a), "v"(b), "v"(c)); return r; }
__device__ __forceinline__ float min2f(float a, float b) { float r; asm("v_min_f32_e32 %0, %1, %2" : "=v"(r) : "v"(a), "v"(b)); return r; }
#define ATT_WAIT_BAR(N) asm volatile("s_waitcnt vmcnt(" #N ") lgkmcnt(0)\n\ts_barrier" ::: "memory")

template <int MODE>
__device__ __forceinline__ void attn_unit(int b, int h, int qb  , const bf16* Q, const bf16* Kg, const bf16* Vg, bf16* OATT, char* shm) {
    constexpr int DQK = MODE == 0 ? 64 : 96, NKS = DQK / 16, NCH = DQK / 8;
    constexpr int QP = MODE == 0 ? 256 : 768, VP = MODE == 0 ? 256 : 512;
    int tid = threadIdx.x; asm volatile("" : "+v"(tid));
    const int lane = tid & 63, r32 = lane & 31, hi = lane >> 5; const int wid = __builtin_amdgcn_readfirstlane(tid >> 6);
    const int q0 = qb < 0 ? 0 : 64 + 256 * qb;
    const int NT = qb < 0 ? 1 : 4 * qb + 5;
    const size_t rowbase = (size_t)b * LP;
    const bf16* Qw = Q + (rowbase + q0 + wid * 32) * QP + h * DQK;
    const bf16* Kh = Kg + rowbase * QP + h * DQK; const bf16* Vh = Vg + rowbase * VP + h * 64;
    const unsigned lds0 = (unsigned)(uintptr_t)shm;
    LAS float* wsf = (LAS float*)(shm + A_WS) + wid * 64;
    const bf16* ksrc0 = Kh + (size_t)lane * QP + wid * 8; const bf16* ksrc1 = ksrc0 + 64;
    const bf16* vsrc = Vh + (size_t)(16 * (wid & 3) + (lane >> 2)) * VP + (wid >> 2) * 32 + (lane & 3) * 8;
    const unsigned kdst = lds0 + A_K + wid * 1024, vdst = lds0 + A_V + wid * 1024;
#define DMA_TILE(t, slot) do { glds16(ksrc0 + (size_t)(t) * 64 * QP, (unsigned)__builtin_amdgcn_readfirstlane(kdst + (slot) * KSLOT)); \
        if (NCH > 8 && wid < NCH - 8) glds16(ksrc1 + (size_t)(t) * 64 * QP, (unsigned)__builtin_amdgcn_readfirstlane(kdst + (slot) * KSLOT + 8192)); \
        glds16(vsrc + (size_t)(t) * 64 * VP, (unsigned)__builtin_amdgcn_readfirstlane(vdst + (slot) * VSLOT)); } while (0)
    const lds_cptr shm3 = (lds_cptr)shm;
    const lds_cptr kp0 = shm3 + A_K + hi * 1024 + r32 * 16;
    const lds_cptr vp0 = shm3 + A_V + ((lane >> 4) & 1) * 32 + (lane & 3) * 8 + (4 * hi + ((lane & 15) >> 2)) * 64;
    bf16x8 qr[NKS];
#pragma unroll
    for (int d0 = 0; d0 < NKS; ++d0) qr[d0] = *(const bf16x8*)(Qw + (size_t)r32 * QP + d0 * 16 + hi * 8);
    DMA_TILE(NT - 1, 0);
    if (NT > 1) DMA_TILE(NT - 2, 1);
#pragma unroll
    for (int d0 = 0; d0 < NKS; ++d0) asm volatile("" : "+v"(qr[d0]));
    const bool npt3 = (MODE == 1) && (wid < NCH - 8);
    f32x16 o[2]; o[0] = f32x16{}; o[1] = f32x16{};
    float mrun = NEGBIG, lrun = MODE == 0 ? 1.0f : 0.f;
    const int qpos = q0 + wid * 32 + r32;
    bf16x8 kf[2 * NKS];
#define LOAD_KF(slot_) do { const lds_cptr kb_ = kp0 + (slot_) * KSLOT; _Pragma("unroll") for (int d0 = 0; d0 < NKS; ++d0) { kf[2 * d0] = *(const LAS bf16x8*)(kb_ + d0 * 2048); kf[2 * d0 + 1] = *(const LAS bf16x8*)(kb_ + d0 * 2048 + 512); } } while (0)
    if (NT > 1) { if (npt3) ATT_WAIT_BAR(3); else ATT_WAIT_BAR(2); } else ATT_WAIT_BAR(0);
    LOAD_KF(0);
    int cur = 0, nx1 = 1, nx2 = 2;
    for (int i = 0; i < NT; ++i) {
        const int t = NT - 1 - i;
        ATT_WAIT_BAR(0);
        if (i + 2 < NT) DMA_TILE(t - 2, nx2);
        const int slot = cur, slot1 = nx1; cur = nx1; nx1 = nx2; nx2 = nx2 == NSLOT - 1 ? 0 : nx2 + 1;
        const bool band = (64 * t + 63 >= q0);
        const bool skip = band && (64 * t > q0 + wid * 32 + 31 - (MODE == 0 ? 1 : 0));
        if (skip) { if (i + 1 < NT) LOAD_KF(slot1); continue; }
        f32x16 p0 = f32x16{}, p1 = f32x16{};
#pragma unroll
        for (int d0 = 0; d0 < NKS; ++d0) { p0 = __builtin_amdgcn_mfma_f32_32x32x16_bf16(kf[2 * d0], qr[d0], p0, 0, 0, 0); p1 = __builtin_amdgcn_mfma_f32_32x32x16_bf16(kf[2 * d0 + 1], qr[d0], p1, 0, 0, 0); }
        const lds_cptr vp = vp0 + slot * VSLOT; s16x4 vlo[4], vhh[4];
#pragma unroll
        for (int ks = 0; ks < 4; ++ks) { vlo[ks] = vtr(vp + ks * 1024); vhh[ks] = vtr(vp + ks * 1024 + 512); }
        __builtin_amdgcn_sched_barrier(0);
        if (band || t == 0) {
            const int kb0 = 64 * t + 4 * hi;
#pragma unroll
            for (int r = 0; r < 16; ++r) { const int kv = kb0 + (r & 3) + 8 * (r >> 2);
                const bool m0 = (MODE == 0 ? kv >= qpos : kv > qpos) || kv < PADF, m1 = (MODE == 0 ? kv + 32 >= qpos : kv + 32 > qpos) || (kv + 32) < PADF;
                if (m0) p0[r] = NEGBIG; if (m1) p1[r] = NEGBIG; }
        }
        if (MODE == 1) {
            float rm = max3f(p0[0], p1[0], p0[1]), rm2 = max3f(p1[1], p0[2], p1[2]);
#pragma unroll
            for (int r = 3; r < 15; r += 2) { rm = max3f(rm, p0[r], p1[r]); rm2 = max3f(rm2, p0[r + 1], p1[r + 1]); }
            rm = max3f(rm, p0[15], p1[15]); rm = max3f(rm, rm2, rm2);
            { auto rr = __builtin_amdgcn_permlane32_swap(__float_as_uint(rm), __float_as_uint(rm), false, false); rm = fmaxf(__uint_as_float(rr[0]), __uint_as_float(rr[1])); }
            if (__any(rm > mrun + 8.0f)) {
                const float mn = fmaxf(mrun, rm), f = __builtin_amdgcn_exp2f(mrun - mn); mrun = mn; lrun *= f;
                if (hi == 0) wsf[r32] = f;
                LDS_WAIT();
#pragma unroll
                for (int r = 0; r < 16; ++r) { const float fr_ = wsf[crow(r, hi)]; o[0][r] *= fr_; o[1][r] *= fr_; }
            }
            float sacc = 0.f;
#pragma unroll
            for (int r = 0; r < 16; ++r) { p0[r] = __builtin_amdgcn_exp2f(p0[r] - mrun); p1[r] = __builtin_amdgcn_exp2f(p1[r] - mrun); sacc += p0[r] + p1[r]; }
            lrun += sacc;
        } else {
            f32x16 a0, a1;
#pragma unroll
            for (int r = 0; r < 16; ++r) { p0[r] = __builtin_amdgcn_exp2f(min2f(p0[r], 80.0f)); p1[r] = __builtin_amdgcn_exp2f(min2f(p1[r], 80.0f));
                a0[r] = __builtin_amdgcn_rcpf(1.0f + p0[r]); a1[r] = __builtin_amdgcn_rcpf(1.0f + p1[r]); }
            float seg[16];
#pragma unroll
            for (int k = 0; k < 4; ++k) {
                const float s0 = (a0[4 * k] * a0[4 * k + 1]) * (a0[4 * k + 2] * a0[4 * k + 3]), s1 = (a1[4 * k] * a1[4 * k + 1]) * (a1[4 * k + 2] * a1[4 * k + 3]);
                auto r0 = __builtin_amdgcn_permlane32_swap(__float_as_uint(s0), __float_as_uint(s0), false, false);
                auto r1 = __builtin_amdgcn_permlane32_swap(__float_as_uint(s1), __float_as_uint(s1), false, false);
                seg[2 * k] = __uint_as_float(r0[0]); seg[2 * k + 1] = __uint_as_float(r0[1]); seg[8 + 2 * k] = __uint_as_float(r1[0]); seg[8 + 2 * k + 1] = __uint_as_float(r1[1]);
            }
            float run = lrun; float sfx[16];
#pragma unroll
            for (int g = 15; g >= 0; --g) { sfx[g] = run; run *= seg[g]; }
            lrun = run;
#pragma unroll
            for (int k = 0; k < 4; ++k) {
                float c0 = hi ? sfx[2 * k + 1] : sfx[2 * k], c1 = hi ? sfx[8 + 2 * k + 1] : sfx[8 + 2 * k];
#pragma unroll
                for (int j = 3; j >= 0; --j) { c0 *= a0[4 * k + j]; p0[4 * k + j] *= c0; c1 *= a1[4 * k + j]; p1[4 * k + j] *= c1; }
            }
        }
        v4u pw[4];
        pw[0] = (v4u){cvtpk(p0[0], p0[1]), cvtpk(p0[2], p0[3]), cvtpk(p0[4], p0[5]), cvtpk(p0[6], p0[7])};
        pw[1] = (v4u){cvtpk(p0[8], p0[9]), cvtpk(p0[10], p0[11]), cvtpk(p0[12], p0[13]), cvtpk(p0[14], p0[15])};
        pw[2] = (v4u){cvtpk(p1[0], p1[1]), cvtpk(p1[2], p1[3]), cvtpk(p1[4], p1[5]), cvtpk(p1[6], p1[7])};
        pw[3] = (v4u){cvtpk(p1[8], p1[9]), cvtpk(p1[10], p1[11]), cvtpk(p1[12], p1[13]), cvtpk(p1[14], p1[15])};
        __builtin_amdgcn_sched_barrier(0);
        s16x4 wlo[4], whh[4];
#pragma unroll
        for (int ks = 0; ks < 4; ++ks) { wlo[ks] = vtr(vp + 4096 + ks * 1024); whh[ks] = vtr(vp + 4096 + ks * 1024 + 512); }
#pragma unroll
        for (int ks = 0; ks < 4; ++ks) { const bf16x8 vf = (bf16x8){vlo[ks][0], vlo[ks][1], vlo[ks][2], vlo[ks][3], vhh[ks][0], vhh[ks][1], vhh[ks][2], vhh[ks][3]};
            o[0] = __builtin_amdgcn_mfma_f32_32x32x16_bf16(__builtin_bit_cast(bf16x8, pw[ks]), vf, o[0], 0, 0, 0); }
        __builtin_amdgcn_sched_barrier(0);
        if (i + 1 < NT) LOAD_KF(slot1);
#pragma unroll
        for (int ks = 0; ks < 4; ++ks) { const bf16x8 vf = (bf16x8){wlo[ks][0], wlo[ks][1], wlo[ks][2], wlo[ks][3], whh[ks][0], whh[ks][1], whh[ks][2], whh[ks][3]};
            o[1] = __builtin_amdgcn_mfma_f32_32x32x16_bf16(__builtin_bit_cast(bf16x8, pw[ks]), vf, o[1], 0, 0, 0); }
    }
#undef LOAD_KF
    if (MODE == 1) {
        { auto rr = __builtin_amdgcn_permlane32_swap(__float_as_uint(lrun), __float_as_uint(lrun), false, false); lrun = __uint_as_float(rr[0]) + __uint_as_float(rr[1]); }
        if (hi == 0) wsf[32 + r32] = lrun;
        LDS_WAIT();
    }
    bf16* Ow = OATT + (size_t)(MODE == 0 ? 0 : 256) + h * 64 + r32;
#pragma unroll
    for (int r = 0; r < 16; ++r) {
        const int pp = q0 + wid * 32 + crow(r, hi);
        const float sc = MODE == 1 ? __builtin_amdgcn_rcpf(wsf[32 + crow(r, hi)]) : 1.0f;
        const bool valid = qb < 0 ? (pp >= PADF && pp < 64) : true;
        if (valid) { bf16* dst = Ow + ((size_t)b * L + (pp - PADF)) * 768; dst[0] = (bf16)f2bf(o[0][r] * sc); dst[32] = (bf16)f2bf(o[1][r] * sc); }
    }
    asm volatile("s_waitcnt lgkmcnt(0)\n\ts_barrier" ::: "memory");
#undef DMA_TILE
}

#ifndef MK_CONV_PER_UNIT
#define MK_CONV_PER_UNIT 2
#endif
__device__ __forceinline__ void attn_phase(Frame& F, KArgs A, int l, int qi  , char* shm) {
    unsigned char* ws = F.ws;
    LAS int* qw = (LAS int*)((LAS char*)F.lds + A_Q);
    bf16* OATT = (bf16*)(ws + WS_OATT);
    LAS float* scr = (LAS float*)(F.lds + RING_OFF + F.wave * 8448);
    bool conv_left = true;
    for (;;) {
        if (F.tid == 0) *qw = (int)__hip_atomic_fetch_add(F.ctl + CW_AQ + qi * 64, 1u, RLX_AGENT);
        __syncthreads();
        const int u = __builtin_amdgcn_readfirstlane(*qw);
        const bool have = u < 9 * 96;
        if (have) {
            const int level = u / 96, w = u - level * 96, qb = 7 - level;
            if (w < 64) attn_unit<1>(w >> 3, w & 7, qb, (const bf16*)(ws + WS_QM), (const bf16*)(ws + WS_KM), (const bf16*)(ws + WS_VM), OATT, shm);
            else attn_unit<0>((w - 64) >> 2, (w - 64) & 3, qb, (const bf16*)(ws + WS_SBQ), (const bf16*)(ws + WS_SBK), (const bf16*)(ws + WS_SBV), OATT, shm);
        }
        for (int c = 0; conv_left && c < MK_CONV_PER_UNIT; ++c) {
            __syncthreads();
            if (F.tid == 0) *qw = (int)__hip_atomic_fetch_add(F.ctl + CW_CONV + l * 8, 1u, RLX_AGENT);
            __syncthreads();
            const int ch = __builtin_amdgcn_readfirstlane(*qw);
            if (ch >= CONV_NCHUNK) { conv_left = false; break; }
            conv_chunk(F, A, l, ch, scr);
        }
        __syncthreads();
        if (!have && !conv_left) break;
    }
    __syncthreads();
}
}
namespace mk {
constexpr int PH_PER_LAYER = 9, N_PHASES = 1 + DEPTH * PH_PER_LAYER;

__global__ void __launch_bounds__(NWAVES * 64, 2) mega_fwd(Args args) {
    extern __shared__ __attribute__((aligned(16))) unsigned char lds[];
    Frame F;
    F.lds = (LAS unsigned char*)lds;
    F.MISC = (volatile LAS unsigned*)(F.lds + MISC_OFF);
    F.tid = threadIdx.x; F.lane = F.tid & 63; F.wave = __builtin_amdgcn_readfirstlane(F.tid >> 6);
    F.G = gridDim.x; { const int bx = blockIdx.x; F.vcu = (F.G % 8 == 0) ? (bx % 8) * (F.G / 8) + bx / 8 : bx; }
    F.ws = args.ws; F.ctl = (gu32*)(args.ws + WS_CTL); F.out = args.out;
    unsigned char* ws = args.ws;
    for (int u = F.tid; u < (TAIL_OFF - LDSCTL_OFF) / 4; u += NWAVES * 64) ((LAS unsigned*)(F.lds + LDSCTL_OFF))[u] = 0u;
    __syncthreads();
    const int lo = args.ph_lo, hi = args.ph_hi;
    const bool use_bar = (hi - lo) > 1;
    XcdBarrier bar; bar.bar = (unsigned*)(F.ctl + CW_BAR); bar.x = 0; bar.st = nullptr;
    if (use_bar) bar = xcd_barrier_post((unsigned*)(F.ctl + CW_BAR), F.MISC + 8);
#ifndef MK_PT_MASK
#define MK_PT_MASK 0x3ff
#endif
#define IN(k) (lo <= (k) && (k) < hi)
#define PT(b) ((MK_PT_MASK >> (b)) & 1)
#ifndef MK_REP
#define MK_REP 0
#endif
#define REPS(b) (1 + ((MK_REP >> (b)) & 1))
#define SEAM(k) do { if (IN(k) && IN((k) + 1)) xcd_barrier(bar); } while (0)

    if (PT(0) && IN(0)) { _Pragma("unroll") for (int rep = 0; rep < REPS(0); ++rep) p0_prologue(F, kargs()); SEAM(0); }
#pragma unroll 1
    for (int l = 0; l < DEPTH; ++l) {
        const int pb = 1 + l * PH_PER_LAYER;
        const f32x2* ROPE = (const f32x2*)(ws + WS_ROPE);
        if (PT(1) && IN(pb + 0)) _Pragma("unroll") for (int rep = 0; rep < REPS(1); ++rep) {
            pg8::Gemm g{(const bf16*)(ws + WS_HB), (const bf16*)(ws + WS_WIN) + (size_t)l * NINP * D, TP, NINP, D};
            pg8::StaticOrder S; S.init(TP, NINP, F.G, (int)blockIdx.x);
            EpiInProj E{(bf16*)(ws + WS_SBQ), (bf16*)(ws + WS_SBK), (bf16*)(ws + WS_SBV), (bf16*)(ws + WS_CQ), (bf16*)(ws + WS_CKV2), (bf16*)(ws + WS_KM), (float*)(ws + WS_U), (float*)(ws + WS_STQ), (float*)(ws + WS_STKV), ROPE};
            { const pg8::ListOrder LO = pg8::make_list(S, (LAS int*)(F.lds + TAIL_OFF + 14336), nullptr); pg8::gemm_phase<EpiInProj, pg8::ListOrder, true, false>(F.lds + RING_OFF, g, LO, E); }
            SEAM(pb + 0);
        }
        if (PT(2) && IN(pb + 1)) _Pragma("unroll") for (int rep = 0; rep < REPS(2); ++rep) {
            { pg8::Gemm g{(const bf16*)(ws + WS_CQ), (const bf16*)(ws + WS_WUQ) + (size_t)l * 768 * 256, TP, 768, 256, 0, (const bf16*)(ws + WS_CKV2), (const bf16*)(ws + WS_WUKV2) + (size_t)l * 1024 * 256};
              MlaOrder S; S.sq.init(TP, 768, 1, 0); S.sk.init(TP, 1024, 1, 0); S.G = F.G; S.c = (int)blockIdx.x;
              EpiMla E{EpiMlaQ{(bf16*)(ws + WS_QM), (const float*)(ws + WS_STQ), ROPE}, EpiMlaKV{(bf16*)(ws + WS_KM), (bf16*)(ws + WS_VM), (const float*)(ws + WS_STKV)}};
              const pg8::ListOrder LO = pg8::make_list(S, (LAS int*)(F.lds + TAIL_OFF + 14336), nullptr);
              pg8::gemm_phase<EpiMla, pg8::ListOrder, true, false>(F.lds + RING_OFF, g, LO, E); }
            SEAM(pb + 1);
        }
        if (PT(3) && IN(pb + 2)) _Pragma("unroll") for (int rep = 0; rep < REPS(3); ++rep) { att::attn_phase(F, kargs(), l, l * 4 + rep, (char*)lds + RING_OFF); SEAM(pb + 2); }
        if (PT(4) && IN(pb + 3)) _Pragma("unroll") for (int rep = 0; rep < REPS(4); ++rep) { phase_norm_conv(F, kargs(), l); SEAM(pb + 3); }
        if (PT(5) && IN(pb + 4)) _Pragma("unroll") for (int rep = 0; rep < REPS(5); ++rep) {
            pg8::Gemm g{(const bf16*)(ws + WS_Y), (const bf16*)(ws + WS_WOUT) + (size_t)l * D * D, TP, D, D};
            pg8::StaticOrder S; S.init(64 * 256, D, F.G, (int)blockIdx.x);
            EpiOut E{(const bf16*)(ws + WS_HB), (float*)(ws + WS_Z)};
            { const pg8::ListOrder LO = pg8::make_list(S, (LAS int*)(F.lds + TAIL_OFF + 14336), nullptr); pg8::gemm_phase<EpiOut, pg8::ListOrder, true, false>(F.lds + RING_OFF, g, LO, E); }
            { pg8::Gemm gt{(const bf16*)(ws + WS_Y), (const bf16*)(ws + WS_WOUT) + (size_t)l * D * D, TP, D, 256, D};
              TailOrder ST{F.vcu}; EpiOutTail ET{(float*)(ws + WS_ZP)};
              pg8::gemm_phase<EpiOutTail, TailOrder, true, false>(F.lds + RING_OFF, gt, ST, ET);
              if ((F.vcu & 15) == 0) {
                  asm volatile("s_waitcnt vmcnt(0)" ::: "memory"); __syncthreads();
                  if (F.tid == 0) {
                      __builtin_amdgcn_fence(__ATOMIC_RELEASE, "agent"); asm volatile("s_waitcnt vmcnt(0)" ::: "memory");
                      unsigned* cw = (unsigned*)(F.ctl + CW_TAIL + l * 64); (void)xb_add(cw, 1u);
                      unsigned sp = 0; while (xb_ld(cw) < 16u * (unsigned)(rep + 1) && ++sp < (1u << 22)) __builtin_amdgcn_s_sleep(1);
                      __builtin_amdgcn_fence(__ATOMIC_ACQUIRE, "agent"); asm volatile("s_waitcnt vmcnt(0)" ::: "memory");
                  }
                  __syncthreads();
                  int tid_ = F.tid; asm volatile("" : "+v"(tid_));
                  const int row = (F.vcu >> 4) * 8 + (tid_ >> 6), c4 = (tid_ & 63) * 4; const float* ZP = (const float*)(ws + WS_ZP);
                  const bf16* hb = (const bf16*)(ws + WS_HB) + (size_t)(64 * 256 + row) * D; float* zr = (float*)(ws + WS_Z) + (size_t)(64 * 256 + row) * D;
#pragma unroll
                  for (int q = 0; q < 4; ++q) { const int c = c4 + 256 * q; const v2u hw = *(const v2u*)(hb + c); f32x4 a = (f32x4){bflo(hw.x), bfhi(hw.x), bflo(hw.y), bfhi(hw.y)} * ALPHA;
#pragma unroll
                      for (int k = 0; k < 4; ++k) a += *(const f32x4*)(ZP + ((size_t)k * 128 + row) * D + c);
                      *(f32x4*)(zr + c) = a; }
              } }
            SEAM(pb + 4);
        }
        if (PT(6) && IN(pb + 5)) { if (REPS(6) > 1) { phase_router(F, kargs(), l, true); SEAM(pb + 5); } phase_router(F, kargs(), l); SEAM(pb + 5); }
        if (PT(7) && IN(pb + 6)) _Pragma("unroll") for (int rep = 0; rep < REPS(7); ++rep) {
            LAS int* tb = (LAS int*)(F.lds + TAIL_OFF); LAS int* rows = tb + 64;
            moe_tile_prefix(F, l, tb);
            MoeOrder S{tb, F.G, F.vcu};
            { pg8::Unit u; const int* LIST = (const int*)(ws + WS_LIST); int tid_ = F.tid; asm volatile("" : "+v"(tid_));
              for (int i = 0; i < 13 && S.next(i, u) && u.kind == 0; ++i) {
                  const int e = u.pb / 8, mt = u.pm - tb[e], cnt = (int)__hip_atomic_load(F.ctl + CW_CNT + l * 64 + e, RLX_AGENT);
                  if (tid_ < 256) { const int idx = mt * 256 + tid_; rows[i * 256 + tid_] = idx < cnt ? LIST[(size_t)e * T + idx] : 0; }
              } }
            __syncthreads();
            pg8::Gemm g{(const bf16*)(ws + WS_HB), (const bf16*)(ws + WS_WGU) + (size_t)l * NE * 2 * FF * D, RP, 2 * FF, D, 0, (const bf16*)(ws + WS_ACT), (const bf16*)(ws + WS_WD) + (size_t)l * NE * D * FF};
            unsigned* rdy = (unsigned*)(F.ctl + CW_RDY + (l * 2 + rep) * 320 * 16);
            EpiMoe12 E{EpiMoe1{(bf16*)(ws + WS_ACT), (const float*)(ws + WS_BGU) + (size_t)l * NE * 2 * FF, rdy}, EpiMoe2{(bf16*)(ws + WS_YS), kargs()->in[I_BD] + (size_t)l * NE * D}};
            { pg8::ListOrder LO = pg8::make_list(S, (LAS int*)(F.lds + TAIL_OFF + 14336), rows); LO.rdy = rdy; LO.need = 64u;
              pg8::gemm_phase<EpiMoe12, pg8::ListOrder, true, true>(F.lds + RING_OFF, g, LO, E);
              { int t2 = F.tid; asm volatile("" : "+v"(t2)); E.e1.flush(t2 & 15, (t2 & 63) >> 4, true); } }
            SEAM(pb + 6);
        }
        if (PT(9) && IN(pb + 8)) { if (REPS(9) > 1) { phase_combine(F, kargs(), l, true); xcd_barrier(bar); } phase_combine(F, kargs(), l); SEAM(pb + 8); }
    }
#undef IN
#undef SEAM
}
}
#ifndef MK_DEBUG
#define MK_DEBUG 0
#endif
#if MK_DEBUG
namespace dbg {
using namespace mk;
struct CkSpec {
    const void* M; const float* N; const float* mgain; long ldm, ldn;
    int mtype  , mrowmap  , mcol0, mhstride, ncol0, nhstride, hc, nh; float scale; int pad;
};
__device__ __forceinline__ void blk_acc(float d2, float r2, double* acc) {
    __shared__ float sd[4], sr[4];
#pragma unroll
    for (int o = 32; o > 0; o >>= 1) { d2 += __shfl_xor(d2, o); r2 += __shfl_xor(r2, o); }
    if ((threadIdx.x & 63) == 0) { sd[threadIdx.x >> 6] = d2; sr[threadIdx.x >> 6] = r2; }
    __syncthreads();
    if (threadIdx.x == 0) { atomicAdd(acc, (double)(sd[0] + sd[1] + sd[2] + sd[3])); atomicAdd(acc + 1, (double)(sr[0] + sr[1] + sr[2] + sr[3])); }
}
__global__ void __launch_bounds__(256) check_k(CkSpec s, double* acc) {
    const long n = (long)T * s.nh * s.hc; float d2 = 0.f, r2 = 0.f;
    for (long i = (long)blockIdx.x * 256 + threadIdx.x; i < n; i += (long)gridDim.x * 256) {
        const long r = i / (s.nh * s.hc); const int cc = (int)(i % (s.nh * s.hc)), h = cc / s.hc, j = cc % s.hc;
        const int mcol = s.mcol0 + h * s.mhstride + j, ncol = s.ncol0 + h * s.nhstride + j;
        long mr = r; if (s.mrowmap) { const long bb = r / L; mr = bb * LP + (r - bb * L) + PADF; }
        float a = s.mtype ? ((const float*)s.M)[mr * s.ldm + mcol] : bf2f(((const bf16*)s.M)[mr * s.ldm + mcol]);
        if (s.mgain) a *= s.mgain[mcol];
        const float b = s.N[r * s.ldn + ncol] * s.scale;
        float d = a - b; if (!(d == d)) d = 1e18f; d2 += d * d; r2 += b * b;
    }
    blk_acc(d2, r2, acc);
}
__global__ void __launch_bounds__(256) check_u_k(const float* U, const float* P, double* acc) {
    const long n = (long)T * 256; float d2 = 0.f, r2 = 0.f;
    for (long i = (long)blockIdx.x * 256 + threadIdx.x; i < n; i += (long)gridDim.x * 256) {
        const long r = i >> 8; const int c = (int)(i & 255);
        const float a = U[i], g = P[r * NIN + 1440 + c], b = P[r * NIN + 1184 + c] / (1.f + expf(-g));
        float d = a - b; if (!(d == d)) d = 1e18f; d2 += d * d; r2 += b * b;
    }
    blk_acc(d2, r2, acc);
}
__global__ void __launch_bounds__(256) check_route_k(const int* TOKE, const float* TOKG, const int* te, const float* tg, double* acc, double* acc2) {
    float mm = 0.f, d2 = 0.f, r2 = 0.f;
    for (int t = blockIdx.x * 256 + threadIdx.x; t < T; t += gridDim.x * 256) {
        bool same = true;
        for (int k = 0; k < 4; ++k) same = same && (TOKE[t * 4 + k] == te[t * 4 + k]);
        if (!same) mm += 1.f; else for (int k = 0; k < 4; ++k) { const float d = TOKG[t * 4 + k] - tg[t * 4 + k]; d2 += d * d; r2 += tg[t * 4 + k] * tg[t * 4 + k]; }
    }
    blk_acc(mm, threadIdx.x == 0 && blockIdx.x == 0 ? (float)T : 0.f, acc);
    __syncthreads();
    blk_acc(d2, r2, acc2);
}
__global__ void tb_k(const unsigned* cnt, int* tb) { if (threadIdx.x == 0) { int s = 0; for (int e = 0; e < NE; ++e) { tb[e] = s; s += ((int)cnt[e] + 255) >> 8; } tb[NE] = s; } }
__global__ void __launch_bounds__(256) check_rows_k(const bf16* Mg, const int* tb, const int* TOKE, const int* TOKP, const float* Nv, const int* slot, const int* te, double* acc) {
    float d2 = 0.f, r2 = 0.f;
    for (long i = (long)blockIdx.x * 256 + threadIdx.x; i < (long)T * 4 * 1024; i += (long)gridDim.x * 256) {
        const int tk = (int)(i >> 10), c = (int)(i & 1023), t = tk >> 2;
        bool same = true;
        for (int k = 0; k < 4; ++k) same = same && (TOKE[t * 4 + k] == te[t * 4 + k]);
        if (!same) continue;
        const float a = bf2f(Mg[((size_t)tb[TOKE[tk]] * 256 + TOKP[tk]) * 1024 + c]), b = Nv[(size_t)slot[tk] * 1024 + c];
        float d = a - b; if (!(d == d)) d = 1e18f; d2 += d * d; r2 += b * b;
    }
    blk_acc(d2, r2, acc);
}
__global__ void __launch_bounds__(256) check_out_k(const float* out, const float* H, double* acc) {
    float d2 = 0.f, r2 = 0.f;
    for (long i = (long)blockIdx.x * 256 + threadIdx.x; i < (long)BATCH * SEQ * D; i += (long)gridDim.x * 256) {
        const long row = i >> 10; const int c = (int)(i & 1023); const long bb = row / SEQ, p = row - bb * SEQ;
        const float a = out[i], b = H[(bb * L + p + NMETA) * D + c]; float d = a - b; if (!(d == d)) d = 1e18f; d2 += d * d; r2 += b * b;
    }
    blk_acc(d2, r2, acc);
}
__global__ void __launch_bounds__(256) verdict_k(const double* acc, int nck, float tol, float* out, long nout) {
    int bad = -1; float cls = 0.f;
    for (int k = 0; k < nck; ++k) { const double d = acc[2 * k], r = acc[2 * k + 1]; if (r == 0.0 && d == 0.0) continue; const double q = r > 0.0 ? d / r : 1e30;
        const double tl = (k < 38 && (k - 2) % 18 == 14) ? 0.06 : (double)tol;
        if (!(q <= tl)) { bad = k; cls = q < 1e-3 ? 0.f : q < 1e-2 ? 1.f : q < 1e-1 ? 2.f : q < 1.0 ? 3.f : 4.f; break; } }
    if (bad < 0) return;
    const float c = sqrtf((10.f + (float)bad) * powf(10.f, cls));
    for (long i = (long)blockIdx.x * 256 + threadIdx.x; i < nout; i += (long)gridDim.x * 256) out[i] += c;
}
}
#endif

static void run_gemm(hipStream_t s, const float* A, int lda, const int* arow, const float* B, int ldb, long strideB, const float* bias, long strideBias, float* C, int ldc,
                     int M, int N, int K, const int* cnt, const int* base, int groups, int swiglu = 0) {
#if MK_DEBUG
    nv::GemmP p{A, arow, B, bias, C, cnt, base, strideB, strideBias, lda, ldb, ldc, M, N, K, swiglu, 0};
    dim3 grid((N + 63) / 64, (M + 63) / 64, groups);
    hipLaunchKernelGGL(nv::sgemm_k, grid, dim3(256), 0, s, p);
#endif
}

extern "C" void kernel_launch(void* const* d_in, const int* in_sizes, int n_in, void* d_out, int out_size, void* d_ws, size_t ws_size, hipStream_t stream) {
    using namespace mk;
    static int grid = 0;
    if (grid == 0) {
        int dev = 0, cus = 0;
        if (n_in != 25 || out_size != BATCH * SEQ * D || ws_size < (size_t)2040 * MiB) { fprintf(stderr, "kernel_launch: unexpected shapes (n_in %d out %d ws %zu)\n", n_in, out_size, ws_size); grid = -1; return; }
        if (hipGetDevice(&dev) != hipSuccess || hipDeviceGetAttribute(&cus, hipDeviceAttributeMultiprocessorCount, dev) != hipSuccess) { grid = -1; return; }
        if (hipFuncSetAttribute((const void*)mega_fwd, hipFuncAttributeMaxDynamicSharedMemorySize, LDS_BYTES) != hipSuccess) { fprintf(stderr, "kernel_launch: hipFuncSetAttribute failed\n"); grid = -1; return; }
        int per_cu = 0;
        if (hipOccupancyMaxActiveBlocksPerMultiprocessor(&per_cu, (const void*)mega_fwd, NWAVES * 64, LDS_BYTES) != hipSuccess || per_cu < 1) fprintf(stderr, "kernel_launch: occupancy query says %d\n", per_cu);
        (void)hipGetLastError();
        grid = cus;
    }
    if (grid < 0) return;
    (void)hipMemsetAsync((char*)d_ws + WS_CTL, 0, CTL_ZERO_BYTES, stream);
    Args a{};
    for (int i = 0; i < 25; ++i) a.in[i] = (const float*)d_in[i];
    a.out = (float*)d_out; a.ws = (unsigned char*)d_ws;
#if !MK_DEBUG
    a.ph_lo = 0; a.ph_hi = N_PHASES;
    hipLaunchKernelGGL(mega_fwd, dim3(grid), dim3(NWAVES * 64), LDS_BYTES, stream, a);
#else
    using namespace nv;
    auto mega = [&](int ph) { a.ph_lo = ph; a.ph_hi = ph + 1; hipLaunchKernelGGL(mega_fwd, dim3(grid), dim3(NWAVES * 64), LDS_BYTES, stream, a); };
    const float* x = (const float*)d_in[0]; const float* meta = (const float*)d_in[1];
    const float* ln_in_g = (const float*)d_in[2]; const float* ln_in_b = (const float*)d_in[3];
    const float* w_in = (const float*)d_in[4]; const float* q_norm_g = (const float*)d_in[5]; const float* w_uq = (const float*)d_in[6];
    const float* kv_norm_g = (const float*)d_in[7]; const float* w_ukv = (const float*)d_in[8]; const float* conv_w = (const float*)d_in[9];
    const float* conv_b = (const float*)d_in[10]; const float* conv_ln_g = (const float*)d_in[11]; const float* conv_ln_b = (const float*)d_in[12];
    const float* grp_norm_g = (const float*)d_in[13]; const float* w_out = (const float*)d_in[14]; const float* ln_mix_g = (const float*)d_in[15];
    const float* ln_mix_b = (const float*)d_in[16]; const float* router_w = (const float*)d_in[17]; const float* router_b = (const float*)d_in[18];
    const float* w_gate_up = (const float*)d_in[19]; const float* b_gate_up = (const float*)d_in[20]; const float* w_down = (const float*)d_in[21];
    const float* b_down = (const float*)d_in[22]; const float* ln_ffn_g = (const float*)d_in[23]; const float* ln_ffn_b = (const float*)d_in[24];
    float* out = (float*)d_out;
    unsigned char* mw = (unsigned char*)d_ws;
    char* w = (char*)d_ws; size_t off = (size_t)1088 * MiB;
    auto take = [&](size_t bytes) { char* p = w + off; off += (bytes + 255) & ~(size_t)255; return p; };
    double* acc = (double*)take(64 * 16); int* tbd = (int*)take(256);
    int* cnt = (int*)take(256); int* base = (int*)take(256);
    int* te = (int*)take((size_t)R * 4); int* tp = (int*)take((size_t)R * 4); float* tg = (float*)take((size_t)R * 4);
    int* list = (int*)take((size_t)R * 4); int* slot = (int*)take((size_t)R * 4);
    float* H = (float*)take((size_t)T * D * 4);
    float* MIX = (float*)take((size_t)T * D * 4);
    float* LOG = (float*)take((size_t)T * NE * 4);
    float* ACT = (float*)take((size_t)R * FF * 4);
    char* alias0 = w + off;
    float* P = (float*)take((size_t)T * NIN * 4);
    float* CQN = (float*)take((size_t)T * 256 * 4); float* CKVN = (float*)take((size_t)T * 128 * 4);
    float* QM = (float*)take((size_t)T * 768 * 4); float* KVM = (float*)take((size_t)T * 1024 * 4); float* KROT = (float*)take((size_t)T * 32 * 4);
    float* SBO = (float*)take((size_t)T * 256 * 4); float* MLAO = (float*)take((size_t)T * 512 * 4);
    float* Y = (float*)take((size_t)T * D * 4);
    float* YS = (float*)alias0;
    if ((size_t)(w + off - alias0) < (size_t)R * D * 4) { fprintf(stderr, "alias too small\n"); return; }
    if (off > ws_size) { fprintf(stderr, "workspace too small: need %zu have %zu\n", off, ws_size); return; }
    (void)hipMemsetAsync(acc, 0, 64 * 16, stream);
    const int CG = 1024;
    auto ck = [&](int id, const void* M, int mtype, int mrowmap, long ldm, int mcol0, int mhstride, const float* N, long ldn, int ncol0, int nhstride, int hc, int nh, float scale, const float* mgain) {
        dbg::CkSpec s{M, N, mgain, ldm, ldn, mtype, mrowmap, mcol0, mhstride, ncol0, nhstride, hc, nh, scale, 0};
        hipLaunchKernelGGL(dbg::check_k, dim3(CG), dim3(256), 0, stream, s, acc + 2 * id);
    };
    mega(0);
    hipLaunchKernelGGL(ln_in_k, dim3(T), dim3(256), 0, stream, x, meta, ln_in_g, ln_in_b, H);
    ck(1, mw + WS_HB, 0, 0, D, 0, 0, H, D, 0, 0, D, 1, 1.f, nullptr);
    for (int l = 0; l < DEPTH; ++l) {
        const int pb = 1 + l * PH_PER_LAYER, cb = 2 + 18 * l;
        mega(pb + 0);
        run_gemm(stream, H, D, nullptr, w_in + (size_t)l * D * NIN, NIN, 0, nullptr, 0, P, NIN, T, NIN, D, nullptr, nullptr, 1);
        ck(cb + 0, mw + WS_SBQ, 0, 1, 256, 0, 0, P, NIN, 0, 0, 256, 1, SBQ_SCALE, nullptr);
        ck(cb + 1, mw + WS_SBK, 0, 1, 256, 0, 0, P, NIN, 256, 0, 256, 1, 1.f, nullptr);
        ck(cb + 2, mw + WS_SBV, 0, 1, 256, 0, 0, P, NIN, 512, 0, 256, 1, 1.f, nullptr);
        ck(cb + 3, mw + WS_CQ, 0, 0, 256, 0, 0, P, NIN, 768, 0, 256, 1, 1.f, nullptr);
        ck(cb + 4, mw + WS_CKV2, 0, 0, 256, 0, 0, P, NIN, 1024, 0, 128, 1, 1.f, nullptr);
        hipLaunchKernelGGL(dbg::check_u_k, dim3(CG), dim3(256), 0, stream, (const float*)(mw + WS_U), P, acc + 2 * (cb + 5));
        mega(pb + 1);
        hipLaunchKernelGGL(rms_cols_k, dim3(T), dim3(256), 0, stream, P, NIN, 768, 256, q_norm_g + l * 256, CQN);
        hipLaunchKernelGGL(rms_cols_k, dim3(T), dim3(256), 0, stream, P, NIN, 1024, 128, kv_norm_g + l * 128, CKVN);
        run_gemm(stream, CQN, 256, nullptr, w_uq + (size_t)l * 256 * 768, 768, 0, nullptr, 0, QM, 768, T, 768, 256, nullptr, nullptr, 1);
        run_gemm(stream, CKVN, 128, nullptr, w_ukv + (size_t)l * 128 * 1024, 1024, 0, nullptr, 0, KVM, 1024, T, 1024, 128, nullptr, nullptr, 1);
        hipLaunchKernelGGL(rotary_k, dim3(T), dim3(256), 0, stream, QM, P, KROT);
        ck(cb + 6, mw + WS_QM, 0, 1, 768, 0, 0, QM, 768, 0, 0, 768, 1, MLAQ_SCALE, nullptr);
        ck(cb + 7, mw + WS_KM, 0, 1, 768, 0, 96, KVM, 1024, 0, 128, 64, 8, 1.f, nullptr);
        ck(cb + 8, mw + WS_KM, 0, 1, 768, 64, 96, KROT, 32, 0, 0, 32, 8, 1.f, nullptr);
        ck(cb + 9, mw + WS_VM, 0, 1, 512, 0, 64, KVM, 1024, 64, 128, 64, 8, 1.f, nullptr);
        mega(pb + 2);
        hipLaunchKernelGGL(attn_k<0>, dim3((L + 3) / 4, 4, BATCH), dim3(256), 0, stream, P, QM, KVM, KROT, SBO);
        hipLaunchKernelGGL(attn_k<1>, dim3((L + 3) / 4, 8, BATCH), dim3(256), 0, stream, P, QM, KVM, KROT, MLAO);
        ck(cb + 10, mw + WS_OATT, 0, 0, 768, 0, 0, SBO, 256, 0, 0, 256, 1, 1.f, nullptr);
        ck(cb + 11, mw + WS_OATT, 0, 0, 768, 256, 0, MLAO, 512, 0, 0, 512, 1, 1.f, nullptr);
        mega(pb + 3);
        hipLaunchKernelGGL(mix_norm_k, dim3(T), dim3(256), 0, stream, P, SBO, MLAO, conv_w + (size_t)l * CONVK * 256, conv_b + l * 256, conv_ln_g + l * 256, conv_ln_b + l * 256,
                           grp_norm_g + l * D, Y);
        ck(cb + 12, mw + WS_Y, 0, 0, D, 0, 0, Y, D, 0, 0, D, 1, 1.f, grp_norm_g + l * D);
        mega(pb + 4);
        mega(pb + 5);
        run_gemm(stream, Y, D, nullptr, w_out + (size_t)l * D * D, D, 0, nullptr, 0, MIX, D, T, D, D, nullptr, nullptr, 1);
        hipLaunchKernelGGL(res_ln_k, dim3(T), dim3(256), 0, stream, H, MIX, ln_mix_g + l * D, ln_mix_b + l * D, (float*)nullptr);
        ck(cb + 13, mw + WS_HB, 0, 0, D, 0, 0, H, D, 0, 0, D, 1, 1.f, nullptr);
        run_gemm(stream, H, D, nullptr, router_w + (size_t)l * D * NE, NE, 0, router_b + l * NE, 0, LOG, NE, T, NE, D, nullptr, nullptr, 1);
        (void)hipMemsetAsync(cnt, 0, 256, stream);
        hipLaunchKernelGGL(route_k, dim3((T + 255) / 256), dim3(256), 0, stream, LOG, cnt, te, tp, tg);
        hipLaunchKernelGGL(prefix_k, dim3(1), dim3(64), 0, stream, cnt, base);
        hipLaunchKernelGGL(scatter_k, dim3((R + 255) / 256), dim3(256), 0, stream, te, tp, base, list, slot);
        hipLaunchKernelGGL(dbg::check_route_k, dim3(64), dim3(256), 0, stream, (const int*)(mw + WS_TOKE), (const float*)(mw + WS_TOKG), te, tg, acc + 2 * (cb + 14), acc + 2 * (38 + l));
        hipLaunchKernelGGL(dbg::tb_k, dim3(1), dim3(64), 0, stream, (const unsigned*)(mw + WS_CTL) + CW_CNT + l * 64, tbd);
        mega(pb + 6);
        run_gemm(stream, H, D, list, w_gate_up + (size_t)l * NE * D * 2 * FF, 2 * FF, (long)D * 2 * FF, b_gate_up + (size_t)l * NE * 2 * FF, 2 * FF, ACT, FF, T, FF, D, cnt, base, NE, 1);
        hipLaunchKernelGGL(dbg::check_rows_k, dim3(CG), dim3(256), 0, stream, (const bf16*)(mw + WS_ACT), tbd, (const int*)(mw + WS_TOKE), (const int*)(mw + WS_TOKP), ACT, slot, te, acc + 2 * (cb + 15));
        mega(pb + 7);
        run_gemm(stream, ACT, FF, nullptr, w_down + (size_t)l * NE * FF * D, D, (long)FF * D, b_down + (size_t)l * NE * D, D, YS, D, T, D, FF, cnt, base, NE);
        hipLaunchKernelGGL(dbg::check_rows_k, dim3(CG), dim3(256), 0, stream, (const bf16*)(mw + WS_YS), tbd, (const int*)(mw + WS_TOKE), (const int*)(mw + WS_TOKP), YS, slot, te, acc + 2 * (cb + 16));
        mega(pb + 8);
        hipLaunchKernelGGL(combine_k, dim3(T), dim3(256), 0, stream, YS, slot, tg, MIX);
        hipLaunchKernelGGL(res_ln_k, dim3(T), dim3(256), 0, stream, H, MIX, ln_ffn_g + l * D, ln_ffn_b + l * D, (float*)nullptr);
        if (l < DEPTH - 1) ck(cb + 17, mw + WS_HB, 0, 0, D, 0, 0, H, D, 0, 0, D, 1, 1.f, nullptr);
        else hipLaunchKernelGGL(dbg::check_out_k, dim3(CG), dim3(256), 0, stream, (const float*)out, (const float*)H, acc + 2 * (cb + 17));
    }
    hipLaunchKernelGGL(dbg::verdict_k, dim3(1024), dim3(256), 0, stream, acc, 40, MK_TOL, out, (long)BATCH * SEQ * D);
#endif
}
```

```cpp
#include <hip/hip_runtime.h>
#include <cstdio>
#include <cstdint>
#include <cmath>
#define MK_DEBUG 0
#define MK_TOL 1e-3f
#define MK_REP 0
namespace pg8 {
#define PG8_LAS __attribute__((address_space(3)))
typedef unsigned short bf16_t;
typedef short bf16x8 __attribute__((ext_vector_type(8)));
typedef float f32x4 __attribute__((ext_vector_type(4)));
typedef float f32x2 __attribute__((ext_vector_type(2)));
typedef unsigned u32x4 __attribute__((ext_vector_type(4)));
typedef unsigned u32x2 __attribute__((ext_vector_type(2)));
constexpr int BM = 256, BK = 64, HALF = 128, HTB = HALF * BK * 2  , STAGE_BYTES = 8 * HTB, NXCD = 8, WGM = 8;

__host__ __device__ __forceinline__ int lds_byte(int r, int c) { const int st = (r >> 4) * 2 + (c >> 5), rr = r & 15, cc = c & 31, ob = rr * 64 + cc * 2; return st * 1024 + (ob ^ (((ob >> 9) & 1) << 5)); }
__host__ __device__ __forceinline__ void stage_rc(int b, int& R, int& C) { const int st = b / 1024, sb = b % 1024, swz = sb ^ (((sb >> 9) & 1) << 5); R = (st >> 1) * 16 + swz / 64; C = (st & 1) * 32 + (swz % 64) / 2; }
__host__ __device__ __forceinline__ int perm32(int rho) { const int n = rho >> 4, i = rho & 15; return 8 * (i >> 2) + 4 * n + (i & 3); }

struct Unit { int pm, pn, pb, ko, kind; };
struct Gemm { const bf16_t* A; const bf16_t* Bt; int M, N, K; int ld = 0; const bf16_t* A2 = nullptr; const bf16_t* Bt2 = nullptr; };

struct StaticOrder {
    int nM, nN, nwg, G, c;
    __host__ __device__ void init(int M, int N, int G_, int c_) { nM = M / BM; nN = N / BM; nwg = nM * nN; G = G_; c = c_; }
    __host__ __device__ bool next(int i, Unit& u) const {
        const long L = (long)i * G + c; if (L >= nwg) return false;
        int wgid = (int)L; { const int q = nwg / NXCD, r = nwg % NXCD, xcd = wgid % NXCD, off = wgid / NXCD; wgid = (xcd < r ? xcd * (q + 1) : r * (q + 1) + (xcd - r) * q) + off; }
        const int nig = WGM * nN, gid = wgid / nig, fm = gid * WGM, gsz = (nM - fm) < WGM ? (nM - fm) : WGM;
        u.pm = fm + ((wgid % nig) % gsz); u.pn = (wgid % nig) / gsz; u.pb = u.pn; u.ko = 0; u.kind = 0; return true;
    }
    __device__ __forceinline__ const PG8_LAS int* rowlist(int) const { return nullptr; }
    __device__ __forceinline__ void a_ready(const Unit&) const {}
};

struct ListOrder {
    const PG8_LAS int* tab; const PG8_LAS int* rows; int n;
    unsigned* rdy = nullptr; unsigned need = 0;
    __device__ __forceinline__ bool next(int i, Unit& u) const { if (i >= n) return false;
        u.pm = __builtin_amdgcn_readfirstlane(tab[4 * i]); u.pn = __builtin_amdgcn_readfirstlane(tab[4 * i + 1]); u.pb = __builtin_amdgcn_readfirstlane(tab[4 * i + 2]); u.kind = __builtin_amdgcn_readfirstlane(tab[4 * i + 3]); u.ko = 0; return true; }
    __device__ __forceinline__ const PG8_LAS int* rowlist(int ui) const { return rows + ui * 256; }
    __device__ __forceinline__ void a_ready(const Unit& u) const {
        if (u.kind != 1 || rdy == nullptr) return;
        if (threadIdx.x < 64) {
            unsigned sp = 0;
            while ((unsigned)__builtin_amdgcn_readfirstlane(__hip_atomic_load(rdy + 16 * u.pm, __ATOMIC_RELAXED, __HIP_MEMORY_SCOPE_AGENT)) < need) { __builtin_amdgcn_s_sleep(2); if (++sp > (1u << 20)) break; }
            __builtin_amdgcn_fence(__ATOMIC_ACQUIRE, "agent");
            asm volatile("s_waitcnt vmcnt(0)" ::: "memory");
        }
        asm volatile("" ::: "memory"); __builtin_amdgcn_s_barrier(); asm volatile("" ::: "memory");
    }
};
template <class Sched> __device__ __forceinline__ ListOrder make_list(const Sched& S, PG8_LAS int* tab, const PG8_LAS int* rows) {
    if (threadIdx.x == 0) { Unit u; int n = 0;
#pragma unroll 1
        while (n < 24 && S.next(n, u)) { tab[4 * n] = u.pm; tab[4 * n + 1] = u.pn; tab[4 * n + 2] = u.pb; tab[4 * n + 3] = u.kind; ++n; } tab[127] = n; }
    __syncthreads();
    ListOrder Lo; Lo.tab = tab; Lo.rows = rows; Lo.n = __builtin_amdgcn_readfirstlane(tab[127]); return Lo;
}
__device__ __forceinline__ unsigned cvt_pk_bf16(float lo, float hi) { unsigned r; asm volatile("v_cvt_pk_bf16_f32 %0, %1, %2" : "=v"(r) : "v"(lo), "v"(hi)); return r; }

template <class Epi, class Sched, bool ALIGN_EPI, bool GATHER>
__device__ __forceinline__ void gemm_phase(PG8_LAS unsigned char* lds, const Gemm g, const Sched& S, const Epi& E) {
    int tid = threadIdx.x; asm volatile("" : "+v"(tid));
    const int wid = __builtin_amdgcn_readfirstlane(tid >> 6), wr = wid >> 2, wc = wid & 3;
    int K = g.K; asm volatile("" : "+s"(K));
    const int nt = K / BK;
    int LD = g.ld ? g.ld : g.K; asm volatile("" : "+s"(LD));
    unsigned voffA[2], voffB[2];
#pragma unroll
    for (int i = 0; i < 2; ++i) { int R, C; stage_rc(tid * 16 + i * 8192, R, C); const int Rb = Epi::PERM ? ((R & ~31) + perm32(R & 31)) : R;
        voffA[i] = (unsigned)(R * LD + C) * 2u; voffB[i] = (unsigned)(Rb * LD + C) * 2u; }
    unsigned voffG[2][2] = {{0u, 0u}, {0u, 0u}};
#define PG8_LOADG(ui_, u_) do { const PG8_LAS int* rl_ = S.rowlist(ui_); _Pragma("unroll") for (int i_ = 0; i_ < 2; ++i_) { int R_, C_; stage_rc(tid * 16 + i_ * 8192, R_, C_);     \
        _Pragma("unroll") for (int h_ = 0; h_ < 2; ++h_) voffG[h_][i_] = (unsigned)((u_).kind ? (u_).pm * BM + h_ * HALF + R_ : rl_[h_ * HALF + R_]) * (unsigned)(LD * 2) + (unsigned)C_ * 2u; } } while (0)
    const size_t kstep = (size_t)(BK * 2);
    const size_t hstep = (size_t)HALF * LD * 2;
    const size_t tstep = 2 * hstep;
    const unsigned ldsw = (unsigned)wid * 1024u;
    const int aoff = lds_byte(wr * 64 + (tid & 15), ((tid & 63) >> 4) * 8), boff = lds_byte(wc * 32 + (tid & 15), ((tid & 63) >> 4) * 8);
#define PG8_SA(b, h) (((b) * 2 + (h)) * HTB)
#define PG8_SB(b, h) ((4 + (b) * 2 + (h)) * HTB)
#define PG8_STAGE(bufoff, gbase, voff) do { _Pragma("unroll") for (int _i = 0; _i < 2; ++_i) \
        __builtin_amdgcn_global_load_lds((const unsigned*)((const char*)(gbase) + (voff)[_i]), (PG8_LAS unsigned*)(lds + (bufoff) + ldsw + _i * 8192), 16, 0, 0); } while (0)
#define PG8_STAGE_A(bufoff, kptr, h) do { if constexpr (GATHER) { PG8_STAGE(bufoff, kptr, voffG[h]); } else { PG8_STAGE(bufoff, (kptr) + (h) * hstep, voffA); } } while (0)
#define PG8_LDA(dst, b, h) do { _Pragma("unroll") for (int m = 0; m < 4; ++m) _Pragma("unroll") for (int k = 0; k < 2; ++k) dst[m][k] = *(const PG8_LAS bf16x8*)(lds + PG8_SA(b, h) + aoff + m * 2048 + k * 1024); } while (0)
#define PG8_LDB(dst, b, h) do { _Pragma("unroll") for (int n = 0; n < 2; ++n) _Pragma("unroll") for (int k = 0; k < 2; ++k) dst[n][k] = *(const PG8_LAS bf16x8*)(lds + PG8_SB(b, h) + boff + n * 2048 + k * 1024); } while (0)
#define PG8_MMA(ai, bj, At, Bt) do { __builtin_amdgcn_s_setprio(1); _Pragma("unroll") for (int m = 0; m < 4; ++m) _Pragma("unroll") for (int n = 0; n < 2; ++n) _Pragma("unroll") for (int k = 0; k < 2; ++k) \
        acc[ai][bj][m][n] = __builtin_amdgcn_mfma_f32_16x16x32_bf16(Bt[n][k], At[m][k], acc[ai][bj][m][n], 0, 0, 0); __builtin_amdgcn_s_setprio(0); } while (0)
#define PG8_WAIT_V(n) asm volatile("s_waitcnt vmcnt(" #n ")" ::: "memory")
#define PG8_WAIT_L(n) asm volatile("s_waitcnt lgkmcnt(" #n ")" ::: "memory")
#define PG8_BAR __builtin_amdgcn_s_barrier()
#define PG8_SCHED __builtin_amdgcn_sched_barrier(0)
    Unit cur, nxt; int ui = 0;
    if (!S.next(0, cur)) return;
    f32x4 acc[2][2][4][2];
#pragma unroll
    for (int a = 0; a < 2; ++a)
#pragma unroll
        for (int b = 0; b < 2; ++b)
#pragma unroll
            for (int m = 0; m < 4; ++m)
#pragma unroll
                for (int n = 0; n < 2; ++n) acc[a][b][m][n] = (f32x4){0.f, 0.f, 0.f, 0.f};
    bf16x8 At[4][2], B0[2][2], B1[2][2];
#define PG8_BASEA(u_) ((const char*)((u_).kind ? g.A2 : g.A) + (GATHER ? (size_t)0 : (size_t)(u_).pm * tstep) + (size_t)(u_).ko * 2)
#define PG8_BASEB(u_) ((const char*)((u_).kind ? g.Bt2 : g.Bt) + (size_t)(u_).pb * tstep + (size_t)(u_).ko * 2)
    const char* cA = PG8_BASEA(cur); const char* cB = PG8_BASEB(cur);
    S.a_ready(cur);
    if constexpr (GATHER) { PG8_LOADG(0, cur); }
    PG8_STAGE(PG8_SB(0, 0), cB, voffB); PG8_STAGE(PG8_SB(0, 1), cB + hstep, voffB); PG8_STAGE_A(PG8_SA(0, 0), cA, 0); PG8_STAGE_A(PG8_SA(0, 1), cA, 1);
    if (wr == 1) PG8_BAR;
    PG8_WAIT_V(2); PG8_BAR;
    PG8_STAGE(PG8_SB(1, 0), cB + kstep, voffB); PG8_STAGE_A(PG8_SA(1, 0), cA + kstep, 0); PG8_STAGE(PG8_SB(1, 1), cB + hstep + kstep, voffB);
    PG8_WAIT_V(6); PG8_BAR;
    for (;;) {
        const bool has_next = S.next(ui + 1, nxt);
        const char* nA = has_next ? PG8_BASEA(nxt) : cA; const char* nB = has_next ? PG8_BASEB(nxt) : cB;
        for (int t = 0; t < nt; t += 2) {
            const bool last = (t == nt - 2);
            const char* a1 = cA + (size_t)(t + 1) * kstep;
            const char* a2 = last ? nA : cA + (size_t)(t + 2) * kstep; const char* b2 = last ? nB : cB + (size_t)(t + 2) * kstep;
            const char* a3 = a2 + kstep; const char* b3 = b2 + kstep;
            if (last && has_next) S.a_ready(nxt);
            PG8_LDB(B0, 0, 0); PG8_LDB(B1, 0, 1); PG8_SCHED; PG8_LDA(At, 0, 0); PG8_STAGE_A(PG8_SA(1, 1), a1, 1);
            if constexpr (GATHER) { if (last && has_next) { PG8_LOADG(ui + 1, nxt); } }
            PG8_WAIT_V(8); PG8_WAIT_L(0); PG8_BAR; PG8_MMA(0, 0, At, B0); PG8_MMA(0, 1, At, B1); PG8_BAR; PG8_SCHED;
            PG8_LDA(At, 0, 1); PG8_STAGE(PG8_SB(0, 0), b2, voffB); PG8_STAGE(PG8_SB(0, 1), b2 + hstep, voffB); PG8_STAGE_A(PG8_SA(0, 0), a2, 0);
            PG8_WAIT_V(8); PG8_WAIT_L(0); PG8_BAR; PG8_MMA(1, 0, At, B0); PG8_MMA(1, 1, At, B1); PG8_BAR; PG8_SCHED;
            PG8_LDB(B0, 1, 0); PG8_LDB(B1, 1, 1); PG8_SCHED; PG8_LDA(At, 1, 0); PG8_STAGE_A(PG8_SA(0, 1), a2, 1);
            PG8_WAIT_V(8); PG8_WAIT_L(0); PG8_BAR; PG8_MMA(0, 0, At, B0); PG8_MMA(0, 1, At, B1); PG8_BAR; PG8_SCHED;
            PG8_LDA(At, 1, 1); PG8_STAGE(PG8_SB(1, 0), b3, voffB); PG8_STAGE(PG8_SB(1, 1), b3 + hstep, voffB); PG8_STAGE_A(PG8_SA(1, 0), a3, 0);
            PG8_WAIT_V(8); PG8_WAIT_L(0); PG8_BAR; PG8_MMA(1, 0, At, B0); PG8_MMA(1, 1, At, B1); PG8_BAR; PG8_SCHED;
        }
        if constexpr (ALIGN_EPI) { if (wr == 0) PG8_BAR; }
        { int t2 = tid; asm volatile("" : "+v"(t2)); E(acc, cur, wr, wc, t2 & 15, (t2 & 63) >> 4); }
        if (!has_next) break;
#pragma unroll
        for (int a = 0; a < 2; ++a)
#pragma unroll
            for (int b = 0; b < 2; ++b)
#pragma unroll
                for (int m = 0; m < 4; ++m)
#pragma unroll
                    for (int n = 0; n < 2; ++n) acc[a][b][m][n] = (f32x4){0.f, 0.f, 0.f, 0.f};
        cur = nxt; cA = nA; cB = nB; ++ui;
        if constexpr (ALIGN_EPI) { if (wr == 1) PG8_BAR; }
    }
    PG8_WAIT_V(0);
    if constexpr (!ALIGN_EPI) { if (wr == 0) PG8_BAR; }
    PG8_BAR;
#undef PG8_LOADG
#undef PG8_BASEA
#undef PG8_BASEB
#undef PG8_SA
#undef PG8_SB
#undef PG8_STAGE
#undef PG8_STAGE_A
#undef PG8_LDA
#undef PG8_LDB
#undef PG8_MMA
#undef PG8_WAIT_V
#undef PG8_WAIT_L
#undef PG8_BAR
#undef PG8_SCHED
}
}
namespace mk {
constexpr int NWAVES = 8;
constexpr int D = 1024, BATCH = 8, SEQ = 2048, NMETA = 16, L = SEQ + NMETA, T = BATCH * L, TP = 16640;
constexpr int LP = 2112, PADF = 48;
constexpr int DEPTH = 2, NE = 32, TOPK = 4, FF = 1024, CONVK = 31, NIN = 1696, NINP = 1792;
constexpr int RP = 74240;
constexpr float ALPHA = 1.4142135623730951f, LN_EPS = 1e-5f, RMS_EPS = 1e-6f;
constexpr float LOG2E = 1.4426950408889634f;
constexpr float SBQ_SCALE = 0.125f * LOG2E;
constexpr float MLAQ_SCALE = 0.10206207261596575f * LOG2E;

constexpr size_t MiB = 1u << 20;
constexpr size_t WS_CTL = 0, CTL_ZERO_BYTES = 1 * MiB;
constexpr size_t WS_WIN = 2 * MiB, WS_WUQ = 9 * MiB, WS_WUKV = 10 * MiB, WS_WOUT = 11 * MiB, WS_BGU = 15 * MiB, WS_ROPE = 16 * MiB, WS_STQ = 17 * MiB, WS_STKV = 17 * MiB + 512 * 1024;
constexpr size_t WS_TOKE = 18 * MiB, WS_TOKP = 18 * MiB + 512 * 1024, WS_TOKG = 19 * MiB, WS_LIST = 20 * MiB, WS_RWT = 24 * MiB, WS_ZP = 26 * MiB;
constexpr size_t WS_WGU = 32 * MiB, WS_WD = 288 * MiB, WS_HL = 416 * MiB  , WS_HB = 481 * MiB, WS_Z = 514 * MiB;
constexpr size_t WS_SBQ = 579 * MiB, WS_SBK = 588 * MiB, WS_SBV = 597 * MiB, WS_CQ = 606 * MiB, WS_CKV = 615 * MiB, WS_U = 620 * MiB;
constexpr size_t WS_QM = 637 * MiB, WS_KM = 662 * MiB, WS_VM = 687 * MiB, WS_OATT = 704 * MiB, WS_Y = 753 * MiB, WS_ACT = 786 * MiB, WS_YS = 931 * MiB, WS_MEGA_END = 1076 * MiB;
constexpr size_t WS_CKV2 = 1077 * MiB  , WS_WUKV2 = 1086 * MiB  ;
static_assert(WS_WIN + (size_t)DEPTH * NINP * D * 2 <= WS_WUQ && WS_WOUT + (size_t)DEPTH * D * D * 2 <= WS_BGU && WS_BGU + (size_t)DEPTH * NE * 2 * FF * 4 <= WS_ROPE, "ws map 1");
static_assert(WS_ROPE + (size_t)L * 16 * 8 <= WS_STQ && WS_STQ + (size_t)TP * 16 <= WS_STKV && WS_STKV + (size_t)TP * 16 <= WS_TOKE && WS_TOKE + (size_t)T * 16 <= WS_TOKP && WS_LIST + (size_t)NE * T * 4 <= WS_WGU, "ws map 2");
static_assert(WS_WGU + (size_t)DEPTH * NE * 2 * FF * D * 2 <= WS_WD && WS_WD + (size_t)DEPTH * NE * FF * D * 2 <= WS_HL && WS_HL + (size_t)TP * D * 2 <= WS_HB && WS_HB + (size_t)TP * D * 2 <= WS_Z && WS_Z + (size_t)T * D * 4 <= WS_SBQ, "ws map 3");
static_assert(WS_SBQ + (size_t)BATCH * LP * 256 * 2 <= WS_SBK && WS_SBV + (size_t)BATCH * LP * 256 * 2 <= WS_CQ && WS_CQ + (size_t)TP * 256 * 2 <= WS_CKV && WS_CKV + (size_t)TP * 128 * 2 <= WS_U && WS_U + (size_t)T * 256 * 4 <= WS_QM, "ws map 4");
static_assert(WS_QM + (size_t)BATCH * LP * 768 * 2 <= WS_KM && WS_KM + (size_t)BATCH * LP * 768 * 2 <= WS_VM && WS_VM + (size_t)BATCH * LP * 512 * 2 <= WS_OATT && WS_OATT + (size_t)T * 768 * 4 <= WS_Y && WS_Y + (size_t)TP * D * 2 <= WS_ACT, "ws map 5");
static_assert(WS_ACT + (size_t)RP * FF * 2 <= WS_YS && WS_YS + (size_t)RP * D * 2 <= WS_MEGA_END, "ws map 6");
constexpr int CW_CNT = 1024;
constexpr int CW_CONV = 1536;
constexpr int CW_TAIL = 1600;
constexpr int CW_AQ = 2048;
constexpr int CW_BAR = 4096;
constexpr int CW_RDY = 8192;

constexpr int RING_OFF = 0, RING_BYTES = 131072;
constexpr int LDSCTL_OFF = RING_BYTES, MISC_OFF = LDSCTL_OFF + 320;
constexpr int TAIL_OFF = RING_BYTES + 1024;
constexpr int LDS_BYTES = 147456;

#define GAS __attribute__((address_space(1)))
#define LAS __attribute__((address_space(3)))
typedef unsigned short bf16;
typedef unsigned v4u __attribute__((ext_vector_type(4)));
typedef unsigned v2u __attribute__((ext_vector_type(2)));
typedef float f32x4 __attribute__((ext_vector_type(4)));
typedef float f32x2 __attribute__((ext_vector_type(2)));
typedef short bf16x8 __attribute__((ext_vector_type(8)));
typedef GAS unsigned gu32;
#define RLX_AGENT __ATOMIC_RELAXED, __HIP_MEMORY_SCOPE_AGENT
#define LDS_WAIT() asm volatile("s_waitcnt lgkmcnt(0)" ::: "memory")
#define VM_WAIT() asm volatile("s_waitcnt vmcnt(0)" ::: "memory")
__device__ __forceinline__ unsigned f2bf(float f) { unsigned u = __builtin_bit_cast(unsigned, f); return (u + 0x7fffu + ((u >> 16) & 1u)) >> 16; }
__device__ __forceinline__ unsigned pk2(float lo, float hi) { return f2bf(lo) | (f2bf(hi) << 16); }
__device__ __forceinline__ unsigned cvtpk_rne(float lo, float hi) { typedef float f2_ __attribute__((ext_vector_type(2))); typedef __bf16 b2_ __attribute__((ext_vector_type(2))); f2_ v = {lo, hi}; b2_ b = __builtin_convertvector(v, b2_); return __builtin_bit_cast(unsigned, b); }
__device__ __forceinline__ float bf2f(unsigned short b) { return __builtin_bit_cast(float, (unsigned)b << 16); }
__device__ __forceinline__ float bflo(unsigned w) { return __builtin_bit_cast(float, w << 16); }
__device__ __forceinline__ float bfhi(unsigned w) { return __builtin_bit_cast(float, w & 0xffff0000u); }

#define XB_TMO      128
#define XB_XCNT(j)  (256  + 64 * (j))
#define XB_XSUB(j)  (1280 + 64 * (j))
#define XB_XGEN(j)  (2304 + 64 * (j))
#define XB_TOP      3328
#define XB_TOPGEN   3392
#define XCD_BAR_WORDS 3456
#define XB_SPIN_CAP (1u << 18)

__device__ __forceinline__ unsigned xb_ld(unsigned* p)              { return __hip_atomic_load(p, __ATOMIC_RELAXED, __HIP_MEMORY_SCOPE_AGENT); }
__device__ __forceinline__ unsigned xb_add(unsigned* p, unsigned v) { return __hip_atomic_fetch_add(p, v, __ATOMIC_RELAXED, __HIP_MEMORY_SCOPE_AGENT); }
__device__ __forceinline__ unsigned xb_xcc_id() { return (unsigned)__builtin_amdgcn_s_getreg((3 << 11) | 20) & 0xFu; }
#define XB_SPIN(cond, bar) do { unsigned _sp = 0; while (cond) { __builtin_amdgcn_s_sleep(1); \
    if ((++_sp & 255u) == 0u) { if (xb_ld(&(bar)[XB_TMO])) break; if (_sp > XB_SPIN_CAP) { atomicAdd(&(bar)[XB_TMO], 1u); break; } } } } while (0)

struct XcdBarrier {
    unsigned* bar; unsigned x;
    volatile LAS unsigned* st;
};
__device__ __forceinline__ XcdBarrier xcd_barrier_post(unsigned* bar, volatile LAS unsigned* st) {
    XcdBarrier b; b.bar = bar; b.x = xb_xcc_id(); b.st = st;
    if (threadIdx.x == 0) (void)xb_add(&bar[XB_XCNT(b.x)], 1u);
    return b;
}
__device__ __forceinline__ void xcd_barrier_complete(unsigned* bar, unsigned x, unsigned& nloc, unsigned& nx) {
    const unsigned G = gridDim.x * gridDim.y * gridDim.z;
    unsigned sum, cnt, mine, sp = 0u;
    for (;;) {
        sum = 0u; cnt = 0u; mine = 0u;
#pragma unroll 1
        for (unsigned j = 0; j < 16; ++j) { const unsigned c = xb_ld(&bar[XB_XCNT(j)]); sum += c; cnt += (c > 0u) ? 1u : 0u; mine = (j == x) ? c : mine; }
        if (sum == G) break;
        __builtin_amdgcn_s_sleep(1);
        if ((++sp & 255u) == 0u) { if (xb_ld(&bar[XB_TMO])) break; if (sp > XB_SPIN_CAP) { atomicAdd(&bar[XB_TMO], 1u); break; } }
    }
    nloc = mine > 0u ? mine : 1u; nx = cnt > 0u ? cnt : 1u;
}
__device__ __forceinline__ void xcd_barrier(const XcdBarrier& b) {
    asm volatile("s_waitcnt vmcnt(0)" ::: "memory");
    __syncthreads();
    if (threadIdx.x == 0) {
        unsigned* bar = b.bar;
        __builtin_amdgcn_s_waitcnt(0);
        unsigned nloc = b.st[0], nx = b.st[1];
        if (nloc == 0u) { xcd_barrier_complete(bar, b.x, nloc, nx); b.st[0] = nloc; b.st[1] = nx; }
        const unsigned old = xb_add(&bar[XB_XSUB(b.x)], 1u);
        const unsigned gen = old / nloc;
        if (old + 1u == (gen + 1u) * nloc) {
            __builtin_amdgcn_fence(__ATOMIC_RELEASE, "agent");
            asm volatile("s_waitcnt vmcnt(0)" ::: "memory");
            const unsigned og = xb_add(&bar[XB_TOP], 1u);
            const unsigned tg = og / nx;
            if (og + 1u == (tg + 1u) * nx) xb_add(&bar[XB_TOPGEN], 1u);
            else XB_SPIN(xb_ld(&bar[XB_TOPGEN]) == tg, bar);
            __builtin_amdgcn_fence(__ATOMIC_ACQUIRE, "agent");
            xb_add(&bar[XB_XGEN(b.x)], 1u);
            asm volatile("s_waitcnt vmcnt(0)" ::: "memory");
        } else {
            XB_SPIN(xb_ld(&bar[XB_XGEN(b.x)]) == gen, bar);
            __builtin_amdgcn_fence(__ATOMIC_ACQUIRE, "agent");
            asm volatile("s_waitcnt vmcnt(0)" ::: "memory");
        }
    }
    __syncthreads();
}

__device__ __forceinline__ float wave_sum(float v) {
#pragma unroll
    for (int o = 1; o < 64; o <<= 1) v += __shfl_xor(v, o);
    return v;
}

struct Frame {
    LAS unsigned char* lds;
    volatile LAS unsigned* MISC;
    gu32* ctl;
    unsigned char* ws;
    int tid, lane, wave;
    int vcu, G;
    const float* in[25];
    float* out;
};
}
#if MK_DEBUG
namespace nv {
using namespace mk;
constexpr int R = T * TOPK;

struct GemmP {
    const float* A; const int* arow;
    const float* B; const float* bias; float* C;
    const int* cnt; const int* base;
    long strideB, strideBias;
    int lda, ldb, ldc, M, N, K;
    int swiglu, pad;
};
__global__ void __launch_bounds__(256) sgemm_k(GemmP p) {
    const int e = blockIdx.z;
    const int M = p.cnt ? p.cnt[e] : p.M;
    const int rbase = p.cnt ? p.base[e] : 0;
    const int m0 = blockIdx.y * 64, n0 = blockIdx.x * 64;
    if (m0 >= M) return;
    const float* B = p.B + (size_t)e * p.strideB;
    const float* bias = p.bias ? p.bias + (size_t)e * p.strideBias : nullptr;
    __shared__ float As[16][68], Bs[16][68], Bs2[16][68];
    const int tid = threadIdx.x, tx = tid & 15, ty = tid >> 4;
    const int ar = tid >> 2, ak = (tid & 3) * 4;
    const int bk = tid >> 4, bn = (tid & 15) * 4;
    long arow_idx = -1;
    if (m0 + ar < M) arow_idx = p.arow ? (long)p.arow[rbase + m0 + ar] : (long)(rbase + m0 + ar);
    const bool bvalid = (n0 + bn) < p.N;
    float acc[4][4] = {}, acc2[4][4] = {};
    for (int k0 = 0; k0 < p.K; k0 += 16) {
        float4 av = make_float4(0.f, 0.f, 0.f, 0.f), bv = make_float4(0.f, 0.f, 0.f, 0.f);
        if (arow_idx >= 0) av = *(const float4*)(p.A + (size_t)arow_idx * p.lda + k0 + ak);
        if (bvalid) bv = *(const float4*)(B + (size_t)(k0 + bk) * p.ldb + n0 + bn);
        As[ak + 0][ar] = av.x; As[ak + 1][ar] = av.y; As[ak + 2][ar] = av.z; As[ak + 3][ar] = av.w;
        *(float4*)&Bs[bk][bn] = bv;
        if (p.swiglu) { float4 bv2 = make_float4(0.f, 0.f, 0.f, 0.f); if (bvalid) bv2 = *(const float4*)(B + (size_t)(k0 + bk) * p.ldb + p.N + n0 + bn); *(float4*)&Bs2[bk][bn] = bv2; }
        __syncthreads();
#pragma unroll
        for (int k = 0; k < 16; ++k) {
            const float4 a4 = *(const float4*)&As[k][ty * 4];
            const float4 b4 = *(const float4*)&Bs[k][tx * 4];
            const float a[4] = {a4.x, a4.y, a4.z, a4.w}, b[4] = {b4.x, b4.y, b4.z, b4.w};
#pragma unroll
            for (int i = 0; i < 4; ++i)
#pragma unroll
                for (int j = 0; j < 4; ++j) acc[i][j] = fmaf(a[i], b[j], acc[i][j]);
            if (p.swiglu) { const float4 c4 = *(const float4*)&Bs2[k][tx * 4]; const float c[4] = {c4.x, c4.y, c4.z, c4.w};
#pragma unroll
                for (int i = 0; i < 4; ++i)
#pragma unroll
                    for (int j = 0; j < 4; ++j) acc2[i][j] = fmaf(a[i], c[j], acc2[i][j]); }
        }
        __syncthreads();
    }
#pragma unroll
    for (int i = 0; i < 4; ++i) {
        const int m = m0 + ty * 4 + i;
        if (m >= M) continue;
#pragma unroll
        for (int j = 0; j < 4; ++j) {
            const int n = n0 + tx * 4 + j;
            if (n < p.N) { float v = acc[i][j] + (bias ? bias[n] : 0.f);
                if (p.swiglu) { float g = fminf(v, 7.f), up = acc2[i][j] + (bias ? bias[p.N + n] : 0.f); up = fminf(fmaxf(up, -7.f), 7.f); v = (up + 1.f) * (g / (1.f + expf(-1.702f * g))); }
                p.C[(size_t)(rbase + m) * p.ldc + n] = v; }
        }
    }
}

__device__ __forceinline__ float block_sum256(float v, float* red) {
#pragma unroll
    for (int o = 32; o > 0; o >>= 1) v += __shfl_xor(v, o);
    __syncthreads();
    if ((threadIdx.x & 63) == 0) red[threadIdx.x >> 6] = v;
    __syncthreads();
    return red[0] + red[1] + red[2] + red[3];
}
__global__ void __launch_bounds__(256) ln_in_k(const float* x, const float* meta, const float* g, const float* b, float* H) {
    __shared__ float red[4];
    const int r = blockIdx.x, bb = r / L, p = r % L;
    const float* src = p < NMETA ? meta + (size_t)p * D : x + ((size_t)bb * SEQ + (p - NMETA)) * D;
    float v[4]; float s = 0.f;
#pragma unroll
    for (int i = 0; i < 4; ++i) { v[i] = src[threadIdx.x + 256 * i]; s += v[i]; }
    const float mu = block_sum256(s, red) * (1.f / D);
    float q = 0.f;
#pragma unroll
    for (int i = 0; i < 4; ++i) { v[i] -= mu; q += v[i] * v[i]; }
    const float rstd = 1.0f / sqrtf(block_sum256(q, red) * (1.f / D) + 1e-5f);
#pragma unroll
    for (int i = 0; i < 4; ++i) { const int c = threadIdx.x + 256 * i; H[(size_t)r * D + c] = v[i] * rstd * g[c] + b[c]; }
}
__global__ void __launch_bounds__(256) res_ln_k(float* H, const float* add, const float* g, const float* b, float* out) {
    __shared__ float red[4];
    const int r = blockIdx.x;
    float v[4]; float s = 0.f;
#pragma unroll
    for (int i = 0; i < 4; ++i) { const int c = threadIdx.x + 256 * i; v[i] = ALPHA * H[(size_t)r * D + c] + add[(size_t)r * D + c]; s += v[i]; }
    const float mu = block_sum256(s, red) * (1.f / D);
    float q = 0.f;
#pragma unroll
    for (int i = 0; i < 4; ++i) { v[i] -= mu; q += v[i] * v[i]; }
    const float rstd = 1.0f / sqrtf(block_sum256(q, red) * (1.f / D) + 1e-5f);
    const int bb = r / L, p = r % L;
#pragma unroll
    for (int i = 0; i < 4; ++i) {
        const int c = threadIdx.x + 256 * i; const float o = v[i] * rstd * g[c] + b[c];
        H[(size_t)r * D + c] = o;
        if (out && p >= NMETA) out[((size_t)bb * SEQ + (p - NMETA)) * D + c] = o;
    }
}
__global__ void __launch_bounds__(256) rms_cols_k(const float* P, int ldp, int col0, int W, const float* g, float* O) {
    __shared__ float red[4];
    const int r = blockIdx.x, c = threadIdx.x;
    const float v = c < W ? P[(size_t)r * ldp + col0 + c] : 0.f;
    const float ss = block_sum256(v * v, red);
    const float rstd = 1.0f / sqrtf(ss / (float)W + 1e-6f);
    if (c < W) O[(size_t)r * W + c] = v * rstd * g[c];
}
__global__ void __launch_bounds__(256) rotary_k(float* QM, const float* P, float* KROT) {
    const int r = blockIdx.x, p = r % L, t = threadIdx.x;
    if (t < 128 + 16) {
        const int i = t & 15;
        const float inv = 1.0f / powf(10000.0f, (float)(2 * i) / 32.0f);
        const float ang = (float)p * inv;
        const float c = cosf(ang), s = sinf(ang);
        if (t < 128) {
            const int h = t >> 4; float* q = QM + (size_t)r * 768 + h * 96 + 64;
            const float x1 = q[i], x2 = q[i + 16];
            q[i] = x1 * c - x2 * s; q[i + 16] = x1 * s + x2 * c;
        } else {
            const float* k = P + (size_t)r * NIN + 1152;
            const float x1 = k[i], x2 = k[i + 16];
            KROT[(size_t)r * 32 + i] = x1 * c - x2 * s; KROT[(size_t)r * 32 + i + 16] = x1 * s + x2 * c;
        }
    }
}

template <int MODE>
__global__ void __launch_bounds__(256) attn_k(const float* P, const float* QM, const float* KVM, const float* KROT, float* O) {
    __shared__ float sc[4][L + 16];
    __shared__ float qs[4][96];
    const int w = threadIdx.x >> 6, lane = threadIdx.x & 63;
    const int t = blockIdx.x * 4 + w, h = blockIdx.y, b = blockIdx.z;
    if (t >= L) return;
    const size_t row = (size_t)b * L + t;
    const int n = MODE == 0 ? t : t + 1;
    float* s = sc[w]; float* q = qs[w];
    if (MODE == 0) { q[lane] = P[row * NIN + h * 64 + lane]; }
    else { q[lane] = QM[row * 768 + h * 96 + lane]; if (lane < 32) q[64 + lane] = QM[row * 768 + h * 96 + 64 + lane]; }
    __syncthreads();
    const float scale = MODE == 0 ? 0.125f : 0.10206207261596575f;
    for (int j = lane; j < n; j += 64) {
        const size_t kr = (size_t)b * L + j; float a = 0.f;
        if (MODE == 0) { const float4* k = (const float4*)(P + kr * NIN + 256 + h * 64);
            for (int d = 0; d < 16; ++d) { const float4 kv = k[d]; a = fmaf(q[4 * d], kv.x, a); a = fmaf(q[4 * d + 1], kv.y, a); a = fmaf(q[4 * d + 2], kv.z, a); a = fmaf(q[4 * d + 3], kv.w, a); } }
        else { const float4* k = (const float4*)(KVM + kr * 1024 + h * 128);
            for (int d = 0; d < 16; ++d) { const float4 kv = k[d]; a = fmaf(q[4 * d], kv.x, a); a = fmaf(q[4 * d + 1], kv.y, a); a = fmaf(q[4 * d + 2], kv.z, a); a = fmaf(q[4 * d + 3], kv.w, a); }
            const float4* kp = (const float4*)(KROT + kr * 32);
            for (int d = 0; d < 8; ++d) { const float4 kv = kp[d]; a = fmaf(q[64 + 4 * d], kv.x, a); a = fmaf(q[64 + 4 * d + 1], kv.y, a); a = fmaf(q[64 + 4 * d + 2], kv.z, a); a = fmaf(q[64 + 4 * d + 3], kv.w, a); } }
        s[j] = a * scale;
    }
    __syncthreads();
    if (MODE == 1) {
        float m = -INFINITY; for (int j = lane; j < n; j += 64) m = fmaxf(m, s[j]);
#pragma unroll
        for (int o = 32; o > 0; o >>= 1) m = fmaxf(m, __shfl_xor(m, o));
        float sum = 0.f; for (int j = lane; j < n; j += 64) { const float e = expf(s[j] - m); s[j] = e; sum += e; }
#pragma unroll
        for (int o = 32; o > 0; o >>= 1) sum += __shfl_xor(sum, o);
        const float inv = 1.0f / sum;
        for (int j = lane; j < n; j += 64) s[j] *= inv;
    } else {
        const int C = (n + 63) / 64, j0 = lane * C, j1 = min(n, j0 + C);
        float cs = 0.f;
        for (int j = j0; j < j1; ++j) { const float z = s[j]; const float a = -(fmaxf(z, 0.f) + log1pf(expf(-fabsf(z)))); cs += a; }
        float incl = cs;
#pragma unroll
        for (int o = 1; o < 64; o <<= 1) { const float v = __shfl_down(incl, o); if (lane + o < 64) incl += v; }
        float run = incl - cs;
        for (int j = j1 - 1; j >= j0; --j) { const float z = s[j]; const float a = -(fmaxf(z, 0.f) + log1pf(expf(-fabsf(z)))); run += a; s[j] = expf(z + run); }
    }
    __syncthreads();
    float o = 0.f;
    if (MODE == 0) { const float* v = P + (size_t)b * L * NIN + 512 + h * 64 + lane; for (int j = 0; j < n; ++j) o = fmaf(s[j], v[(size_t)j * NIN], o); O[row * 256 + h * 64 + lane] = o; }
    else { const float* v = KVM + (size_t)b * L * 1024 + h * 128 + 64 + lane; for (int j = 0; j < n; ++j) o = fmaf(s[j], v[(size_t)j * 1024], o); O[row * 512 + h * 64 + lane] = o; }
}

__global__ void __launch_bounds__(256) mix_norm_k(const float* P, const float* SBO, const float* MLAO, const float* cw, const float* cb, const float* clg, const float* clb,
                                                  const float* gg, float* Y) {
    __shared__ float red[4];
    const int r = blockIdx.x, p = r % L, c = threadIdx.x;
    float acc = cb[c];
    for (int k = 0; k < CONVK; ++k) {
        const int pp = p - (CONVK - 1) + k;
        if (pp >= 0) { const float* pr = P + (size_t)(r - (CONVK - 1) + k) * NIN; const float a = pr[1184 + c], g = pr[1440 + c]; acc = fmaf(a / (1.f + expf(-g)), cw[k * 256 + c], acc); }
    }
    const float mu = block_sum256(acc, red) * (1.f / 256.f);
    const float dv = acc - mu;
    const float var = block_sum256(dv * dv, red) * (1.f / 256.f);
    float y = dv * (1.0f / sqrtf(var + 1e-5f)) * clg[c] + clb[c];
    y = y / (1.f + expf(-y));
    const float ssc = block_sum256(y * y, red);
    Y[(size_t)r * D + 768 + c] = y * (1.0f / sqrtf(ssc / 256.f + 1e-6f)) * gg[768 + c];
    const float sb = SBO[(size_t)r * 256 + c];
    const float sss = block_sum256(sb * sb, red);
    Y[(size_t)r * D + c] = sb * (1.0f / sqrtf(sss / 256.f + 1e-6f)) * gg[c];
    const float m0 = MLAO[(size_t)r * 512 + c], m1 = MLAO[(size_t)r * 512 + 256 + c];
    const float ssm = block_sum256(m0 * m0 + m1 * m1, red);
    const float rm = 1.0f / sqrtf(ssm / 512.f + 1e-6f);
    Y[(size_t)r * D + 256 + c] = m0 * rm * gg[256 + c];
    Y[(size_t)r * D + 512 + c] = m1 * rm * gg[512 + c];
}

__global__ void route_k(const float* LOG, int* cnt, int* te, int* tp, float* tg) {
    const int t = blockIdx.x * blockDim.x + threadIdx.x;
    if (t >= T) return;
    float v[NE];
#pragma unroll
    for (int e = 0; e < NE; ++e) v[e] = LOG[(size_t)t * NE + e];
    float tv[TOPK]; int ti[TOPK];
#pragma unroll
    for (int k = 0; k < TOPK; ++k) {
        float bv = -INFINITY; int bi = 0;
#pragma unroll
        for (int e = 0; e < NE; ++e) if (v[e] > bv) { bv = v[e]; bi = e; }
        tv[k] = bv; ti[k] = bi;
#pragma unroll
        for (int e = 0; e < NE; ++e) if (e == bi) v[e] = -INFINITY;
    }
    float sum = 0.f, ex[TOPK];
#pragma unroll
    for (int k = 0; k < TOPK; ++k) { ex[k] = expf(tv[k] - tv[0]); sum += ex[k]; }
#pragma unroll
    for (int k = 0; k < TOPK; ++k) { te[t * TOPK + k] = ti[k]; tg[t * TOPK + k] = ex[k] / sum; tp[t * TOPK + k] = atomicAdd(&cnt[ti[k]], 1); }
}
__global__ void prefix_k(const int* cnt, int* base) { if (threadIdx.x == 0) { int s = 0; for (int e = 0; e < NE; ++e) { base[e] = s; s += cnt[e]; } } }
__global__ void scatter_k(const int* te, const int* tp, const int* base, int* list, int* slot) {
    const int i = blockIdx.x * blockDim.x + threadIdx.x;
    if (i >= R) return;
    const int s = base[te[i]] + tp[i]; list[s] = i / TOPK; slot[i] = s;
}
__global__ void swiglu_k(const float* GU, float* ACT) {
    const size_t i = (size_t)blockIdx.x * blockDim.x + threadIdx.x;
    if (i >= (size_t)R * FF) return;
    const size_t r = i / FF; const int c = (int)(i % FF);
    float g = GU[r * 2 * FF + c], up = GU[r * 2 * FF + FF + c];
    g = fminf(g, 7.f); up = fminf(fmaxf(up, -7.f), 7.f);
    ACT[i] = (up + 1.f) * (g / (1.f + expf(-1.702f * g)));
}
__global__ void __launch_bounds__(256) combine_k(const float* YS, const int* slot, const float* tg, float* FFN) {
    const int t = blockIdx.x;
#pragma unroll
    for (int i = 0; i < 4; ++i) {
        const int c = threadIdx.x + 256 * i; float a = 0.f;
#pragma unroll
        for (int k = 0; k < TOPK; ++k) a += YS[(size_t)slot[t * TOPK + k] * D + c] * tg[t * TOPK + k];
        FFN[(size_t)t * D + c] = a;
    }
}
}
#endif
namespace mk {
struct MapId { __device__ __forceinline__ int operator()(int n) const { return n; } };
struct MapIn {
    __device__ __forceinline__ int operator()(int n) const {
        if (n < 1184) return n;
        if (n < 1280) return -1;
        const int t = n - 1280, tile = t >> 8, j = t & 255, ch = tile * 128 + (j & 127);
        return (j < 128 ? 1184 : 1440) + ch;
    }
};
struct MapGU {
    __device__ __forceinline__ int operator()(int n) const { const int pn = n >> 8, j = n & 255; return (j < 128 ? 0 : FF) + pn * 128 + (j & 127); }
};
template <class Map>
__device__ __forceinline__ void p0_transpose_item(const float* W, int K, int N, int nblk, bf16* WT, const float* gain, LAS float* scr, int item, int lane, Map map, int ldt = 0) {
    if (ldt == 0) ldt = K;
    const int kb = item / nblk, nb = item % nblk, k0 = 64 * kb, n0 = 32 * nb;
    const int src = map(n0 + (lane & 31));
#pragma unroll 8
    for (int i = 0; i < 32; ++i) { const int kk = 2 * i + (lane >> 5); float v = 0.f; if (src >= 0) v = W[(size_t)(k0 + kk) * N + src]; if (gain) v *= gain[k0 + kk]; scr[kk * 33 + (lane & 31)] = v; }
    LDS_WAIT(); asm volatile("" ::: "memory");
    const int c = lane & 7;
#pragma unroll
    for (int j = 0; j < 4; ++j) { const int n = (lane >> 3) + 8 * j; const LAS float* s = scr + (8 * c) * 33 + n;
        v4u o; o.x = pk2(s[0 * 33], s[1 * 33]); o.y = pk2(s[2 * 33], s[3 * 33]); o.z = pk2(s[4 * 33], s[5 * 33]); o.w = pk2(s[6 * 33], s[7 * 33]);
        *(GAS v4u*)(WT + (size_t)(n0 + n) * ldt + k0 + 8 * c) = o; }
    LDS_WAIT(); asm volatile("" ::: "memory");
}
template <class Map>
__device__ __forceinline__ void p0_tr64_load(const float* W, int N, int nblk, int item, int lane, Map map, f32x4 (&v)[8]) {
    const int kb = item / nblk, nb = item - kb * nblk; const float* src = W + (size_t)(32 * kb + (lane >> 4)) * N + map(64 * nb) + (lane & 15) * 4;
#pragma unroll
    for (int i = 0; i < 8; ++i) v[i] = __builtin_nontemporal_load((const f32x4*)(src + (size_t)(4 * i) * N));
}
__device__ __forceinline__ void p0_tr64_store(const f32x4 (&v)[8], int K, int nblk, int item, bf16* WT, LAS float* scr, int lane) {
    const int kb = item / nblk, nb = item - kb * nblk, k0 = 32 * kb, n0 = 64 * nb;
#pragma unroll
    for (int i = 0; i < 8; ++i) { LAS float* d = scr + (4 * i + (lane >> 4)) * 65 + (lane & 15) * 4; d[0] = v[i].x; d[1] = v[i].y; d[2] = v[i].z; d[3] = v[i].w; }
    LDS_WAIT(); asm volatile("" ::: "memory");
    const int c = lane & 3;
#pragma unroll
    for (int j = 0; j < 4; ++j) { const int n = (lane >> 2) + 16 * j; const LAS float* s = scr + (8 * c) * 65 + n;
        v4u o; o.x = cvtpk_rne(s[0 * 65], s[1 * 65]); o.y = cvtpk_rne(s[2 * 65], s[3 * 65]); o.z = cvtpk_rne(s[4 * 65], s[5 * 65]); o.w = cvtpk_rne(s[6 * 65], s[7 * 65]);
        *(GAS v4u*)(WT + (size_t)(n0 + n) * K + k0 + 8 * c) = o; }
    LDS_WAIT(); asm volatile("" ::: "memory");
}
struct Args { const float* in[25]; float* out; unsigned char* ws; int ph_lo, ph_hi; };
typedef const Args __attribute__((address_space(4)))* KArgs;
__device__ __forceinline__ KArgs kargs() { KArgs p = (KArgs)__builtin_amdgcn_kernarg_segment_ptr(); asm volatile("" : "+s"(p)); return p; }
enum { I_X = 0, I_META, I_LNIN_G, I_LNIN_B, I_WIN, I_QNG, I_WUQ, I_KVNG, I_WUKV, I_CONVW, I_CONVB, I_CLNG, I_CLNB, I_GRPG, I_WOUT, I_LNMIX_G, I_LNMIX_B, I_RW, I_RB, I_WGU, I_BGU, I_WD, I_BD, I_LNFFN_G, I_LNFFN_B };

__device__ __forceinline__ void ln_row16(f32x4 (&v)[4], const float* g, const float* b, int lane) {
    float s = 0.f;
#pragma unroll
    for (int j = 0; j < 4; ++j) s += (v[j].x + v[j].y) + (v[j].z + v[j].w);
    const float mean = wave_sum(s) * (1.f / D); float s2 = 0.f;
#pragma unroll
    for (int j = 0; j < 4; ++j) { v[j] = v[j] - mean; s2 += (v[j].x * v[j].x + v[j].y * v[j].y) + (v[j].z * v[j].z + v[j].w * v[j].w); }
    const float rstd = __builtin_amdgcn_rsqf(wave_sum(s2) * (1.f / D) + LN_EPS);
#pragma unroll
    for (int j = 0; j < 4; ++j) { const f32x4 gg = *(const f32x4*)(g + 4 * lane + 256 * j), bb = *(const f32x4*)(b + 4 * lane + 256 * j); v[j] = v[j] * rstd * gg + bb; }
}
__device__ __forceinline__ void store_row16(const f32x4 (&v)[4], float* hf, bf16* hb, int lane) {
#pragma unroll
    for (int j = 0; j < 4; ++j) {
        if (hf) *(f32x4*)(hf + 4 * lane + 256 * j) = v[j];
        if (hb) *(v2u*)(hb + 4 * lane + 256 * j) = (v2u){pk2(v[j].x, v[j].y), pk2(v[j].z, v[j].w)};
    }
}

__device__ __forceinline__ void p0_prologue(Frame& F, KArgs A) {
    LAS float* scr = (LAS float*)(F.lds + RING_OFF + F.wave * 16384);
    const int gw = F.vcu * NWAVES + F.wave, NGW = F.G * NWAVES, lane = F.lane;
    unsigned char* ws = F.ws;
    constexpr int I_IN = 16 * (NINP / 32), I_UQ = 4 * 24, I_UKV = 2 * 32, I_OUT = 16 * 32, I_GU = 32 * 32, I_DN = 32 * 16;
    constexpr int S0 = DEPTH * I_IN, S1 = S0 + DEPTH * I_UQ, S2 = S1 + DEPTH * I_UKV, S3 = S2 + DEPTH * I_OUT;
    for (int it = gw; it < S3; it += NGW) {
        if (it >= S2) { const int r = it - S2, l = r / I_OUT, i = r % I_OUT;
            p0_transpose_item(A->in[I_WOUT] + (size_t)l * D * D, D, D, D / 32, (bf16*)(ws + WS_WOUT) + (size_t)l * D * D, A->in[I_GRPG] + l * D, scr, i, lane, MapId()); }
        else if (it >= S1) { const int r = it - S1, l = r / I_UKV, i = r % I_UKV;
            p0_transpose_item(A->in[I_WUKV] + (size_t)l * 128 * 1024, 128, 1024, 1024 / 32, (bf16*)(ws + WS_WUKV2) + (size_t)l * 1024 * 256, A->in[I_KVNG] + l * 128, scr, i, lane, MapId(), 256); }
        else if (it >= S0) { const int r = it - S0, l = r / I_UQ, i = r % I_UQ;
            p0_transpose_item(A->in[I_WUQ] + (size_t)l * 256 * 768, 256, 768, 768 / 32, (bf16*)(ws + WS_WUQ) + (size_t)l * 768 * 256, A->in[I_QNG] + l * 256, scr, i, lane, MapId()); }
        else { const int l = it / I_IN, i = it % I_IN;
            p0_transpose_item(A->in[I_WIN] + (size_t)l * D * NIN, D, NIN, NINP / 32, (bf16*)(ws + WS_WIN) + (size_t)l * NINP * D, nullptr, scr, i, lane, MapIn()); }
    }
    const int gt = gw * 64 + lane, NGT = NGW * 64;
    for (int i = gt; i < DEPTH * NE * 2 * FF; i += NGT) { const int m = i / (2 * FF), n = i % (2 * FF); ((float*)(ws + WS_BGU))[i] = A->in[I_BGU][(size_t)m * 2 * FF + MapGU()(n)]; }
    for (int i = gt; i < L * 16; i += NGT) { const int p = i >> 4, k = i & 15; const float inv = 1.0f / powf(10000.0f, (float)(2 * k) / 32.0f); const float ang = (float)p * inv;
        ((f32x2*)(ws + WS_ROPE))[i] = (f32x2){cosf(ang), sinf(ang)}; }
    for (int i = gt; i < DEPTH * NE * D; i += NGT) { const int ll = i / (NE * D), e = (i / D) % NE, k = i % D; const float w = A->in[I_RW][((size_t)ll * D + k) * NE + e]; const unsigned h = f2bf(w);
        bf16* o = (bf16*)(ws + WS_RWT) + (size_t)ll * 2 * NE * D + (size_t)e * D + k; o[0] = (bf16)h; o[NE * D] = (bf16)f2bf(w - bf2f((bf16)h)); }
    for (int i = gt; i < DEPTH * 1024 * 128; i += NGT) ((bf16*)(ws + WS_WUKV2))[(size_t)(i >> 7) * 256 + 128 + (i & 127)] = 0;
    for (int i = gt; i < BATCH * PADF * 256; i += NGT) { const int b = i / (PADF * 256), r = i % (PADF * 256); ((bf16*)(ws + WS_SBV))[(size_t)b * LP * 256 + r] = 0; ((bf16*)(ws + WS_SBK))[(size_t)b * LP * 256 + r] = 0; }
    for (int i = gt; i < BATCH * PADF * 512; i += NGT) { const int b = i / (PADF * 512), r = i % (PADF * 512); ((bf16*)(ws + WS_VM))[(size_t)b * LP * 512 + r] = 0; }
    for (int i = gt; i < BATCH * PADF * 768; i += NGT) { const int b = i / (PADF * 768), r = i % (PADF * 768); ((bf16*)(ws + WS_KM))[(size_t)b * LP * 768 + r] = 0; }
    for (int r = gw; r < TP; r += NGW) {
        bf16* hb = (bf16*)(ws + WS_HB) + (size_t)r * D;
        if (r >= T) { *(v4u*)(hb + 8 * lane) = (v4u){0u, 0u, 0u, 0u}; *(v4u*)(hb + 512 + 8 * lane) = (v4u){0u, 0u, 0u, 0u}; continue; }
        const int bb = r / L, p = r - bb * L;
        const float* src = p < NMETA ? A->in[I_META] + (size_t)p * D : A->in[I_X] + ((size_t)bb * SEQ + (p - NMETA)) * D;
        f32x4 v[4];
#pragma unroll
        for (int j = 0; j < 4; ++j) v[j] = *(const f32x4*)(src + 4 * lane + 256 * j);
        ln_row16(v, A->in[I_LNIN_G], A->in[I_LNIN_B], lane);
        store_row16(v, nullptr, hb, lane);
    }
}


constexpr int CONV_IGU = 32 * 32, CONV_IDN = 32 * 16, CONV_NGU = NE * CONV_IGU, CONV_ITEMS = CONV_NGU + NE * CONV_IDN, CONV_CHUNK = 32, CONV_NCHUNK = CONV_ITEMS / CONV_CHUNK;
__device__ __forceinline__ void conv_chunk(Frame& F, KArgs A, int l, int ch, LAS float* scr) {
    unsigned char* ws = F.ws; int tid = F.tid; asm volatile("" : "+v"(tid)); const int lane = tid & 63;
    const float* wgu = A->in[I_WGU] + (size_t)l * NE * D * 2 * FF; const float* wdn = A->in[I_WD] + (size_t)l * NE * FF * D;
    bf16* tgu = (bf16*)(ws + WS_WGU) + (size_t)l * NE * 2 * FF * D; bf16* tdn = (bf16*)(ws + WS_WD) + (size_t)l * NE * D * FF;
    const bool isgu = ch < CONV_NGU / CONV_CHUNK; const int chl = isgu ? ch : ch - CONV_NGU / CONV_CHUNK;
    const int nblk = isgu ? 2 * FF / 64 : D / 64, cpe = nblk * 32 / CONV_CHUNK, m = chl / cpe, cl = chl - m * cpe, ngr = nblk / 16, kbp = cl / ngr, ng = cl - kbp * ngr;
    const float* src = isgu ? wgu + (size_t)m * D * 2 * FF : wdn + (size_t)m * FF * D; bf16* dst = isgu ? tgu + (size_t)m * 2 * FF * D : tdn + (size_t)m * D * FF;
    const int N = isgu ? 2 * FF : D;
#define CV_ITEM(k_) ((2 * kbp + ((k_) & 1)) * nblk + ng * 16 + F.wave + 8 * ((k_) >> 1))
#define CV_LOAD(k_, v_) do { if (isgu) p0_tr64_load(src, N, nblk, CV_ITEM(k_), lane, MapGU(), v_); else p0_tr64_load(src, N, nblk, CV_ITEM(k_), lane, MapId(), v_); } while (0)
#define CV_STORE(k_, v_) p0_tr64_store(v_, 1024, nblk, CV_ITEM(k_), dst, scr, lane)
    f32x4 va[8], vb[8], vc[8], vd[8];
    CV_LOAD(0, va); CV_LOAD(1, vb); CV_LOAD(2, vc); CV_LOAD(3, vd);
    CV_STORE(0, va); CV_STORE(1, vb); CV_STORE(2, vc); CV_STORE(3, vd);
#undef CV_ITEM
#undef CV_LOAD
#undef CV_STORE
}

typedef pg8::f32x4 (AccT)[2][2][4][2];
__device__ __forceinline__ v2u pk4(f32x4 v) { return (v2u){cvtpk_rne(v.x, v.y), cvtpk_rne(v.z, v.w)}; }
__device__ __forceinline__ float sigmoidf_(float x) { return __builtin_amdgcn_rcpf(1.0f + __builtin_amdgcn_exp2f(x * -LOG2E)); }

struct EpiInProj {
    static constexpr bool PERM = false;
    bf16 *SBQ, *SBK, *SBV, *CQ, *CKV, *KM; float *U, *STQ, *STKV; const f32x2* ROPE;
    __device__ __forceinline__ void operator()(const AccT& acc, const pg8::Unit& u, int wr, int wc, int fr, int fq) const {
        const int pn = u.pn;
#pragma unroll
        for (int ai = 0; ai < 2; ++ai) {
            if (u.pm * 256 + ai * 128 >= T) continue;
#pragma unroll
            for (int m = 0; m < 4; ++m) {
                const int r = u.pm * 256 + ai * 128 + wr * 64 + m * 16 + fr;
                const int bb = r / L, p = r - bb * L; const size_t ar = (size_t)bb * LP + p + PADF;
                if (pn <= 2) {
                    bf16* dst = (pn == 0 ? SBQ : pn == 1 ? SBK : SBV) + ar * 256 + wc * 32 + 4 * fq; const float sc = pn == 0 ? SBQ_SCALE : 1.0f;
#pragma unroll
                    for (int bj = 0; bj < 2; ++bj)
#pragma unroll
                        for (int n = 0; n < 2; ++n) *(v2u*)(dst + bj * 128 + n * 16) = pk4(acc[ai][bj][m][n] * sc);
                } else if (pn == 3) {
                    float ss = 0.f;
#pragma unroll
                    for (int bj = 0; bj < 2; ++bj)
#pragma unroll
                        for (int n = 0; n < 2; ++n) { const f32x4 v = acc[ai][bj][m][n]; ss += (v.x * v.x + v.y * v.y) + (v.z * v.z + v.w * v.w); *(v2u*)(CQ + (size_t)r * 256 + bj * 128 + wc * 32 + n * 16 + 4 * fq) = pk4(v); }
                    ss += __shfl_xor(ss, 16); ss += __shfl_xor(ss, 32);
                    if (fq == 0) STQ[(size_t)r * 4 + wc] = ss;
                } else if (pn == 4) {
                    float ss = 0.f;
#pragma unroll
                    for (int n = 0; n < 2; ++n) { const f32x4 v = acc[ai][0][m][n]; ss += (v.x * v.x + v.y * v.y) + (v.z * v.z + v.w * v.w); *(v2u*)(CKV + (size_t)r * 256 + wc * 32 + n * 16 + 4 * fq) = pk4(v); *(v2u*)(CKV + (size_t)r * 256 + 128 + wc * 32 + n * 16 + 4 * fq) = (v2u){0u, 0u}; }
                    ss += __shfl_xor(ss, 16); ss += __shfl_xor(ss, 32);
                    if (fq == 0) STKV[(size_t)r * 4 + wc] = ss;
                    if (wc == 0) {
                        const f32x4 x1 = acc[ai][1][m][0], x2 = acc[ai][1][m][1]; f32x4 y1, y2;
#pragma unroll
                        for (int j = 0; j < 4; ++j) { const f32x2 cs = ROPE[p * 16 + 4 * fq + j]; y1[j] = x1[j] * cs.x - x2[j] * cs.y; y2[j] = x1[j] * cs.y + x2[j] * cs.x; }
                        const v2u w1 = pk4(y1), w2 = pk4(y2);
#pragma unroll
                        for (int h = 0; h < 8; ++h) { bf16* kd = KM + ar * 768 + h * 96 + 64 + 4 * fq; *(v2u*)kd = w1; *(v2u*)(kd + 16) = w2; }
                    }
                } else {
#pragma unroll
                    for (int n = 0; n < 2; ++n) { const f32x4 a = acc[ai][0][m][n], g = acc[ai][1][m][n]; f32x4 o;
#pragma unroll
                        for (int j = 0; j < 4; ++j) o[j] = a[j] * sigmoidf_(g[j]);
                        *(f32x4*)(U + (size_t)r * 256 + (pn - 5) * 128 + wc * 32 + n * 16 + 4 * fq) = o; }
                }
                asm volatile("" ::: "memory");
            }
        }
    }
};
struct EpiMlaQ {
    static constexpr bool PERM = false;
    bf16* QM; const float* STQ; const f32x2* ROPE;
    __device__ __forceinline__ void operator()(const AccT& acc, const pg8::Unit& u, int wr, int wc, int fr, int fq) const {
#pragma unroll
        for (int ai = 0; ai < 2; ++ai) {
            if (u.pm * 256 + ai * 128 >= T) continue;
#pragma unroll
            for (int m = 0; m < 4; ++m) {
                const int r = u.pm * 256 + ai * 128 + wr * 64 + m * 16 + fr;
                const int bb = r / L, p = r - bb * L; const size_t ar = (size_t)bb * LP + p + PADF;
                const f32x4 st = *(const f32x4*)(STQ + (size_t)r * 4);
                const float rs = MLAQ_SCALE * __builtin_amdgcn_rsqf(((st.x + st.y) + (st.z + st.w)) * (1.f / 256.f) + RMS_EPS);
#pragma unroll
                for (int bj = 0; bj < 2; ++bj) {
                    const int G = 8 * u.pn + 4 * bj + wc, head = G / 3, part = G - 3 * head;
                    f32x4 v0 = acc[ai][bj][m][0] * rs, v1 = acc[ai][bj][m][1] * rs;
                    if (part == 2) {
#pragma unroll
                        for (int j = 0; j < 4; ++j) { const f32x2 cs = ROPE[p * 16 + 4 * fq + j]; const float x1 = v0[j], x2 = v1[j]; v0[j] = x1 * cs.x - x2 * cs.y; v1[j] = x1 * cs.y + x2 * cs.x; }
                    }
                    bf16* dst = QM + ar * 768 + head * 96 + part * 32 + 4 * fq;
                    *(v2u*)dst = pk4(v0); *(v2u*)(dst + 16) = pk4(v1);
                }
                asm volatile("" ::: "memory");
            }
        }
    }
};
struct EpiMlaKV {
    static constexpr bool PERM = false;
    bf16 *KM, *VM; const float* STKV;
    __device__ __forceinline__ void operator()(const AccT& acc, const pg8::Unit& u, int wr, int wc, int fr, int fq) const {
#pragma unroll
        for (int ai = 0; ai < 2; ++ai) {
            if (u.pm * 256 + ai * 128 >= T) continue;
#pragma unroll
            for (int m = 0; m < 4; ++m) {
                const int r = u.pm * 256 + ai * 128 + wr * 64 + m * 16 + fr;
                const int bb = r / L, p = r - bb * L; const size_t ar = (size_t)bb * LP + p + PADF;
                const f32x4 st = *(const f32x4*)(STKV + (size_t)r * 4);
                const float rs = __builtin_amdgcn_rsqf(((st.x + st.y) + (st.z + st.w)) * (1.f / 128.f) + RMS_EPS);
#pragma unroll
                for (int bj = 0; bj < 2; ++bj) {
                    const int G = 8 * u.pn + 4 * bj + wc, head = G >> 2, part = G & 3;
                    bf16* dst = part < 2 ? KM + ar * 768 + head * 96 + part * 32 + 4 * fq : VM + ar * 512 + head * 64 + (part - 2) * 32 + 4 * fq;
                    *(v2u*)dst = pk4(acc[ai][bj][m][0] * rs); *(v2u*)(dst + 16) = pk4(acc[ai][bj][m][1] * rs);
                }
                asm volatile("" ::: "memory");
            }
        }
    }
};
struct EpiMla {
    static constexpr bool PERM = false;
    EpiMlaQ q; EpiMlaKV kv;
    __device__ __forceinline__ void operator()(const AccT& acc, const pg8::Unit& u, int wr, int wc, int fr, int fq) const { if (u.kind == 0) q(acc, u, wr, wc, fr, fq); else kv(acc, u, wr, wc, fr, fq); }
};
struct MlaOrder {
    pg8::StaticOrder sq, sk; int G, c;
    __device__ __forceinline__ bool next(int i, pg8::Unit& u) const {
        const int Lx = i * G + c;
        if (Lx < sq.nwg) { pg8::StaticOrder s = sq; s.G = 1; s.c = 0; const bool ok = s.next(Lx, u); u.kind = 0; return ok; }
        if (Lx - sq.nwg < sk.nwg) { pg8::StaticOrder s = sk; s.G = 1; s.c = 0; const bool ok = s.next(Lx - sq.nwg, u); u.kind = 1; return ok; }
        return false;
    }
};
struct EpiOut {
    static constexpr bool PERM = false;
    const bf16* HBr; float* Z;
    __device__ __forceinline__ void operator()(const AccT& acc, const pg8::Unit& u, int wr, int wc, int fr, int fq) const {
#pragma unroll
        for (int ai = 0; ai < 2; ++ai) {
            if (u.pm * 256 + ai * 128 >= T) continue;
#pragma unroll
            for (int m = 0; m < 4; ++m) {
                const size_t off = (size_t)(u.pm * 256 + ai * 128 + wr * 64 + m * 16 + fr) * D + u.pn * 256 + wc * 32 + 4 * fq;
#pragma unroll
                for (int bj = 0; bj < 2; ++bj)
#pragma unroll
                    for (int n = 0; n < 2; ++n) { const v2u hw = *(const v2u*)(HBr + off + bj * 128 + n * 16); const f32x4 h = (f32x4){bflo(hw.x), bfhi(hw.x), bflo(hw.y), bfhi(hw.y)}; *(f32x4*)(Z + off + bj * 128 + n * 16) = h * ALPHA + acc[ai][bj][m][n]; }
                asm volatile("" ::: "memory");
            }
        }
    }
};
struct EpiOutTail {
    static constexpr bool PERM = false;
    float* ZP;
    __device__ __forceinline__ void operator()(const AccT& acc, const pg8::Unit& u, int wr, int wc, int fr, int fq) const {
        float* base = ZP + (size_t)(u.ko >> 8) * 128 * D;
#pragma unroll
        for (int m = 0; m < 4; ++m) {
            const size_t off = (size_t)(wr * 64 + m * 16 + fr) * D + u.pn * 256 + wc * 32 + 4 * fq;
#pragma unroll
            for (int bj = 0; bj < 2; ++bj)
#pragma unroll
                for (int n = 0; n < 2; ++n) *(f32x4*)(base + off + bj * 128 + n * 16) = acc[0][bj][m][n];
        }
    }
};
struct TailOrder {
    int vcu;
    __device__ __forceinline__ bool next(int i, pg8::Unit& u) const { if (i > 0 || (vcu & 15) != 0) return false; const int j = vcu >> 4; u.pm = 64; u.pn = j & 3; u.pb = j & 3; u.ko = (j >> 2) * 256; u.kind = 0; return true; }
    __device__ __forceinline__ void a_ready(const pg8::Unit&) const {}
    __device__ __forceinline__ const LAS int* rowlist(int) const { return nullptr; }
};
__device__ __forceinline__ void store16_wt(void* p, v4u v) { asm volatile("global_store_dwordx4 %0, %1, off sc1\n\ts_nop 1" :: "v"(p), "v"(v) : "memory"); }
struct EpiMoe1 {
    static constexpr bool PERM = true;
    bf16* ACT; const float* BGU; unsigned* rdy;
    mutable int pend = -1;
    __device__ __forceinline__ void flush(int fr, int fq, bool drain_all) const {
        if (pend < 0) return;
        if (drain_all) asm volatile("s_waitcnt vmcnt(0)" ::: "memory"); else asm volatile("s_waitcnt vmcnt(8)" ::: "memory");
        if (fr == 0 && fq == 0) __hip_atomic_fetch_add(rdy + 16 * pend, 1u, __ATOMIC_RELAXED, __HIP_MEMORY_SCOPE_AGENT);
        pend = -1;
    }
    __device__ __forceinline__ void operator()(const AccT& acc, const pg8::Unit& u, int wr, int wc, int fr, int fq) const {
        flush(fr, fq, false);
        const int c8 = wc * 32 + 8 * fq; const float* bp = BGU + (size_t)u.pb * 256 + c8;
        f32x4 bg[2], bu[2];
#pragma unroll
        for (int n = 0; n < 2; ++n) { bg[n] = *(const f32x4*)(bp + 4 * n); bu[n] = *(const f32x4*)(bp + 128 + 4 * n); }
#pragma unroll
        for (int ai = 0; ai < 2; ++ai)
#pragma unroll
            for (int m = 0; m < 4; ++m) {
                bf16* dst = ACT + (size_t)(u.pm * 256 + ai * 128 + wr * 64 + m * 16 + fr) * FF + u.pn * 128 + c8;
                f32x4 o[2];
#pragma unroll
                for (int n = 0; n < 2; ++n) { const f32x4 g = acc[ai][0][m][n] + bg[n], up = acc[ai][1][m][n] + bu[n];
#pragma unroll
                    for (int j = 0; j < 4; j += 2) { f32x2 gg, uu; gg.x = fminf(g[j], 7.0f); gg.y = fminf(g[j + 1], 7.0f); uu.x = __builtin_amdgcn_fmed3f(up[j], -7.0f, 7.0f); uu.y = __builtin_amdgcn_fmed3f(up[j + 1], -7.0f, 7.0f);
                        const f32x2 t = gg * (-1.702f * LOG2E); f32x2 e; e.x = __builtin_amdgcn_exp2f(t.x); e.y = __builtin_amdgcn_exp2f(t.y);
                        const f32x2 d = e + 1.0f; f32x2 r; r.x = __builtin_amdgcn_rcpf(d.x); r.y = __builtin_amdgcn_rcpf(d.y);
                        const f32x2 res = (uu + 1.0f) * (gg * r); o[n][j] = res.x; o[n][j + 1] = res.y; } }
                v4u w; w.x = cvtpk_rne(o[0].x, o[0].y); w.y = cvtpk_rne(o[0].z, o[0].w); w.z = cvtpk_rne(o[1].x, o[1].y); w.w = cvtpk_rne(o[1].z, o[1].w);
                store16_wt(dst, w);
            }
        pend = u.pm;
    }
};
struct EpiMoe2 {
    static constexpr bool PERM = true;
    bf16* YS; const float* BD;
    __device__ __forceinline__ void operator()(const AccT& acc, const pg8::Unit& u, int wr, int wc, int fr, int fq) const {
        const int c8 = wc * 32 + 8 * fq; const float* bp = BD + (size_t)u.pb * 256 + c8;
        f32x4 bv[2][2];
#pragma unroll
        for (int bj = 0; bj < 2; ++bj)
#pragma unroll
            for (int n = 0; n < 2; ++n) bv[bj][n] = *(const f32x4*)(bp + bj * 128 + 4 * n);
#pragma unroll
        for (int ai = 0; ai < 2; ++ai)
#pragma unroll
            for (int m = 0; m < 4; ++m) {
                bf16* dst = YS + (size_t)(u.pm * 256 + ai * 128 + wr * 64 + m * 16 + fr) * D + u.pn * 256 + c8;
#pragma unroll
                for (int bj = 0; bj < 2; ++bj) { const f32x4 v0 = acc[ai][bj][m][0] + bv[bj][0], v1 = acc[ai][bj][m][1] + bv[bj][1];
                    v4u w; w.x = cvtpk_rne(v0.x, v0.y); w.y = cvtpk_rne(v0.z, v0.w); w.z = cvtpk_rne(v1.x, v1.y); w.w = cvtpk_rne(v1.z, v1.w);
                    *(v4u*)(dst + bj * 128) = w; }
                asm volatile("" ::: "memory");
            }
    }
};

struct EpiMoe12 {
    static constexpr bool PERM = true;
    EpiMoe1 e1; EpiMoe2 e2;
    __device__ __forceinline__ void operator()(const AccT& acc, const pg8::Unit& u, int wr, int wc, int fr, int fq) const { if (u.kind == 0) e1(acc, u, wr, wc, fr, fq); else { e1.flush(fr, fq, false); e2(acc, u, wr, wc, fr, fq); } }
};
#ifndef MOE_GM
#define MOE_GM 4
#endif
struct MoeOrder {
    const LAS int* tb; int G, vcu;
    __device__ __forceinline__ bool next(int i, pg8::Unit& u) const {
        const int TM = tb[NE]; int Lx = i * G + vcu; if (Lx >= TM * 12) return false;
        const int kind = Lx >= TM * 8 ? 1 : 0, NT = kind ? 4 : 8; if (kind) Lx -= TM * 8;
        constexpr int GM = MOE_GM;
        const int grp = Lx / (GM * NT), rem = Lx - grp * GM * NT, gs = (TM - GM * grp) < GM ? (TM - GM * grp) : GM;
        const int pn = rem / gs, pm = GM * grp + (rem - pn * gs);
        int e = 0;
#pragma unroll 1
        for (int k = 1; k < NE; ++k) e += (tb[k] <= pm) ? 1 : 0;
        u.pm = pm; u.pn = pn; u.pb = e * NT + pn; u.ko = 0; u.kind = kind; return true;
    }
};
__device__ __forceinline__ void moe_tile_prefix(Frame& F, int l, LAS int* tb) {
    if (F.tid == 0) { int s = 0; for (int e = 0; e < NE; ++e) { tb[e] = s; s += ((int)__hip_atomic_load(F.ctl + CW_CNT + l * 64 + e, RLX_AGENT) + 255) >> 8; } tb[NE] = s; }
    __syncthreads();
}

constexpr int CONV_RUN = 9;
__device__ __forceinline__ void phase_norm_conv(Frame& F, KArgs A, int l) {
    unsigned char* ws = F.ws; int lane = F.lane; asm volatile("" : "+v"(lane));
    LAS float* cw = (LAS float*)(F.lds + RING_OFF);
    const float* cwg = A->in[I_CONVW] + (size_t)l * CONVK * 256;
    for (int i = F.wave * 64 + lane; i < 47 * 256; i += NWAVES * 64) { const int k = (i >> 8) - 8; cw[i] = (k >= 0 && k < CONVK) ? cwg[k * 256 + (i & 255)] : 0.f; }
    __syncthreads();
    const bf16* OATT = (const bf16*)(ws + WS_OATT); const float* U = (const float*)(ws + WS_U); bf16* Y = (bf16*)(ws + WS_Y);
    const f32x4 cb = *(const f32x4*)(A->in[I_CONVB] + l * 256 + 4 * lane), lg = *(const f32x4*)(A->in[I_CLNG] + l * 256 + 4 * lane), lb = *(const f32x4*)(A->in[I_CLNB] + l * 256 + 4 * lane);
    const int gw = F.vcu * NWAVES + F.wave, wpb = (F.G * NWAVES) / BATCH;
    const LAS f32x4* cwl = (const LAS f32x4*)(cw + 4 * lane);
    if (gw < wpb * BATCH) {
        const int b = gw / wpb, wi = gw - b * wpb, ps = (wi * L) / wpb, pe = ((wi + 1) * L) / wpb;
        const size_t rb = (size_t)b * L;
#pragma unroll 1
        for (int p0 = ps; p0 < pe; p0 += CONV_RUN) {
            const int n = (pe - p0) < CONV_RUN ? (pe - p0) : CONV_RUN;
            f32x4 acc[CONV_RUN];
#pragma unroll
            for (int i = 0; i < CONV_RUN; ++i) acc[i] = cb;
#pragma unroll 1
            for (int c = 0; c < 3; ++c) {
                f32x4 u[13];
#pragma unroll
                for (int jj = 0; jj < 13; ++jj) { const int j = -(CONVK - 1) + c * 13 + jj; int pr = p0 + j; const bool ok = pr >= 0; pr = pr < 0 ? 0 : (pr > L - 1 ? L - 1 : pr);
                    u[jj] = *(const f32x4*)(U + (rb + pr) * 256 + 4 * lane); if (!ok) u[jj] = (f32x4){0.f, 0.f, 0.f, 0.f}; }
                const LAS f32x4* wc = cwl + (c * 13) * 64;
#pragma unroll
                for (int jj = 0; jj < 13; ++jj)
#pragma unroll
                    for (int i = 0; i < CONV_RUN; ++i) acc[i] += u[jj] * wc[(jj - i + 8) * 64];
            }
#pragma unroll
            for (int i0 = 0; i0 < CONV_RUN; i0 += 3) {
                f32x4 o[3][3];
#pragma unroll
                for (int ii = 0; ii < 3; ++ii) { const int i = (i0 + ii) < n ? (i0 + ii) : 0;
#pragma unroll
                    for (int j = 0; j < 3; ++j) { const v2u w = *(const v2u*)(OATT + (rb + p0 + i) * 768 + 4 * lane + 256 * j); o[ii][j] = (f32x4){bflo(w.x), bfhi(w.x), bflo(w.y), bfhi(w.y)}; } }
#pragma unroll
                for (int ii = 0; ii < 3; ++ii) {
                    const int i = i0 + ii; const size_t r = rb + p0 + i;
                    f32x4 c = acc[i];
                    const float mu = wave_sum((c.x + c.y) + (c.z + c.w)) * (1.f / 256.f); c = c - mu;
                    const float var = wave_sum((c.x * c.x + c.y * c.y) + (c.z * c.z + c.w * c.w)) * (1.f / 256.f);
                    c = c * __builtin_amdgcn_rsqf(var + LN_EPS) * lg + lb;
#pragma unroll
                    for (int j = 0; j < 4; ++j) c[j] = c[j] * sigmoidf_(c[j]);
                    const float rc = __builtin_amdgcn_rsqf(wave_sum((c.x * c.x + c.y * c.y) + (c.z * c.z + c.w * c.w)) * (1.f / 256.f) + RMS_EPS);
                    const f32x4 o0 = o[ii][0], o1 = o[ii][1], o2 = o[ii][2];
                    const float s0 = wave_sum((o0.x * o0.x + o0.y * o0.y) + (o0.z * o0.z + o0.w * o0.w));
                    const float s1 = wave_sum(((o1.x * o1.x + o1.y * o1.y) + (o1.z * o1.z + o1.w * o1.w)) + ((o2.x * o2.x + o2.y * o2.y) + (o2.z * o2.z + o2.w * o2.w)));
                    const float r0s = __builtin_amdgcn_rsqf(s0 * (1.f / 256.f) + RMS_EPS), r1s = __builtin_amdgcn_rsqf(s1 * (1.f / 512.f) + RMS_EPS);
                    if (i < n) {
                        *(v2u*)(Y + r * D + 768 + 4 * lane) = pk4(c * rc);
                        *(v2u*)(Y + r * D + 4 * lane) = pk4(o0 * r0s);
                        *(v2u*)(Y + r * D + 256 + 4 * lane) = pk4(o1 * r1s);
                        *(v2u*)(Y + r * D + 512 + 4 * lane) = pk4(o2 * r1s);
                    }
                }
            }
        }
    }
    __syncthreads();
}

#ifndef RT_ROWS
#define RT_ROWS 4
#endif
__device__ __forceinline__ void phase_router(Frame& F, KArgs A, int l, bool dry = false) {
    typedef __attribute__((ext_vector_type(16))) float f32x16;
    unsigned char* ws = F.ws; int tid = F.tid; asm volatile("" : "+v"(tid)); const int lane = tid & 63, wave = F.wave;
    LAS float* PART = (LAS float*)(F.lds + RING_OFF);
    LAS int* lcnt = (LAS int*)(F.lds + TAIL_OFF); LAS int* lbase = lcnt + 32; LAS int* sel = lbase + 32;
    if (tid < 32) lcnt[tid] = 0;
    const int start = (int)(((long)F.vcu * T) / F.G), end = (int)(((long)(F.vcu + 1) * T) / F.G);
    const float* Z = (const float*)(ws + WS_Z); bf16* HL = (bf16*)(ws + WS_HL); bf16* HB = (bf16*)(ws + WS_HB);
    int* TOKE = (int*)(ws + WS_TOKE); int* TOKP = (int*)(ws + WS_TOKP); float* TOKG = (float*)(ws + WS_TOKG); int* LIST = (int*)(ws + WS_LIST);
    const float* lng = A->in[I_LNMIX_G] + l * D; const float* lnb = A->in[I_LNMIX_B] + l * D;
#pragma unroll 1
    for (int t0 = start + wave; t0 < end; t0 += RT_ROWS * NWAVES) {
        f32x4 v[RT_ROWS][4];
#pragma unroll
        for (int s = 0; s < RT_ROWS; ++s) { const int t = (t0 + s * NWAVES) < end ? (t0 + s * NWAVES) : t0;
#pragma unroll
            for (int j = 0; j < 4; ++j) v[s][j] = *(const f32x4*)(Z + (size_t)t * D + 4 * lane + 256 * j); }
#pragma unroll
        for (int s = 0; s < RT_ROWS; ++s) { ln_row16(v[s], lng, lnb, lane); const int t = t0 + s * NWAVES;
            if (t < end) {
#pragma unroll
                for (int j = 0; j < 4; ++j) { const v2u hw = (v2u){pk2(v[s][j].x, v[s][j].y), pk2(v[s][j].z, v[s][j].w)};
                    *(v2u*)(HB + (size_t)t * D + 4 * lane + 256 * j) = hw;
                    *(v2u*)(HL + (size_t)t * D + 4 * lane + 256 * j) = (v2u){pk2(v[s][j].x - bflo(hw.x), v[s][j].y - bfhi(hw.x)), pk2(v[s][j].z - bflo(hw.y), v[s][j].w - bfhi(hw.y))}; } } }
    }
    asm volatile("s_waitcnt vmcnt(0)" ::: "memory");
    __syncthreads();
    const bf16* rwh = (const bf16*)(ws + WS_RWT) + (size_t)l * 2 * NE * D; const bf16* rwl = rwh + NE * D;
    const int r32 = lane & 31, hi = lane >> 5;
#pragma unroll 1
    for (int g0 = start; g0 < end; g0 += 96) {
        const int ng = (end - g0) < 96 ? (end - g0) : 96;
        f32x16 acc[3]; acc[0] = f32x16{}; acc[1] = f32x16{}; acc[2] = f32x16{};
        int tok[3];
#pragma unroll
        for (int g = 0; g < 3; ++g) tok[g] = g0 + ((32 * g + r32) < ng ? (32 * g + r32) : 0);
#pragma unroll 2
        for (int ks = 0; ks < 8; ++ks) {
            const int kk = 128 * wave + 16 * ks + 8 * hi;
            const bf16x8 bh = *(const bf16x8*)(rwh + (size_t)r32 * D + kk), bl = *(const bf16x8*)(rwl + (size_t)r32 * D + kk);
#pragma unroll
            for (int g = 0; g < 3; ++g) {
                const v4u aw = *(const v4u*)(HB + (size_t)tok[g] * D + kk), lw = *(const v4u*)(HL + (size_t)tok[g] * D + kk);
                const bf16x8 ah = __builtin_bit_cast(bf16x8, aw), al = __builtin_bit_cast(bf16x8, lw);
                acc[g] = __builtin_amdgcn_mfma_f32_32x32x16_bf16(ah, bh, acc[g], 0, 0, 0);
                acc[g] = __builtin_amdgcn_mfma_f32_32x32x16_bf16(ah, bl, acc[g], 0, 0, 0);
                acc[g] = __builtin_amdgcn_mfma_f32_32x32x16_bf16(al, bh, acc[g], 0, 0, 0);
            }
        }
#pragma unroll
        for (int g = 0; g < 3; ++g)
#pragma unroll
            for (int r = 0; r < 16; ++r) PART[(wave * 96 + 32 * g + (r & 3) + 8 * (r >> 2) + 4 * hi) * 33 + r32] = acc[g][r];
        __syncthreads();
        if (tid < ng) {
            const int t = g0 + tid; float v[32];
#pragma unroll
            for (int e = 0; e < 32; ++e) { float s = A->in[I_RB][l * NE + e];
#pragma unroll
                for (int w = 0; w < 8; ++w) s += PART[(w * 96 + tid) * 33 + e];
                v[e] = s; }
            float tv[4]; int ti[4];
#pragma unroll
            for (int k = 0; k < 4; ++k) {
                float bv = -INFINITY; int bi = 0;
#pragma unroll
                for (int e = 0; e < 32; ++e) if (v[e] > bv) { bv = v[e]; bi = e; }
                tv[k] = bv; ti[k] = bi;
#pragma unroll
                for (int e = 0; e < 32; ++e) if (e == bi) v[e] = -INFINITY;
            }
            float ex[4], sum = 0.f;
#pragma unroll
            for (int k = 0; k < 4; ++k) { ex[k] = __expf(tv[k] - tv[0]); sum += ex[k]; }
            const float inv = 1.0f / sum;
            *(v4u*)(TOKE + t * 4) = (v4u){(unsigned)ti[0], (unsigned)ti[1], (unsigned)ti[2], (unsigned)ti[3]};
            *(f32x4*)(TOKG + t * 4) = (f32x4){ex[0] * inv, ex[1] * inv, ex[2] * inv, ex[3] * inv};
#pragma unroll
            for (int k = 0; k < 4; ++k) { const int rank = __hip_atomic_fetch_add(lcnt + ti[k], 1, __ATOMIC_RELAXED, __HIP_MEMORY_SCOPE_WORKGROUP);
                sel[((t - start) * 4 + k) * 2] = ti[k]; sel[((t - start) * 4 + k) * 2 + 1] = rank; }
        }
        __syncthreads();
    }
    if (tid < 32) lbase[tid] = (int)__hip_atomic_fetch_add(F.ctl + CW_CNT + (dry ? 128 : 0) + l * 64 + tid, (unsigned)lcnt[tid], RLX_AGENT);
    __syncthreads();
    if (!dry) for (int i = tid; i < (end - start) * 4; i += NWAVES * 64) { const int e = sel[i * 2], pos = lbase[e] + sel[i * 2 + 1]; TOKP[(start + (i >> 2)) * 4 + (i & 3)] = pos; LIST[(size_t)e * T + pos] = start + (i >> 2); }
    __syncthreads();
}

__device__ __forceinline__ void phase_combine(Frame& F, KArgs A, int l, bool dry = false) {
    unsigned char* ws = F.ws; int lane = F.lane; asm volatile("" : "+v"(lane));
    bf16* HB = (bf16*)(ws + WS_HB); const bf16* YS = (const bf16*)(ws + WS_YS);
    const int* TOKE = (const int*)(ws + WS_TOKE); const int* TOKP = (const int*)(ws + WS_TOKP); const float* TOKG = (const float*)(ws + WS_TOKG);
    int tiles = 0; if (lane < NE) tiles = ((int)__hip_atomic_load(F.ctl + CW_CNT + l * 64 + lane, RLX_AGENT) + 255) >> 8;
    int incl = tiles;
#pragma unroll
    for (int o = 1; o < 32; o <<= 1) { const int v = __shfl_up(incl, o); if (lane >= o) incl += v; }
    const int tbl = incl - tiles;
    const float* lng = A->in[I_LNFFN_G] + l * D; const float* lnb = A->in[I_LNFFN_B] + l * D;
    f32x4 gg[4], bb[4];
#pragma unroll
    for (int q = 0; q < 4; ++q) { const int c = 8 * lane + 512 * (q >> 1) + 4 * (q & 1); gg[q] = *(const f32x4*)(lng + c); bb[q] = *(const f32x4*)(lnb + c); }
    const int gw = F.vcu * NWAVES + F.wave, NGW = F.G * NWAVES;
#pragma unroll 1
    for (int t0 = gw; t0 < T; t0 += 2 * NGW) {
        int tt[2]; tt[0] = t0; tt[1] = (t0 + NGW) < T ? (t0 + NGW) : t0; const bool ok1 = (t0 + NGW) < T;
        f32x4 v[2][4]; v4u y[2][4][2]; float g[2][4];
#pragma unroll
        for (int s = 0; s < 2; ++s) {
            const int t = tt[s];
            const v4u e4 = *(const v4u*)(TOKE + t * 4), p4 = *(const v4u*)(TOKP + t * 4); const f32x4 g4 = *(const f32x4*)(TOKG + t * 4);
#pragma unroll
            for (int jj = 0; jj < 2; ++jj) { const v4u hw = *(const v4u*)(HB + (size_t)t * D + 8 * lane + 512 * jj); v[s][2 * jj] = (f32x4){bflo(hw.x), bfhi(hw.x), bflo(hw.y), bfhi(hw.y)}; v[s][2 * jj + 1] = (f32x4){bflo(hw.z), bfhi(hw.z), bflo(hw.w), bfhi(hw.w)}; }
#pragma unroll
            for (int k = 0; k < 4; ++k) { const size_t row = (size_t)__shfl(tbl, (int)e4[k]) * 256 + p4[k]; g[s][k] = g4[k];
#pragma unroll
                for (int jj = 0; jj < 2; ++jj) y[s][k][jj] = *(const v4u*)(YS + row * D + 8 * lane + 512 * jj); }
        }
#pragma unroll
        for (int s = 0; s < 2; ++s) {
#pragma unroll
            for (int q = 0; q < 4; ++q) v[s][q] = v[s][q] * ALPHA;
#pragma unroll
            for (int k = 0; k < 4; ++k)
#pragma unroll
                for (int jj = 0; jj < 2; ++jj) { const v4u w = y[s][k][jj]; const float gk = g[s][k];
                    v[s][2 * jj] += (f32x4){bflo(w.x), bfhi(w.x), bflo(w.y), bfhi(w.y)} * gk; v[s][2 * jj + 1] += (f32x4){bflo(w.z), bfhi(w.z), bflo(w.w), bfhi(w.w)} * gk; }
            float sm = 0.f;
#pragma unroll
            for (int q = 0; q < 4; ++q) sm += (v[s][q].x + v[s][q].y) + (v[s][q].z + v[s][q].w);
            const float mean = wave_sum(sm) * (1.f / D); float s2 = 0.f;
#pragma unroll
            for (int q = 0; q < 4; ++q) { v[s][q] = v[s][q] - mean; s2 += (v[s][q].x * v[s][q].x + v[s][q].y * v[s][q].y) + (v[s][q].z * v[s][q].z + v[s][q].w * v[s][q].w); }
            const float rstd = __builtin_amdgcn_rsqf(wave_sum(s2) * (1.f / D) + LN_EPS);
#pragma unroll
            for (int q = 0; q < 4; ++q) v[s][q] = v[s][q] * rstd * gg[q] + bb[q];
            if (s == 0 || ok1) {
                const int t = tt[s];
                if (dry) { bf16* ob = (bf16*)(ws + WS_Z) + (size_t)t * D + 8 * lane;
#pragma unroll
                    for (int jj = 0; jj < 2; ++jj) *(v4u*)(ob + 512 * jj) = (v4u){pk2(v[s][2 * jj].x, v[s][2 * jj].y), pk2(v[s][2 * jj].z, v[s][2 * jj].w), pk2(v[s][2 * jj + 1].x, v[s][2 * jj + 1].y), pk2(v[s][2 * jj + 1].z, v[s][2 * jj + 1].w)};
                } else if (l == DEPTH - 1) {
                    const int bi = t / L, pp = t - bi * L;
                    if (pp >= NMETA) { float* o = F.out + ((size_t)bi * SEQ + (pp - NMETA)) * D + 8 * lane;
#pragma unroll
                        for (int q = 0; q < 4; ++q) *(f32x4*)(o + 512 * (q >> 1) + 4 * (q & 1)) = v[s][q]; }
                } else {
                    bf16* ob = HB + (size_t)t * D + 8 * lane;
#pragma unroll
                    for (int jj = 0; jj < 2; ++jj) *(v4u*)(ob + 512 * jj) = (v4u){pk2(v[s][2 * jj].x, v[s][2 * jj].y), pk2(v[s][2 * jj].z, v[s][2 * jj].w), pk2(v[s][2 * jj + 1].x, v[s][2 * jj + 1].y), pk2(v[s][2 * jj + 1].z, v[s][2 * jj + 1].w)};
                }
            }
        }
    }
}
}
namespace att {
using namespace mk;
typedef __attribute__((ext_vector_type(4))) short s16x4;
typedef __attribute__((ext_vector_type(16))) float f32x16;
typedef short v4i16_t __attribute__((ext_vector_type(4)));
typedef LAS const char* lds_cptr;
constexpr int KSLOT = 12288, VSLOT = 8192;
constexpr int NSLOT = 3;
constexpr int A_K = 0, A_V = NSLOT * KSLOT, A_WS = A_V + NSLOT * VSLOT, A_Q = A_WS + NWAVES * 256, A_BYTES = A_Q + 64;
constexpr float NEGBIG = -1.0e30f;
__device__ __forceinline__ int crow(int r, int hi) { return (r & 3) + 8 * (r >> 2) + 4 * hi; }
__device__ __forceinline__ void glds16(const void* gsrc, unsigned lds_dst) { unsigned keep;
    asm volatile("s_mov_b32 %0, m0\n\ts_mov_b32 m0, %2\n\ts_nop 0\n\tglobal_load_lds_dwordx4 %1, off\n\ts_mov_b32 m0, %0" : "=&s"(keep) : "v"(gsrc), "s"(lds_dst) : "memory"); }
__device__ __forceinline__ s16x4 vtr(lds_cptr p) { return __builtin_bit_cast(s16x4, __builtin_amdgcn_ds_read_tr16_b64_v4i16((LAS v4i16_t*)p)); }
__device__ __forceinline__ unsigned cvtpk(float lo, float hi) { typedef float f2 __attribute__((ext_vector_type(2))); typedef __bf16 b2 __attribute__((ext_vector_type(2))); f2 v = {lo, hi}; b2 b = __builtin_convertvector(v, b2); return __builtin_bit_cast(unsigned, b); }
__device__ __forceinline__ float max3f(float a, float b, float c) { float r; asm("v_max3_f32 %0, %1, %2, %3" : "=v"(r) : "v"(a), "v"(b), "v"(c)); return r; }
__device__ __forceinline__ float min2f(float a, float b) { float r; asm("v_min_f32_e32 %0, %1, %2" : "=v"(r) : "v"(a), "v"(b)); return r; }
#define ATT_WAIT_BAR(N) asm volatile("s_waitcnt vmcnt(" #N ") lgkmcnt(0)\n\ts_barrier" ::: "memory")

template <int MODE>
__device__ __forceinline__ void attn_unit(int b, int h, int qb  , const bf16* Q, const bf16* Kg, const bf16* Vg, bf16* OATT, char* shm) {
    constexpr int DQK = MODE == 0 ? 64 : 96, NKS = DQK / 16, NCH = DQK / 8;
    constexpr int QP = MODE == 0 ? 256 : 768, VP = MODE == 0 ? 256 : 512;
    int tid = threadIdx.x; asm volatile("" : "+v"(tid));
    const int lane = tid & 63, r32 = lane & 31, hi = lane >> 5; const int wid = __builtin_amdgcn_readfirstlane(tid >> 6);
    const int q0 = qb < 0 ? 0 : 64 + 256 * qb;
    const int NT = qb < 0 ? 1 : 4 * qb + 5;
    const size_t rowbase = (size_t)b * LP;
    const bf16* Qw = Q + (rowbase + q0 + wid * 32) * QP + h * DQK;
    const bf16* Kh = Kg + rowbase * QP + h * DQK; const bf16* Vh = Vg + rowbase * VP + h * 64;
    const unsigned lds0 = (unsigned)(uintptr_t)shm;
    LAS float* wsf = (LAS float*)(shm + A_WS) + wid * 64;
    const bf16* ksrc0 = Kh + (size_t)lane * QP + wid * 8; const bf16* ksrc1 = ksrc0 + 64;
    const bf16* vsrc = Vh + (size_t)(16 * (wid & 3) + (lane >> 2)) * VP + (wid >> 2) * 32 + (lane & 3) * 8;
    const unsigned kdst = lds0 + A_K + wid * 1024, vdst = lds0 + A_V + wid * 1024;
#define DMA_TILE(t, slot) do { glds16(ksrc0 + (size_t)(t) * 64 * QP, (unsigned)__builtin_amdgcn_readfirstlane(kdst + (slot) * KSLOT)); \
        if (NCH > 8 && wid < NCH - 8) glds16(ksrc1 + (size_t)(t) * 64 * QP, (unsigned)__builtin_amdgcn_readfirstlane(kdst + (slot) * KSLOT + 8192)); \
        glds16(vsrc + (size_t)(t) * 64 * VP, (unsigned)__builtin_amdgcn_readfirstlane(vdst + (slot) * VSLOT)); } while (0)
    const lds_cptr shm3 = (lds_cptr)shm;
    const lds_cptr kp0 = shm3 + A_K + hi * 1024 + r32 * 16;
    const lds_cptr vp0 = shm3 + A_V + ((lane >> 4) & 1) * 32 + (lane & 3) * 8 + (4 * hi + ((lane & 15) >> 2)) * 64;
    bf16x8 qr[NKS];
#pragma unroll
    for (int d0 = 0; d0 < NKS; ++d0) qr[d0] = *(const bf16x8*)(Qw + (size_t)r32 * QP + d0 * 16 + hi * 8);
    DMA_TILE(NT - 1, 0);
    if (NT > 1) DMA_TILE(NT - 2, 1);
#pragma unroll
    for (int d0 = 0; d0 < NKS; ++d0) asm volatile("" : "+v"(qr[d0]));
    const bool npt3 = (MODE == 1) && (wid < NCH - 8);
    f32x16 o[2]; o[0] = f32x16{}; o[1] = f32x16{};
    float mrun = NEGBIG, lrun = MODE == 0 ? 1.0f : 0.f;
    const int qpos = q0 + wid * 32 + r32;
    bf16x8 kf[2 * NKS];
#define LOAD_KF(slot_) do { const lds_cptr kb_ = kp0 + (slot_) * KSLOT; _Pragma("unroll") for (int d0 = 0; d0 < NKS; ++d0) { kf[2 * d0] = *(const LAS bf16x8*)(kb_ + d0 * 2048); kf[2 * d0 + 1] = *(const LAS bf16x8*)(kb_ + d0 * 2048 + 512); } } while (0)
    if (NT > 1) { if (npt3) ATT_WAIT_BAR(3); else ATT_WAIT_BAR(2); } else ATT_WAIT_BAR(0);
    LOAD_KF(0);
    int cur = 0, nx1 = 1, nx2 = 2;
    for (int i = 0; i < NT; ++i) {
        const int t = NT - 1 - i;
        ATT_WAIT_BAR(0);
        if (i + 2 < NT) DMA_TILE(t - 2, nx2);
        const int slot = cur, slot1 = nx1; cur = nx1; nx1 = nx2; nx2 = nx2 == NSLOT - 1 ? 0 : nx2 + 1;
        const bool band = (64 * t + 63 >= q0);
        const bool skip = band && (64 * t > q0 + wid * 32 + 31 - (MODE == 0 ? 1 : 0));
        if (skip) { if (i + 1 < NT) LOAD_KF(slot1); continue; }
        f32x16 p0 = f32x16{}, p1 = f32x16{};
#pragma unroll
        for (int d0 = 0; d0 < NKS; ++d0) { p0 = __builtin_amdgcn_mfma_f32_32x32x16_bf16(kf[2 * d0], qr[d0], p0, 0, 0, 0); p1 = __builtin_amdgcn_mfma_f32_32x32x16_bf16(kf[2 * d0 + 1], qr[d0], p1, 0, 0, 0); }
        const lds_cptr vp = vp0 + slot * VSLOT; s16x4 vlo[4], vhh[4];
#pragma unroll
        for (int ks = 0; ks < 4; ++ks) { vlo[ks] = vtr(vp + ks * 1024); vhh[ks] = vtr(vp + ks * 1024 + 512); }
        __builtin_amdgcn_sched_barrier(0);
        if (band || t == 0) {
            const int kb0 = 64 * t + 4 * hi;
#pragma unroll
            for (int r = 0; r < 16; ++r) { const int kv = kb0 + (r & 3) + 8 * (r >> 2);
                const bool m0 = (MODE == 0 ? kv >= qpos : kv > qpos) || kv < PADF, m1 = (MODE == 0 ? kv + 32 >= qpos : kv + 32 > qpos) || (kv + 32) < PADF;
                if (m0) p0[r] = NEGBIG; if (m1) p1[r] = NEGBIG; }
        }
        if (MODE == 1) {
            float rm = max3f(p0[0], p1[0], p0[1]), rm2 = max3f(p1[1], p0[2], p1[2]);
#pragma unroll
            for (int r = 3; r < 15; r += 2) { rm = max3f(rm, p0[r], p1[r]); rm2 = max3f(rm2, p0[r + 1], p1[r + 1]); }
            rm = max3f(rm, p0[15], p1[15]); rm = max3f(rm, rm2, rm2);
            { auto rr = __builtin_amdgcn_permlane32_swap(__float_as_uint(rm), __float_as_uint(rm), false, false); rm = fmaxf(__uint_as_float(rr[0]), __uint_as_float(rr[1])); }
            if (__any(rm > mrun + 8.0f)) {
                const float mn = fmaxf(mrun, rm), f = __builtin_amdgcn_exp2f(mrun - mn); mrun = mn; lrun *= f;
                if (hi == 0) wsf[r32] = f;
                LDS_WAIT();
#pragma unroll
                for (int r = 0; r < 16; ++r) { const float fr_ = wsf[crow(r, hi)]; o[0][r] *= fr_; o[1][r] *= fr_; }
            }
            float sacc = 0.f;
#pragma unroll
            for (int r = 0; r < 16; ++r) { p0[r] = __builtin_amdgcn_exp2f(p0[r] - mrun); p1[r] = __builtin_amdgcn_exp2f(p1[r] - mrun); sacc += p0[r] + p1[r]; }
            lrun += sacc;
        } else {
            f32x16 a0, a1;
#pragma unroll
            for (int r = 0; r < 16; ++r) { p0[r] = __builtin_amdgcn_exp2f(min2f(p0[r], 80.0f)); p1[r] = __builtin_amdgcn_exp2f(min2f(p1[r], 80.0f));
                a0[r] = __builtin_amdgcn_rcpf(1.0f + p0[r]); a1[r] = __builtin_amdgcn_rcpf(1.0f + p1[r]); }
            float seg[16];
#pragma unroll
            for (int k = 0; k < 4; ++k) {
                const float s0 = (a0[4 * k] * a0[4 * k + 1]) * (a0[4 * k + 2] * a0[4 * k + 3]), s1 = (a1[4 * k] * a1[4 * k + 1]) * (a1[4 * k + 2] * a1[4 * k + 3]);
                auto r0 = __builtin_amdgcn_permlane32_swap(__float_as_uint(s0), __float_as_uint(s0), false, false);
                auto r1 = __builtin_amdgcn_permlane32_swap(__float_as_uint(s1), __float_as_uint(s1), false, false);
                seg[2 * k] = __uint_as_float(r0[0]); seg[2 * k + 1] = __uint_as_float(r0[1]); seg[8 + 2 * k] = __uint_as_float(r1[0]); seg[8 + 2 * k + 1] = __uint_as_float(r1[1]);
            }
            float run = lrun; float sfx[16];
#pragma unroll
            for (int g = 15; g >= 0; --g) { sfx[g] = run; run *= seg[g]; }
            lrun = run;
#pragma unroll
            for (int k = 0; k < 4; ++k) {
                float c0 = hi ? sfx[2 * k + 1] : sfx[2 * k], c1 = hi ? sfx[8 + 2 * k + 1] : sfx[8 + 2 * k];
#pragma unroll
                for (int j = 3; j >= 0; --j) { c0 *= a0[4 * k + j]; p0[4 * k + j] *= c0; c1 *= a1[4 * k + j]; p1[4 * k + j] *= c1; }
            }
        }
        v4u pw[4];
        pw[0] = (v4u){cvtpk(p0[0], p0[1]), cvtpk(p0[2], p0[3]), cvtpk(p0[4], p0[5]), cvtpk(p0[6], p0[7])};
        pw[1] = (v4u){cvtpk(p0[8], p0[9]), cvtpk(p0[10], p0[11]), cvtpk(p0[12], p0[13]), cvtpk(p0[14], p0[15])};
        pw[2] = (v4u){cvtpk(p1[0], p1[1]), cvtpk(p1[2], p1[3]), cvtpk(p1[4], p1[5]), cvtpk(p1[6], p1[7])};
        pw[3] = (v4u){cvtpk(p1[8], p1[9]), cvtpk(p1[10], p1[11]), cvtpk(p1[12], p1[13]), cvtpk(p1[14], p1[15])};
        __builtin_amdgcn_sched_barrier(0);
        s16x4 wlo[4], whh[4];
#pragma unroll
        for (int ks = 0; ks < 4; ++ks) { wlo[ks] = vtr(vp + 4096 + ks * 1024); whh[ks] = vtr(vp + 4096 + ks * 1024 + 512); }
#pragma unroll
        for (int ks = 0; ks < 4; ++ks) { const bf16x8 vf = (bf16x8){vlo[ks][0], vlo[ks][1], vlo[ks][2], vlo[ks][3], vhh[ks][0], vhh[ks][1], vhh[ks][2], vhh[ks][3]};
            o[0] = __builtin_amdgcn_mfma_f32_32x32x16_bf16(__builtin_bit_cast(bf16x8, pw[ks]), vf, o[0], 0, 0, 0); }
        __builtin_amdgcn_sched_barrier(0);
        if (i + 1 < NT) LOAD_KF(slot1);
#pragma unroll
        for (int ks = 0; ks < 4; ++ks) { const bf16x8 vf = (bf16x8){wlo[ks][0], wlo[ks][1], wlo[ks][2], wlo[ks][3], whh[ks][0], whh[ks][1], whh[ks][2], whh[ks][3]};
            o[1] = __builtin_amdgcn_mfma_f32_32x32x16_bf16(__builtin_bit_cast(bf16x8, pw[ks]), vf, o[1], 0, 0, 0); }
    }
#undef LOAD_KF
    if (MODE == 1) {
        { auto rr = __builtin_amdgcn_permlane32_swap(__float_as_uint(lrun), __float_as_uint(lrun), false, false); lrun = __uint_as_float(rr[0]) + __uint_as_float(rr[1]); }
        if (hi == 0) wsf[32 + r32] = lrun;
        LDS_WAIT();
    }
    bf16* Ow = OATT + (size_t)(MODE == 0 ? 0 : 256) + h * 64 + r32;
#pragma unroll
    for (int r = 0; r < 16; ++r) {
        const int pp = q0 + wid * 32 + crow(r, hi);
        const float sc = MODE == 1 ? __builtin_amdgcn_rcpf(wsf[32 + crow(r, hi)]) : 1.0f;
        const bool valid = qb < 0 ? (pp >= PADF && pp < 64) : true;
        if (valid) { bf16* dst = Ow + ((size_t)b * L + (pp - PADF)) * 768; dst[0] = (bf16)f2bf(o[0][r] * sc); dst[32] = (bf16)f2bf(o[1][r] * sc); }
    }
    asm volatile("s_waitcnt lgkmcnt(0)\n\ts_barrier" ::: "memory");
#undef DMA_TILE
}

#ifndef MK_CONV_PER_UNIT
#define MK_CONV_PER_UNIT 2
#endif
__device__ __forceinline__ void attn_phase(Frame& F, KArgs A, int l, int qi  , char* shm) {
    unsigned char* ws = F.ws;
    LAS int* qw = (LAS int*)((LAS char*)F.lds + A_Q);
    bf16* OATT = (bf16*)(ws + WS_OATT);
    LAS float* scr = (LAS float*)(F.lds + RING_OFF + F.wave * 8448);
    bool conv_left = true;
    for (;;) {
        if (F.tid == 0) *qw = (int)__hip_atomic_fetch_add(F.ctl + CW_AQ + qi * 64, 1u, RLX_AGENT);
        __syncthreads();
        const int u = __builtin_amdgcn_readfirstlane(*qw);
        const bool have = u < 9 * 96;
        if (have) {
            const int level = u / 96, w = u - level * 96, qb = 7 - level;
            if (w < 64) attn_unit<1>(w >> 3, w & 7, qb, (const bf16*)(ws + WS_QM), (const bf16*)(ws + WS_KM), (const bf16*)(ws + WS_VM), OATT, shm);
            else attn_unit<0>((w - 64) >> 2, (w - 64) & 3, qb, (const bf16*)(ws + WS_SBQ), (const bf16*)(ws + WS_SBK), (const bf16*)(ws + WS_SBV), OATT, shm);
        }
        for (int c = 0; conv_left && c < MK_CONV_PER_UNIT; ++c) {
            __syncthreads();
            if (F.tid == 0) *qw = (int)__hip_atomic_fetch_add(F.ctl + CW_CONV + l * 8, 1u, RLX_AGENT);
            __syncthreads();
            const int ch = __builtin_amdgcn_readfirstlane(*qw);
            if (ch >= CONV_NCHUNK) { conv_left = false; break; }
            conv_chunk(F, A, l, ch, scr);
        }
        __syncthreads();
        if (!have && !conv_left) break;
    }
    __syncthreads();
}
}
namespace mk {
constexpr int PH_PER_LAYER = 9, N_PHASES = 1 + DEPTH * PH_PER_LAYER;

__global__ void __launch_bounds__(NWAVES * 64, 2) mega_fwd(Args args) {
    extern __shared__ __attribute__((aligned(16))) unsigned char lds[];
    Frame F;
    F.lds = (LAS unsigned char*)lds;
    F.MISC = (volatile LAS unsigned*)(F.lds + MISC_OFF);
    F.tid = threadIdx.x; F.lane = F.tid & 63; F.wave = __builtin_amdgcn_readfirstlane(F.tid >> 6);
    F.G = gridDim.x; { const int bx = blockIdx.x; F.vcu = (F.G % 8 == 0) ? (bx % 8) * (F.G / 8) + bx / 8 : bx; }
    F.ws = args.ws; F.ctl = (gu32*)(args.ws + WS_CTL); F.out = args.out;
    unsigned char* ws = args.ws;
    for (int u = F.tid; u < (TAIL_OFF - LDSCTL_OFF) / 4; u += NWAVES * 64) ((LAS unsigned*)(F.lds + LDSCTL_OFF))[u] = 0u;
    __syncthreads();
    const int lo = args.ph_lo, hi = args.ph_hi;
    const bool use_bar = (hi - lo) > 1;
    XcdBarrier bar; bar.bar = (unsigned*)(F.ctl + CW_BAR); bar.x = 0; bar.st = nullptr;
    if (use_bar) bar = xcd_barrier_post((unsigned*)(F.ctl + CW_BAR), F.MISC + 8);
#ifndef MK_PT_MASK
#define MK_PT_MASK 0x3ff
#endif
#define IN(k) (lo <= (k) && (k) < hi)
#define PT(b) ((MK_PT_MASK >> (b)) & 1)
#ifndef MK_REP
#define MK_REP 0
#endif
#define REPS(b) (1 + ((MK_REP >> (b)) & 1))
#define SEAM(k) do { if (IN(k) && IN((k) + 1)) xcd_barrier(bar); } while (0)

    if (PT(0) && IN(0)) { _Pragma("unroll") for (int rep = 0; rep < REPS(0); ++rep) p0_prologue(F, kargs()); SEAM(0); }
#pragma unroll 1
    for (int l = 0; l < DEPTH; ++l) {
        const int pb = 1 + l * PH_PER_LAYER;
        const f32x2* ROPE = (const f32x2*)(ws + WS_ROPE);
        if (PT(1) && IN(pb + 0)) _Pragma("unroll") for (int rep = 0; rep < REPS(1); ++rep) {
            pg8::Gemm g{(const bf16*)(ws + WS_HB), (const bf16*)(ws + WS_WIN) + (size_t)l * NINP * D, TP, NINP, D};
            pg8::StaticOrder S; S.init(TP, NINP, F.G, (int)blockIdx.x);
            EpiInProj E{(bf16*)(ws + WS_SBQ), (bf16*)(ws + WS_SBK), (bf16*)(ws + WS_SBV), (bf16*)(ws + WS_CQ), (bf16*)(ws + WS_CKV2), (bf16*)(ws + WS_KM), (float*)(ws + WS_U), (float*)(ws + WS_STQ), (float*)(ws + WS_STKV), ROPE};
            { const pg8::ListOrder LO = pg8::make_list(S, (LAS int*)(F.lds + TAIL_OFF + 14336), nullptr); pg8::gemm_phase<EpiInProj, pg8::ListOrder, true, false>(F.lds + RING_OFF, g, LO, E); }
            SEAM(pb + 0);
        }
        if (PT(2) && IN(pb + 1)) _Pragma("unroll") for (int rep = 0; rep < REPS(2); ++rep) {
            { pg8::Gemm g{(const bf16*)(ws + WS_CQ), (const bf16*)(ws + WS_WUQ) + (size_t)l * 768 * 256, TP, 768, 256, 0, (const bf16*)(ws + WS_CKV2), (const bf16*)(ws + WS_WUKV2) + (size_t)l * 1024 * 256};
              MlaOrder S; S.sq.init(TP, 768, 1, 0); S.sk.init(TP, 1024, 1, 0); S.G = F.G; S.c = (int)blockIdx.x;
              EpiMla E{EpiMlaQ{(bf16*)(ws + WS_QM), (const float*)(ws + WS_STQ), ROPE}, EpiMlaKV{(bf16*)(ws + WS_KM), (bf16*)(ws + WS_VM), (const float*)(ws + WS_STKV)}};
              const pg8::ListOrder LO = pg8::make_list(S, (LAS int*)(F.lds + TAIL_OFF + 14336), nullptr);
              pg8::gemm_phase<EpiMla, pg8::ListOrder, true, false>(F.lds + RING_OFF, g, LO, E); }
            SEAM(pb + 1);
        }
        if (PT(3) && IN(pb + 2)) _Pragma("unroll") for (int rep = 0; rep < REPS(3); ++rep) { att::attn_phase(F, kargs(), l, l * 4 + rep, (char*)lds + RING_OFF); SEAM(pb + 2); }
        if (PT(4) && IN(pb + 3)) _Pragma("unroll") for (int rep = 0; rep < REPS(4); ++rep) { phase_norm_conv(F, kargs(), l); SEAM(pb + 3); }
        if (PT(5) && IN(pb + 4)) _Pragma("unroll") for (int rep = 0; rep < REPS(5); ++rep) {
            pg8::Gemm g{(const bf16*)(ws + WS_Y), (const bf16*)(ws + WS_WOUT) + (size_t)l * D * D, TP, D, D};
            pg8::StaticOrder S; S.init(64 * 256, D, F.G, (int)blockIdx.x);
            EpiOut E{(const bf16*)(ws + WS_HB), (float*)(ws + WS_Z)};
            { const pg8::ListOrder LO = pg8::make_list(S, (LAS int*)(F.lds + TAIL_OFF + 14336), nullptr); pg8::gemm_phase<EpiOut, pg8::ListOrder, true, false>(F.lds + RING_OFF, g, LO, E); }
            { pg8::Gemm gt{(const bf16*)(ws + WS_Y), (const bf16*)(ws + WS_WOUT) + (size_t)l * D * D, TP, D, 256, D};
              TailOrder ST{F.vcu}; EpiOutTail ET{(float*)(ws + WS_ZP)};
              pg8::gemm_phase<EpiOutTail, TailOrder, true, false>(F.lds + RING_OFF, gt, ST, ET);
              if ((F.vcu & 15) == 0) {
                  asm volatile("s_waitcnt vmcnt(0)" ::: "memory"); __syncthreads();
                  if (F.tid == 0) {
                      __builtin_amdgcn_fence(__ATOMIC_RELEASE, "agent"); asm volatile("s_waitcnt vmcnt(0)" ::: "memory");
                      unsigned* cw = (unsigned*)(F.ctl + CW_TAIL + l * 64); (void)xb_add(cw, 1u);
                      unsigned sp = 0; while (xb_ld(cw) < 16u * (unsigned)(rep + 1) && ++sp < (1u << 22)) __builtin_amdgcn_s_sleep(1);
                      __builtin_amdgcn_fence(__ATOMIC_ACQUIRE, "agent"); asm volatile("s_waitcnt vmcnt(0)" ::: "memory");
                  }
                  __syncthreads();
                  int tid_ = F.tid; asm volatile("" : "+v"(tid_));
                  const int row = (F.vcu >> 4) * 8 + (tid_ >> 6), c4 = (tid_ & 63) * 4; const float* ZP = (const float*)(ws + WS_ZP);
                  const bf16* hb = (const bf16*)(ws + WS_HB) + (size_t)(64 * 256 + row) * D; float* zr = (float*)(ws + WS_Z) + (size_t)(64 * 256 + row) * D;
#pragma unroll
                  for (int q = 0; q < 4; ++q) { const int c = c4 + 256 * q; const v2u hw = *(const v2u*)(hb + c); f32x4 a = (f32x4){bflo(hw.x), bfhi(hw.x), bflo(hw.y), bfhi(hw.y)} * ALPHA;
#pragma unroll
                      for (int k = 0; k < 4; ++k) a += *(const f32x4*)(ZP + ((size_t)k * 128 + row) * D + c);
                      *(f32x4*)(zr + c) = a; }
              } }
            SEAM(pb + 4);
        }
        if (PT(6) && IN(pb + 5)) { if (REPS(6) > 1) { phase_router(F, kargs(), l, true); SEAM(pb + 5); } phase_router(F, kargs(), l); SEAM(pb + 5); }
        if (PT(7) && IN(pb + 6)) _Pragma("unroll") for (int rep = 0; rep < REPS(7); ++rep) {
            LAS int* tb = (LAS int*)(F.lds + TAIL_OFF); LAS int* rows = tb + 64;
            moe_tile_prefix(F, l, tb);
            MoeOrder S{tb, F.G, F.vcu};
            { pg8::Unit u; const int* LIST = (const int*)(ws + WS_LIST); int tid_ = F.tid; asm volatile("" : "+v"(tid_));
              for (int i = 0; i < 13 && S.next(i, u) && u.kind == 0; ++i) {
                  const int e = u.pb / 8, mt = u.pm - tb[e], cnt = (int)__hip_atomic_load(F.ctl + CW_CNT + l * 64 + e, RLX_AGENT);
                  if (tid_ < 256) { const int idx = mt * 256 + tid_; rows[i * 256 + tid_] = idx < cnt ? LIST[(size_t)e * T + idx] : 0; }
              } }
            __syncthreads();
            pg8::Gemm g{(const bf16*)(ws + WS_HB), (const bf16*)(ws + WS_WGU) + (size_t)l * NE * 2 * FF * D, RP, 2 * FF, D, 0, (const bf16*)(ws + WS_ACT), (const bf16*)(ws + WS_WD) + (size_t)l * NE * D * FF};
            unsigned* rdy = (unsigned*)(F.ctl + CW_RDY + (l * 2 + rep) * 320 * 16);
            EpiMoe12 E{EpiMoe1{(bf16*)(ws + WS_ACT), (const float*)(ws + WS_BGU) + (size_t)l * NE * 2 * FF, rdy}, EpiMoe2{(bf16*)(ws + WS_YS), kargs()->in[I_BD] + (size_t)l * NE * D}};
            { pg8::ListOrder LO = pg8::make_list(S, (LAS int*)(F.lds + TAIL_OFF + 14336), rows); LO.rdy = rdy; LO.need = 64u;
              pg8::gemm_phase<EpiMoe12, pg8::ListOrder, true, true>(F.lds + RING_OFF, g, LO, E);
              { int t2 = F.tid; asm volatile("" : "+v"(t2)); E.e1.flush(t2 & 15, (t2 & 63) >> 4, true); } }
            SEAM(pb + 6);
        }
        if (PT(9) && IN(pb + 8)) { if (REPS(9) > 1) { phase_combine(F, kargs(), l, true); xcd_barrier(bar); } phase_combine(F, kargs(), l); SEAM(pb + 8); }
    }
#undef IN
#undef SEAM
}
}
#ifndef MK_DEBUG
#define MK_DEBUG 0
#endif
#if MK_DEBUG
namespace dbg {
using namespace mk;
struct CkSpec {
    const void* M; const float* N; const float* mgain; long ldm, ldn;
    int mtype  , mrowmap  , mcol0, mhstride, ncol0, nhstride, hc, nh; float scale; int pad;
};
__device__ __forceinline__ void blk_acc(float d2, float r2, double* acc) {
    __shared__ float sd[4], sr[4];
#pragma unroll
    for (int o = 32; o > 0; o >>= 1) { d2 += __shfl_xor(d2, o); r2 += __shfl_xor(r2, o); }
    if ((threadIdx.x & 63) == 0) { sd[threadIdx.x >> 6] = d2; sr[threadIdx.x >> 6] = r2; }
    __syncthreads();
    if (threadIdx.x == 0) { atomicAdd(acc, (double)(sd[0] + sd[1] + sd[2] + sd[3])); atomicAdd(acc + 1, (double)(sr[0] + sr[1] + sr[2] + sr[3])); }
}
__global__ void __launch_bounds__(256) check_k(CkSpec s, double* acc) {
    const long n = (long)T * s.nh * s.hc; float d2 = 0.f, r2 = 0.f;
    for (long i = (long)blockIdx.x * 256 + threadIdx.x; i < n; i += (long)gridDim.x * 256) {
        const long r = i / (s.nh * s.hc); const int cc = (int)(i % (s.nh * s.hc)), h = cc / s.hc, j = cc % s.hc;
        const int mcol = s.mcol0 + h * s.mhstride + j, ncol = s.ncol0 + h * s.nhstride + j;
        long mr = r; if (s.mrowmap) { const long bb = r / L; mr = bb * LP + (r - bb * L) + PADF; }
        float a = s.mtype ? ((const float*)s.M)[mr * s.ldm + mcol] : bf2f(((const bf16*)s.M)[mr * s.ldm + mcol]);
        if (s.mgain) a *= s.mgain[mcol];
        const float b = s.N[r * s.ldn + ncol] * s.scale;
        float d = a - b; if (!(d == d)) d = 1e18f; d2 += d * d; r2 += b * b;
    }
    blk_acc(d2, r2, acc);
}
__global__ void __launch_bounds__(256) check_u_k(const float* U, const float* P, double* acc) {
    const long n = (long)T * 256; float d2 = 0.f, r2 = 0.f;
    for (long i = (long)blockIdx.x * 256 + threadIdx.x; i < n; i += (long)gridDim.x * 256) {
        const long r = i >> 8; const int c = (int)(i & 255);
        const float a = U[i], g = P[r * NIN + 1440 + c], b = P[r * NIN + 1184 + c] / (1.f + expf(-g));
        float d = a - b; if (!(d == d)) d = 1e18f; d2 += d * d; r2 += b * b;
    }
    blk_acc(d2, r2, acc);
}
__global__ void __launch_bounds__(256) check_route_k(const int* TOKE, const float* TOKG, const int* te, const float* tg, double* acc, double* acc2) {
    float mm = 0.f, d2 = 0.f, r2 = 0.f;
    for (int t = blockIdx.x * 256 + threadIdx.x; t < T; t += gridDim.x * 256) {
        bool same = true;
        for (int k = 0; k < 4; ++k) same = same && (TOKE[t * 4 + k] == te[t * 4 + k]);
        if (!same) mm += 1.f; else for (int k = 0; k < 4; ++k) { const float d = TOKG[t * 4 + k] - tg[t * 4 + k]; d2 += d * d; r2 += tg[t * 4 + k] * tg[t * 4 + k]; }
    }
    blk_acc(mm, threadIdx.x == 0 && blockIdx.x == 0 ? (float)T : 0.f, acc);
    __syncthreads();
    blk_acc(d2, r2, acc2);
}
__global__ void tb_k(const unsigned* cnt, int* tb) { if (threadIdx.x == 0) { int s = 0; for (int e = 0; e < NE; ++e) { tb[e] = s; s += ((int)cnt[e] + 255) >> 8; } tb[NE] = s; } }
__global__ void __launch_bounds__(256) check_rows_k(const bf16* Mg, const int* tb, const int* TOKE, const int* TOKP, const float* Nv, const int* slot, const int* te, double* acc) {
    float d2 = 0.f, r2 = 0.f;
    for (long i = (long)blockIdx.x * 256 + threadIdx.x; i < (long)T * 4 * 1024; i += (long)gridDim.x * 256) {
        const int tk = (int)(i >> 10), c = (int)(i & 1023), t = tk >> 2;
        bool same = true;
        for (int k = 0; k < 4; ++k) same = same && (TOKE[t * 4 + k] == te[t * 4 + k]);
        if (!same) continue;
        const float a = bf2f(Mg[((size_t)tb[TOKE[tk]] * 256 + TOKP[tk]) * 1024 + c]), b = Nv[(size_t)slot[tk] * 1024 + c];
        float d = a - b; if (!(d == d)) d = 1e18f; d2 += d * d; r2 += b * b;
    }
    blk_acc(d2, r2, acc);
}
__global__ void __launch_bounds__(256) check_out_k(const float* out, const float* H, double* acc) {
    float d2 = 0.f, r2 = 0.f;
    for (long i = (long)blockIdx.x * 256 + threadIdx.x; i < (long)BATCH * SEQ * D; i += (long)gridDim.x * 256) {
        const long row = i >> 10; const int c = (int)(i & 1023); const long bb = row / SEQ, p = row - bb * SEQ;
        const float a = out[i], b = H[(bb * L + p + NMETA) * D + c]; float d = a - b; if (!(d == d)) d = 1e18f; d2 += d * d; r2 += b * b;
    }
    blk_acc(d2, r2, acc);
}
__global__ void __launch_bounds__(256) verdict_k(const double* acc, int nck, float tol, float* out, long nout) {
    int bad = -1; float cls = 0.f;
    for (int k = 0; k < nck; ++k) { const double d = acc[2 * k], r = acc[2 * k + 1]; if (r == 0.0 && d == 0.0) continue; const double q = r > 0.0 ? d / r : 1e30;
        const double tl = (k < 38 && (k - 2) % 18 == 14) ? 0.06 : (double)tol;
        if (!(q <= tl)) { bad = k; cls = q < 1e-3 ? 0.f : q < 1e-2 ? 1.f : q < 1e-1 ? 2.f : q < 1.0 ? 3.f : 4.f; break; } }
    if (bad < 0) return;
    const float c = sqrtf((10.f + (float)bad) * powf(10.f, cls));
    for (long i = (long)blockIdx.x * 256 + threadIdx.x; i < nout; i += (long)gridDim.x * 256) out[i] += c;
}
}
#endif

static void run_gemm(hipStream_t s, const float* A, int lda, const int* arow, const float* B, int ldb, long strideB, const float* bias, long strideBias, float* C, int ldc,
                     int M, int N, int K, const int* cnt, const int* base, int groups, int swiglu = 0) {
#if MK_DEBUG
    nv::GemmP p{A, arow, B, bias, C, cnt, base, strideB, strideBias, lda, ldb, ldc, M, N, K, swiglu, 0};
    dim3 grid((N + 63) / 64, (M + 63) / 64, groups);
    hipLaunchKernelGGL(nv::sgemm_k, grid, dim3(256), 0, s, p);
#endif
}

extern "C" void kernel_launch(void* const* d_in, const int* in_sizes, int n_in, void* d_out, int out_size, void* d_ws, size_t ws_size, hipStream_t stream) {
    using namespace mk;
    static int grid = 0;
    if (grid == 0) {
        int dev = 0, cus = 0;
        if (n_in != 25 || out_size != BATCH * SEQ * D || ws_size < (size_t)2040 * MiB) { fprintf(stderr, "kernel_launch: unexpected shapes (n_in %d out %d ws %zu)\n", n_in, out_size, ws_size); grid = -1; return; }
        if (hipGetDevice(&dev) != hipSuccess || hipDeviceGetAttribute(&cus, hipDeviceAttributeMultiprocessorCount, dev) != hipSuccess) { grid = -1; return; }
        if (hipFuncSetAttribute((const void*)mega_fwd, hipFuncAttributeMaxDynamicSharedMemorySize, LDS_BYTES) != hipSuccess) { fprintf(stderr, "kernel_launch: hipFuncSetAttribute failed\n"); grid = -1; return; }
        int per_cu = 0;
        if (hipOccupancyMaxActiveBlocksPerMultiprocessor(&per_cu, (const void*)mega_fwd, NWAVES * 64, LDS_BYTES) != hipSuccess || per_cu < 1) fprintf(stderr, "kernel_launch: occupancy query says %d\n", per_cu);
        (void)hipGetLastError();
        grid = cus;
    }
    if (grid < 0) return;
    (void)hipMemsetAsync((char*)d_ws + WS_CTL, 0, CTL_ZERO_BYTES, stream);
    Args a{};
    for (int i = 0; i < 25; ++i) a.in[i] = (const float*)d_in[i];
    a.out = (float*)d_out; a.ws = (unsigned char*)d_ws;
#if !MK_DEBUG
    a.ph_lo = 0; a.ph_hi = N_PHASES;
    hipLaunchKernelGGL(mega_fwd, dim3(grid), dim3(NWAVES * 64), LDS_BYTES, stream, a);
#else
    using namespace nv;
    auto mega = [&](int ph) { a.ph_lo = ph; a.ph_hi = ph + 1; hipLaunchKernelGGL(mega_fwd, dim3(grid), dim3(NWAVES * 64), LDS_BYTES, stream, a); };
    const float* x = (const float*)d_in[0]; const float* meta = (const float*)d_in[1];
    const float* ln_in_g = (const float*)d_in[2]; const float* ln_in_b = (const float*)d_in[3];
    const float* w_in = (const float*)d_in[4]; const float* q_norm_g = (const float*)d_in[5]; const float* w_uq = (const float*)d_in[6];
    const float* kv_norm_g = (const float*)d_in[7]; const float* w_ukv = (const float*)d_in[8]; const float* conv_w = (const float*)d_in[9];
    const float* conv_b = (const float*)d_in[10]; const float* conv_ln_g = (const float*)d_in[11]; const float* conv_ln_b = (const float*)d_in[12];
    const float* grp_norm_g = (const float*)d_in[13]; const float* w_out = (const float*)d_in[14]; const float* ln_mix_g = (const float*)d_in[15];
    const float* ln_mix_b = (const float*)d_in[16]; const float* router_w = (const float*)d_in[17]; const float* router_b = (const float*)d_in[18];
    const float* w_gate_up = (const float*)d_in[19]; const float* b_gate_up = (const float*)d_in[20]; const float* w_down = (const float*)d_in[21];
    const float* b_down = (const float*)d_in[22]; const float* ln_ffn_g = (const float*)d_in[23]; const float* ln_ffn_b = (const float*)d_in[24];
    float* out = (float*)d_out;
    unsigned char* mw = (unsigned char*)d_ws;
    char* w = (char*)d_ws; size_t off = (size_t)1088 * MiB;
    auto take = [&](size_t bytes) { char* p = w + off; off += (bytes + 255) & ~(size_t)255; return p; };
    double* acc = (double*)take(64 * 16); int* tbd = (int*)take(256);
    int* cnt = (int*)take(256); int* base = (int*)take(256);
    int* te = (int*)take((size_t)R * 4); int* tp = (int*)take((size_t)R * 4); float* tg = (float*)take((size_t)R * 4);
    int* list = (int*)take((size_t)R * 4); int* slot = (int*)take((size_t)R * 4);
    float* H = (float*)take((size_t)T * D * 4);
    float* MIX = (float*)take((size_t)T * D * 4);
    float* LOG = (float*)take((size_t)T * NE * 4);
    float* ACT = (float*)take((size_t)R * FF * 4);
    char* alias0 = w + off;
    float* P = (float*)take((size_t)T * NIN * 4);
    float* CQN = (float*)take((size_t)T * 256 * 4); float* CKVN = (float*)take((size_t)T * 128 * 4);
    float* QM = (float*)take((size_t)T * 768 * 4); float* KVM = (float*)take((size_t)T * 1024 * 4); float* KROT = (float*)take((size_t)T * 32 * 4);
    float* SBO = (float*)take((size_t)T * 256 * 4); float* MLAO = (float*)take((size_t)T * 512 * 4);
    float* Y = (float*)take((size_t)T * D * 4);
    float* YS = (float*)alias0;
    if ((size_t)(w + off - alias0) < (size_t)R * D * 4) { fprintf(stderr, "alias too small\n"); return; }
    if (off > ws_size) { fprintf(stderr, "workspace too small: need %zu have %zu\n", off, ws_size); return; }
    (void)hipMemsetAsync(acc, 0, 64 * 16, stream);
    const int CG = 1024;
    auto ck = [&](int id, const void* M, int mtype, int mrowmap, long ldm, int mcol0, int mhstride, const float* N, long ldn, int ncol0, int nhstride, int hc, int nh, float scale, const float* mgain) {
        dbg::CkSpec s{M, N, mgain, ldm, ldn, mtype, mrowmap, mcol0, mhstride, ncol0, nhstride, hc, nh, scale, 0};
        hipLaunchKernelGGL(dbg::check_k, dim3(CG), dim3(256), 0, stream, s, acc + 2 * id);
    };
    mega(0);
    hipLaunchKernelGGL(ln_in_k, dim3(T), dim3(256), 0, stream, x, meta, ln_in_g, ln_in_b, H);
    ck(1, mw + WS_HB, 0, 0, D, 0, 0, H, D, 0, 0, D, 1, 1.f, nullptr);
    for (int l = 0; l < DEPTH; ++l) {
        const int pb = 1 + l * PH_PER_LAYER, cb = 2 + 18 * l;
        mega(pb + 0);
        run_gemm(stream, H, D, nullptr, w_in + (size_t)l * D * NIN, NIN, 0, nullptr, 0, P, NIN, T, NIN, D, nullptr, nullptr, 1);
        ck(cb + 0, mw + WS_SBQ, 0, 1, 256, 0, 0, P, NIN, 0, 0, 256, 1, SBQ_SCALE, nullptr);
        ck(cb + 1, mw + WS_SBK, 0, 1, 256, 0, 0, P, NIN, 256, 0, 256, 1, 1.f, nullptr);
        ck(cb + 2, mw + WS_SBV, 0, 1, 256, 0, 0, P, NIN, 512, 0, 256, 1, 1.f, nullptr);
        ck(cb + 3, mw + WS_CQ, 0, 0, 256, 0, 0, P, NIN, 768, 0, 256, 1, 1.f, nullptr);
        ck(cb + 4, mw + WS_CKV2, 0, 0, 256, 0, 0, P, NIN, 1024, 0, 128, 1, 1.f, nullptr);
        hipLaunchKernelGGL(dbg::check_u_k, dim3(CG), dim3(256), 0, stream, (const float*)(mw + WS_U), P, acc + 2 * (cb + 5));
        mega(pb + 1);
        hipLaunchKernelGGL(rms_cols_k, dim3(T), dim3(256), 0, stream, P, NIN, 768, 256, q_norm_g + l * 256, CQN);
        hipLaunchKernelGGL(rms_cols_k, dim3(T), dim3(256), 0, stream, P, NIN, 1024, 128, kv_norm_g + l * 128, CKVN);
        run_gemm(stream, CQN, 256, nullptr, w_uq + (size_t)l * 256 * 768, 768, 0, nullptr, 0, QM, 768, T, 768, 256, nullptr, nullptr, 1);
        run_gemm(stream, CKVN, 128, nullptr, w_ukv + (size_t)l * 128 * 1024, 1024, 0, nullptr, 0, KVM, 1024, T, 1024, 128, nullptr, nullptr, 1);
        hipLaunchKernelGGL(rotary_k, dim3(T), dim3(256), 0, stream, QM, P, KROT);
        ck(cb + 6, mw + WS_QM, 0, 1, 768, 0, 0, QM, 768, 0, 0, 768, 1, MLAQ_SCALE, nullptr);
        ck(cb + 7, mw + WS_KM, 0, 1, 768, 0, 96, KVM, 1024, 0, 128, 64, 8, 1.f, nullptr);
        ck(cb + 8, mw + WS_KM, 0, 1, 768, 64, 96, KROT, 32, 0, 0, 32, 8, 1.f, nullptr);
        ck(cb + 9, mw + WS_VM, 0, 1, 512, 0, 64, KVM, 1024, 64, 128, 64, 8, 1.f, nullptr);
        mega(pb + 2);
        hipLaunchKernelGGL(attn_k<0>, dim3((L + 3) / 4, 4, BATCH), dim3(256), 0, stream, P, QM, KVM, KROT, SBO);
        hipLaunchKernelGGL(attn_k<1>, dim3((L + 3) / 4, 8, BATCH), dim3(256), 0, stream, P, QM, KVM, KROT, MLAO);
        ck(cb + 10, mw + WS_OATT, 0, 0, 768, 0, 0, SBO, 256, 0, 0, 256, 1, 1.f, nullptr);
        ck(cb + 11, mw + WS_OATT, 0, 0, 768, 256, 0, MLAO, 512, 0, 0, 512, 1, 1.f, nullptr);
        mega(pb + 3);
        hipLaunchKernelGGL(mix_norm_k, dim3(T), dim3(256), 0, stream, P, SBO, MLAO, conv_w + (size_t)l * CONVK * 256, conv_b + l * 256, conv_ln_g + l * 256, conv_ln_b + l * 256,
                           grp_norm_g + l * D, Y);
        ck(cb + 12, mw + WS_Y, 0, 0, D, 0, 0, Y, D, 0, 0, D, 1, 1.f, grp_norm_g + l * D);
        mega(pb + 4);
        mega(pb + 5);
        run_gemm(stream, Y, D, nullptr, w_out + (size_t)l * D * D, D, 0, nullptr, 0, MIX, D, T, D, D, nullptr, nullptr, 1);
        hipLaunchKernelGGL(res_ln_k, dim3(T), dim3(256), 0, stream, H, MIX, ln_mix_g + l * D, ln_mix_b + l * D, (float*)nullptr);
        ck(cb + 13, mw + WS_HB, 0, 0, D, 0, 0, H, D, 0, 0, D, 1, 1.f, nullptr);
        run_gemm(stream, H, D, nullptr, router_w + (size_t)l * D * NE, NE, 0, router_b + l * NE, 0, LOG, NE, T, NE, D, nullptr, nullptr, 1);
        (void)hipMemsetAsync(cnt, 0, 256, stream);
        hipLaunchKernelGGL(route_k, dim3((T + 255) / 256), dim3(256), 0, stream, LOG, cnt, te, tp, tg);
        hipLaunchKernelGGL(prefix_k, dim3(1), dim3(64), 0, stream, cnt, base);
        hipLaunchKernelGGL(scatter_k, dim3((R + 255) / 256), dim3(256), 0, stream, te, tp, base, list, slot);
        hipLaunchKernelGGL(dbg::check_route_k, dim3(64), dim3(256), 0, stream, (const int*)(mw + WS_TOKE), (const float*)(mw + WS_TOKG), te, tg, acc + 2 * (cb + 14), acc + 2 * (38 + l));
        hipLaunchKernelGGL(dbg::tb_k, dim3(1), dim3(64), 0, stream, (const unsigned*)(mw + WS_CTL) + CW_CNT + l * 64, tbd);
        mega(pb + 6);
        run_gemm(stream, H, D, list, w_gate_up + (size_t)l * NE * D * 2 * FF, 2 * FF, (long)D * 2 * FF, b_gate_up + (size_t)l * NE * 2 * FF, 2 * FF, ACT, FF, T, FF, D, cnt, base, NE, 1);
        hipLaunchKernelGGL(dbg::check_rows_k, dim3(CG), dim3(256), 0, stream, (const bf16*)(mw + WS_ACT), tbd, (const int*)(mw + WS_TOKE), (const int*)(mw + WS_TOKP), ACT, slot, te, acc + 2 * (cb + 15));
        mega(pb + 7);
        run_gemm(stream, ACT, FF, nullptr, w_down + (size_t)l * NE * FF * D, D, (long)FF * D, b_down + (size_t)l * NE * D, D, YS, D, T, D, FF, cnt, base, NE);
        hipLaunchKernelGGL(dbg::check_rows_k, dim3(CG), dim3(256), 0, stream, (const bf16*)(mw + WS_YS), tbd, (const int*)(mw + WS_TOKE), (const int*)(mw + WS_TOKP), YS, slot, te, acc + 2 * (cb + 16));
        mega(pb + 8);
        hipLaunchKernelGGL(combine_k, dim3(T), dim3(256), 0, stream, YS, slot, tg, MIX);
        hipLaunchKernelGGL(res_ln_k, dim3(T), dim3(256), 0, stream, H, MIX, ln_ffn_g + l * D, ln_ffn_b + l * D, (float*)nullptr);
        if (l < DEPTH - 1) ck(cb + 17, mw + WS_HB, 0, 0, D, 0, 0, H, D, 0, 0, D, 1, 1.f, nullptr);
        else hipLaunchKernelGGL(dbg::check_out_k, dim3(CG), dim3(256), 0, stream, (const float*)out, (const float*)H, acc + 2 * (cb + 17));
    }
    hipLaunchKernelGGL(dbg::verdict_k, dim3(1024), dim3(256), 0, stream, acc, 40, MK_TOL, out, (long)BATCH * SEQ * D);
#endif
}
```

```cpp
#include <hip/hip_runtime.h>
#include <cstdio>
#include <cstdint>
#include <cmath>
#define MK_DEBUG 0
#define MK_TOL 1e-3f
#define MK_REP 0
namespace pg8 {
#define PG8_LAS __attribute__((address_space(3)))
typedef unsigned short bf16_t;
typedef short bf16x8 __attribute__((ext_vector_type(8)));
typedef float f32x4 __attribute__((ext_vector_type(4)));
typedef float f32x2 __attribute__((ext_vector_type(2)));
typedef unsigned u32x4 __attribute__((ext_vector_type(4)));
typedef unsigned u32x2 __attribute__((ext_vector_type(2)));
constexpr int BM = 256, BK = 64, HALF = 128, HTB = HALF * BK * 2  , STAGE_BYTES = 8 * HTB, NXCD = 8, WGM = 8;

__host__ __device__ __forceinline__ int lds_byte(int r, int c) { const int st = (r >> 4) * 2 + (c >> 5), rr = r & 15, cc = c & 31, ob = rr * 64 + cc * 2; return st * 1024 + (ob ^ (((ob >> 9) & 1) << 5)); }
__host__ __device__ __forceinline__ void stage_rc(int b, int& R, int& C) { const int st = b / 1024, sb = b % 1024, swz = sb ^ (((sb >> 9) & 1) << 5); R = (st >> 1) * 16 + swz / 64; C = (st & 1) * 32 + (swz % 64) / 2; }
__host__ __device__ __forceinline__ int perm32(int rho) { const int n = rho >> 4, i = rho & 15; return 8 * (i >> 2) + 4 * n + (i & 3); }

struct Unit { int pm, pn, pb, ko, kind; };
struct Gemm { const bf16_t* A; const bf16_t* Bt; int M, N, K; int ld = 0; const bf16_t* A2 = nullptr; const bf16_t* Bt2 = nullptr; };

struct StaticOrder {
    int nM, nN, nwg, G, c;
    __host__ __device__ void init(int M, int N, int G_, int c_) { nM = M / BM; nN = N / BM; nwg = nM * nN; G = G_; c = c_; }
    __host__ __device__ bool next(int i, Unit& u) const {
        const long L = (long)i * G + c; if (L >= nwg) return false;
        int wgid = (int)L; { const int q = nwg / NXCD, r = nwg % NXCD, xcd = wgid % NXCD, off = wgid / NXCD; wgid = (xcd < r ? xcd * (q + 1) : r * (q + 1) + (xcd - r) * q) + off; }
        const int nig = WGM * nN, gid = wgid / nig, fm = gid * WGM, gsz = (nM - fm) < WGM ? (nM - fm) : WGM;
        u.pm = fm + ((wgid % nig) % gsz); u.pn = (wgid % nig) / gsz; u.pb = u.pn; u.ko = 0; u.kind = 0; return true;
    }
    __device__ __forceinline__ const PG8_LAS int* rowlist(int) const { return nullptr; }
    __device__ __forceinline__ void a_ready(const Unit&) const {}
};

struct ListOrder {
    const PG8_LAS int* tab; const PG8_LAS int* rows; int n;
    unsigned* rdy = nullptr; unsigned need = 0;
    __device__ __forceinline__ bool next(int i, Unit& u) const { if (i >= n) return false;
        u.pm = __builtin_amdgcn_readfirstlane(tab[4 * i]); u.pn = __builtin_amdgcn_readfirstlane(tab[4 * i + 1]); u.pb = __builtin_amdgcn_readfirstlane(tab[4 * i + 2]); u.kind = __builtin_amdgcn_readfirstlane(tab[4 * i + 3]); u.ko = 0; return true; }
    __device__ __forceinline__ const PG8_LAS int* rowlist(int ui) const { return rows + ui * 256; }
    __device__ __forceinline__ void a_ready(const Unit& u) const {
        if (u.kind != 1 || rdy == nullptr) return;
        if (threadIdx.x < 64) {
            unsigned sp = 0;
            while ((unsigned)__builtin_amdgcn_readfirstlane(__hip_atomic_load(rdy + 16 * u.pm, __ATOMIC_RELAXED, __HIP_MEMORY_SCOPE_AGENT)) < need) { __builtin_amdgcn_s_sleep(2); if (++sp > (1u << 20)) break; }
            __builtin_amdgcn_fence(__ATOMIC_ACQUIRE, "agent");
            asm volatile("s_waitcnt vmcnt(0)" ::: "memory");
        }
        asm volatile("" ::: "memory"); __builtin_amdgcn_s_barrier(); asm volatile("" ::: "memory");
    }
};
template <class Sched> __device__ __forceinline__ ListOrder make_list(const Sched& S, PG8_LAS int* tab, const PG8_LAS int* rows) {
    if (threadIdx.x == 0) { Unit u; int n = 0;
#pragma unroll 1
        while (n < 24 && S.next(n, u)) { tab[4 * n] = u.pm; tab[4 * n + 1] = u.pn; tab[4 * n + 2] = u.pb; tab[4 * n + 3] = u.kind; ++n; } tab[127] = n; }
    __syncthreads();
    ListOrder Lo; Lo.tab = tab; Lo.rows = rows; Lo.n = __builtin_amdgcn_readfirstlane(tab[127]); return Lo;
}
__device__ __forceinline__ unsigned cvt_pk_bf16(float lo, float hi) { unsigned r; asm volatile("v_cvt_pk_bf16_f32 %0, %1, %2" : "=v"(r) : "v"(lo), "v"(hi)); return r; }

template <class Epi, class Sched, bool ALIGN_EPI, bool GATHER>
__device__ __forceinline__ void gemm_phase(PG8_LAS unsigned char* lds, const Gemm g, const Sched& S, const Epi& E) {
    int tid = threadIdx.x; asm volatile("" : "+v"(tid));
    const int wid = __builtin_amdgcn_readfirstlane(tid >> 6), wr = wid >> 2, wc = wid & 3;
    int K = g.K; asm volatile("" : "+s"(K));
    const int nt = K / BK;
    int LD = g.ld ? g.ld : g.K; asm volatile("" : "+s"(LD));
    unsigned voffA[2], voffB[2];
#pragma unroll
    for (int i = 0; i < 2; ++i) { int R, C; stage_rc(tid * 16 + i * 8192, R, C); const int Rb = Epi::PERM ? ((R & ~31) + perm32(R & 31)) : R;
        voffA[i] = (unsigned)(R * LD + C) * 2u; voffB[i] = (unsigned)(Rb * LD + C) * 2u; }
    unsigned voffG[2][2] = {{0u, 0u}, {0u, 0u}};
#define PG8_LOADG(ui_, u_) do { const PG8_LAS int* rl_ = S.rowlist(ui_); _Pragma("unroll") for (int i_ = 0; i_ < 2; ++i_) { int R_, C_; stage_rc(tid * 16 + i_ * 8192, R_, C_);     \
        _Pragma("unroll") for (int h_ = 0; h_ < 2; ++h_) voffG[h_][i_] = (unsigned)((u_).kind ? (u_).pm * BM + h_ * HALF + R_ : rl_[h_ * HALF + R_]) * (unsigned)(LD * 2) + (unsigned)C_ * 2u; } } while (0)
    const size_t kstep = (size_t)(BK * 2);
    const size_t hstep = (size_t)HALF * LD * 2;
    const size_t tstep = 2 * hstep;
    const unsigned ldsw = (unsigned)wid * 1024u;
    const int aoff = lds_byte(wr * 64 + (tid & 15), ((tid & 63) >> 4) * 8), boff = lds_byte(wc * 32 + (tid & 15), ((tid & 63) >> 4) * 8);
#define PG8_SA(b, h) (((b) * 2 + (h)) * HTB)
#define PG8_SB(b, h) ((4 + (b) * 2 + (h)) * HTB)
#define PG8_STAGE(bufoff, gbase, voff) do { _Pragma("unroll") for (int _i = 0; _i < 2; ++_i) \
        __builtin_amdgcn_global_load_lds((const unsigned*)((const char*)(gbase) + (voff)[_i]), (PG8_LAS unsigned*)(lds + (bufoff) + ldsw + _i * 8192), 16, 0, 0); } while (0)
#define PG8_STAGE_A(bufoff, kptr, h) do { if constexpr (GATHER) { PG8_STAGE(bufoff, kptr, voffG[h]); } else { PG8_STAGE(bufoff, (kptr) + (h) * hstep, voffA); } } while (0)
#define PG8_LDA(dst, b, h) do { _Pragma("unroll") for (int m = 0; m < 4; ++m) _Pragma("unroll") for (int k = 0; k < 2; ++k) dst[m][k] = *(const PG8_LAS bf16x8*)(lds + PG8_SA(b, h) + aoff + m * 2048 + k * 1024); } while (0)
#define PG8_LDB(dst, b, h) do { _Pragma("unroll") for (int n = 0; n < 2; ++n) _Pragma("unroll") for (int k = 0; k < 2; ++k) dst[n][k] = *(const PG8_LAS bf16x8*)(lds + PG8_SB(b, h) + boff + n * 2048 + k * 1024); } while (0)
#define PG8_MMA(ai, bj, At, Bt) do { __builtin_amdgcn_s_setprio(1); _Pragma("unroll") for (int m = 0; m < 4; ++m) _Pragma("unroll") for (int n = 0; n < 2; ++n) _Pragma("unroll") for (int k = 0; k < 2; ++k) \
        acc[ai][bj][m][n] = __builtin_amdgcn_mfma_f32_16x16x32_bf16(Bt[n][k], At[m][k], acc[ai][bj][m][n], 0, 0, 0); __builtin_amdgcn_s_setprio(0); } while (0)
#define PG8_WAIT_V(n) asm volatile("s_waitcnt vmcnt(" #n ")" ::: "memory")
#define PG8_WAIT_L(n) asm volatile("s_waitcnt lgkmcnt(" #n ")" ::: "memory")
#define PG8_BAR __builtin_amdgcn_s_barrier()
#define PG8_SCHED __builtin_amdgcn_sched_barrier(0)
    Unit cur, nxt; int ui = 0;
    if (!S.next(0, cur)) return;
    f32x4 acc[2][2][4][2];
#pragma unroll
    for (int a = 0; a < 2; ++a)
#pragma unroll
        for (int b = 0; b < 2; ++b)
#pragma unroll
            for (int m = 0; m < 4; ++m)
#pragma unroll
                for (int n = 0; n < 2; ++n) acc[a][b][m][n] = (f32x4){0.f, 0.f, 0.f, 0.f};
    bf16x8 At[4][2], B0[2][2], B1[2][2];
#define PG8_BASEA(u_) ((const char*)((u_).kind ? g.A2 : g.A) + (GATHER ? (size_t)0 : (size_t)(u_).pm * tstep) + (size_t)(u_).ko * 2)
#define PG8_BASEB(u_) ((const char*)((u_).kind ? g.Bt2 : g.Bt) + (size_t)(u_).pb * tstep + (size_t)(u_).ko * 2)
    const char* cA = PG8_BASEA(cur); const char* cB = PG8_BASEB(cur);
    S.a_ready(cur);
    if constexpr (GATHER) { PG8_LOADG(0, cur); }
    PG8_STAGE(PG8_SB(0, 0), cB, voffB); PG8_STAGE(PG8_SB(0, 1), cB + hstep, voffB); PG8_STAGE_A(PG8_SA(0, 0), cA, 0); PG8_STAGE_A(PG8_SA(0, 1), cA, 1);
    if (wr == 1) PG8_BAR;
    PG8_WAIT_V(2); PG8_BAR;
    PG8_STAGE(PG8_SB(1, 0), cB + kstep, voffB); PG8_STAGE_A(PG8_SA(1, 0), cA + kstep, 0); PG8_STAGE(PG8_SB(1, 1), cB + hstep + kstep, voffB);
    PG8_WAIT_V(6); PG8_BAR;
    for (;;) {
        const bool has_next = S.next(ui + 1, nxt);
        const char* nA = has_next ? PG8_BASEA(nxt) : cA; const char* nB = has_next ? PG8_BASEB(nxt) : cB;
        for (int t = 0; t < nt; t += 2) {
            const bool last = (t == nt - 2);
            const char* a1 = cA + (size_t)(t + 1) * kstep;
            const char* a2 = last ? nA : cA + (size_t)(t + 2) * kstep; const char* b2 = last ? nB : cB + (size_t)(t + 2) * kstep;
            const char* a3 = a2 + kstep; const char* b3 = b2 + kstep;
            if (last && has_next) S.a_ready(nxt);
            PG8_LDB(B0, 0, 0); PG8_LDB(B1, 0, 1); PG8_SCHED; PG8_LDA(At, 0, 0); PG8_STAGE_A(PG8_SA(1, 1), a1, 1);
            if constexpr (GATHER) { if (last && has_next) { PG8_LOADG(ui + 1, nxt); } }
            PG8_WAIT_V(8); PG8_WAIT_L(0); PG8_BAR; PG8_MMA(0, 0, At, B0); PG8_MMA(0, 1, At, B1); PG8_BAR; PG8_SCHED;
            PG8_LDA(At, 0, 1); PG8_STAGE(PG8_SB(0, 0), b2, voffB); PG8_STAGE(PG8_SB(0, 1), b2 + hstep, voffB); PG8_STAGE_A(PG8_SA(0, 0), a2, 0);
            PG8_WAIT_V(8); PG8_WAIT_L(0); PG8_BAR; PG8_MMA(1, 0, At, B0); PG8_MMA(1, 1, At, B1); PG8_BAR; PG8_SCHED;
            PG8_LDB(B0, 1, 0); PG8_LDB(B1, 1, 1); PG8_SCHED; PG8_LDA(At, 1, 0); PG8_STAGE_A(PG8_SA(0, 1), a2, 1);
            PG8_WAIT_V(8); PG8_WAIT_L(0); PG8_BAR; PG8_MMA(0, 0, At, B0); PG8_MMA(0, 1, At, B1); PG8_BAR; PG8_SCHED;
            PG8_LDA(At, 1, 1); PG8_STAGE(PG8_SB(1, 0), b3, voffB); PG8_STAGE(PG8_SB(1, 1), b3 + hstep, voffB); PG8_STAGE_A(PG8_SA(1, 0), a3, 0);
            PG8_WAIT_V(8); PG8_WAIT_L(0); PG8_BAR; PG8_MMA(1, 0, At, B0); PG8_MMA(1, 1, At, B1); PG8_BAR; PG8_SCHED;
        }
        if constexpr (ALIGN_EPI) { if (wr == 0) PG8_BAR; }
        { int t2 = tid; asm volatile("" : "+v"(t2)); E(acc, cur, wr, wc, t2 & 15, (t2 & 63) >> 4); }
        if (!has_next) break;
#pragma unroll
        for (int a = 0; a < 2; ++a)
#pragma unroll
            for (int b = 0; b < 2; ++b)
#pragma unroll
                for (int m = 0; m < 4; ++m)
#pragma unroll
                    for (int n = 0; n < 2; ++n) acc[a][b][m][n] = (f32x4){0.f, 0.f, 0.f, 0.f};
        cur = nxt; cA = nA; cB = nB; ++ui;
        if constexpr (ALIGN_EPI) { if (wr == 1) PG8_BAR; }
    }
    PG8_WAIT_V(0);
    if constexpr (!ALIGN_EPI) { if (wr == 0) PG8_BAR; }
    PG8_BAR;
#undef PG8_LOADG
#undef PG8_BASEA
#undef PG8_BASEB
#undef PG8_SA
#undef PG8_SB
#undef PG8_STAGE
#undef PG8_STAGE_A
#undef PG8_LDA
#undef PG8_LDB
#undef PG8_MMA
#undef PG8_WAIT_V
#undef PG8_WAIT_L
#undef PG8_BAR
#undef PG8_SCHED
}
}
namespace mk {
constexpr int NWAVES = 8;
constexpr int D = 1024, BATCH = 8, SEQ = 2048, NMETA = 16, L = SEQ + NMETA, T = BATCH * L, TP = 16640;
constexpr int LP = 2112, PADF = 48;
constexpr int DEPTH = 2, NE = 32, TOPK = 4, FF = 1024, CONVK = 31, NIN = 1696, NINP = 1792;
constexpr int RP = 74240;
constexpr float ALPHA = 1.4142135623730951f, LN_EPS = 1e-5f, RMS_EPS = 1e-6f;
constexpr float LOG2E = 1.4426950408889634f;
constexpr float SBQ_SCALE = 0.125f * LOG2E;
constexpr float MLAQ_SCALE = 0.10206207261596575f * LOG2E;

constexpr size_t MiB = 1u << 20;
constexpr size_t WS_CTL = 0, CTL_ZERO_BYTES = 1 * MiB;
constexpr size_t WS_WIN = 2 * MiB, WS_WUQ = 9 * MiB, WS_WUKV = 10 * MiB, WS_WOUT = 11 * MiB, WS_BGU = 15 * MiB, WS_ROPE = 16 * MiB, WS_STQ = 17 * MiB, WS_STKV = 17 * MiB + 512 * 1024;
constexpr size_t WS_TOKE = 18 * MiB, WS_TOKP = 18 * MiB + 512 * 1024, WS_TOKG = 19 * MiB, WS_LIST = 20 * MiB, WS_RWT = 24 * MiB, WS_ZP = 26 * MiB;
constexpr size_t WS_WGU = 32 * MiB, WS_WD = 288 * MiB, WS_HL = 416 * MiB  , WS_HB = 481 * MiB, WS_Z = 514 * MiB;
constexpr size_t WS_SBQ = 579 * MiB, WS_SBK = 588 * MiB, WS_SBV = 597 * MiB, WS_CQ = 606 * MiB, WS_CKV = 615 * MiB, WS_U = 620 * MiB;
constexpr size_t WS_QM = 637 * MiB, WS_KM = 662 * MiB, WS_VM = 687 * MiB, WS_OATT = 704 * MiB, WS_Y = 753 * MiB, WS_ACT = 786 * MiB, WS_YS = 931 * MiB, WS_MEGA_END = 1076 * MiB;
constexpr size_t WS_CKV2 = 1077 * MiB  , WS_WUKV2 = 1086 * MiB  ;
static_assert(WS_WIN + (size_t)DEPTH * NINP * D * 2 <= WS_WUQ && WS_WOUT + (size_t)DEPTH * D * D * 2 <= WS_BGU && WS_BGU + (size_t)DEPTH * NE * 2 * FF * 4 <= WS_ROPE, "ws map 1");
static_assert(WS_ROPE + (size_t)L * 16 * 8 <= WS_STQ && WS_STQ + (size_t)TP * 16 <= WS_STKV && WS_STKV + (size_t)TP * 16 <= WS_TOKE && WS_TOKE + (size_t)T * 16 <= WS_TOKP && WS_LIST + (size_t)NE * T * 4 <= WS_WGU, "ws map 2");
static_assert(WS_WGU + (size_t)DEPTH * NE * 2 * FF * D * 2 <= WS_WD && WS_WD + (size_t)DEPTH * NE * FF * D * 2 <= WS_HL && WS_HL + (size_t)TP * D * 2 <= WS_HB && WS_HB + (size_t)TP * D * 2 <= WS_Z && WS_Z + (size_t)T * D * 4 <= WS_SBQ, "ws map 3");
static_assert(WS_SBQ + (size_t)BATCH * LP * 256 * 2 <= WS_SBK && WS_SBV + (size_t)BATCH * LP * 256 * 2 <= WS_CQ && WS_CQ + (size_t)TP * 256 * 2 <= WS_CKV && WS_CKV + (size_t)TP * 128 * 2 <= WS_U && WS_U + (size_t)T * 256 * 4 <= WS_QM, "ws map 4");
static_assert(WS_QM + (size_t)BATCH * LP * 768 * 2 <= WS_KM && WS_KM + (size_t)BATCH * LP * 768 * 2 <= WS_VM && WS_VM + (size_t)BATCH * LP * 512 * 2 <= WS_OATT && WS_OATT + (size_t)T * 768 * 4 <= WS_Y && WS_Y + (size_t)TP * D * 2 <= WS_ACT, "ws map 5");
static_assert(WS_ACT + (size_t)RP * FF * 2 <= WS_YS && WS_YS + (size_t)RP * D * 2 <= WS_MEGA_END, "ws map 6");
constexpr int CW_CNT = 1024;
constexpr int CW_CONV = 1536;
constexpr int CW_TAIL = 1600;
constexpr int CW_AQ = 2048;
constexpr int CW_BAR = 4096;
constexpr int CW_RDY = 8192;

constexpr int RING_OFF = 0, RING_BYTES = 131072;
constexpr int LDSCTL_OFF = RING_BYTES, MISC_OFF = LDSCTL_OFF + 320;
constexpr int TAIL_OFF = RING_BYTES + 1024;
constexpr int LDS_BYTES = 147456;

#define GAS __attribute__((address_space(1)))
#define LAS __attribute__((address_space(3)))
typedef unsigned short bf16;
typedef unsigned v4u __attribute__((ext_vector_type(4)));
typedef unsigned v2u __attribute__((ext_vector_type(2)));
typedef float f32x4 __attribute__((ext_vector_type(4)));
typedef float f32x2 __attribute__((ext_vector_type(2)));
typedef short bf16x8 __attribute__((ext_vector_type(8)));
typedef GAS unsigned gu32;
#define RLX_AGENT __ATOMIC_RELAXED, __HIP_MEMORY_SCOPE_AGENT
#define LDS_WAIT() asm volatile("s_waitcnt lgkmcnt(0)" ::: "memory")
#define VM_WAIT() asm volatile("s_waitcnt vmcnt(0)" ::: "memory")
__device__ __forceinline__ unsigned f2bf(float f) { unsigned u = __builtin_bit_cast(unsigned, f); return (u + 0x7fffu + ((u >> 16) & 1u)) >> 16; }
__device__ __forceinline__ unsigned pk2(float lo, float hi) { return f2bf(lo) | (f2bf(hi) << 16); }
__device__ __forceinline__ unsigned cvtpk_rne(float lo, float hi) { typedef float f2_ __attribute__((ext_vector_type(2))); typedef __bf16 b2_ __attribute__((ext_vector_type(2))); f2_ v = {lo, hi}; b2_ b = __builtin_convertvector(v, b2_); return __builtin_bit_cast(unsigned, b); }
__device__ __forceinline__ float bf2f(unsigned short b) { return __builtin_bit_cast(float, (unsigned)b << 16); }
__device__ __forceinline__ float bflo(unsigned w) { return __builtin_bit_cast(float, w << 16); }
__device__ __forceinline__ float bfhi(unsigned w) { return __builtin_bit_cast(float, w & 0xffff0000u); }

#define XB_TMO      128
#define XB_XCNT(j)  (256  + 64 * (j))
#define XB_XSUB(j)  (1280 + 64 * (j))
#define XB_XGEN(j)  (2304 + 64 * (j))
#define XB_TOP      3328
#define XB_TOPGEN   3392
#define XCD_BAR_WORDS 3456
#define XB_SPIN_CAP (1u << 18)

__device__ __forceinline__ unsigned xb_ld(unsigned* p)              { return __hip_atomic_load(p, __ATOMIC_RELAXED, __HIP_MEMORY_SCOPE_AGENT); }
__device__ __forceinline__ unsigned xb_add(unsigned* p, unsigned v) { return __hip_atomic_fetch_add(p, v, __ATOMIC_RELAXED, __HIP_MEMORY_SCOPE_AGENT); }
__device__ __forceinline__ unsigned xb_xcc_id() { return (unsigned)__builtin_amdgcn_s_getreg((3 << 11) | 20) & 0xFu; }
#define XB_SPIN(cond, bar) do { unsigned _sp = 0; while (cond) { __builtin_amdgcn_s_sleep(1); \
    if ((++_sp & 255u) == 0u) { if (xb_ld(&(bar)[XB_TMO])) break; if (_sp > XB_SPIN_CAP) { atomicAdd(&(bar)[XB_TMO], 1u); break; } } } } while (0)

struct XcdBarrier {
    unsigned* bar; unsigned x;
    volatile LAS unsigned* st;
};
__device__ __forceinline__ XcdBarrier xcd_barrier_post(unsigned* bar, volatile LAS unsigned* st) {
    XcdBarrier b; b.bar = bar; b.x = xb_xcc_id(); b.st = st;
    if (threadIdx.x == 0) (void)xb_add(&bar[XB_XCNT(b.x)], 1u);
    return b;
}
__device__ __forceinline__ void xcd_barrier_complete(unsigned* bar, unsigned x, unsigned& nloc, unsigned& nx) {
    const unsigned G = gridDim.x * gridDim.y * gridDim.z;
    unsigned sum, cnt, mine, sp = 0u;
    for (;;) {
        sum = 0u; cnt = 0u; mine = 0u;
#pragma unroll 1
        for (unsigned j = 0; j < 16; ++j) { const unsigned c = xb_ld(&bar[XB_XCNT(j)]); sum += c; cnt += (c > 0u) ? 1u : 0u; mine = (j == x) ? c : mine; }
        if (sum == G) break;
        __builtin_amdgcn_s_sleep(1);
        if ((++sp & 255u) == 0u) { if (xb_ld(&bar[XB_TMO])) break; if (sp > XB_SPIN_CAP) { atomicAdd(&bar[XB_TMO], 1u); break; } }
    }
    nloc = mine > 0u ? mine : 1u; nx = cnt > 0u ? cnt : 1u;
}
__device__ __forceinline__ void xcd_barrier(const XcdBarrier& b) {
    asm volatile("s_waitcnt vmcnt(0)" ::: "memory");
    __syncthreads();
    if (threadIdx.x == 0) {
        unsigned* bar = b.bar;
        __builtin_amdgcn_s_waitcnt(0);
        unsigned nloc = b.st[0], nx = b.st[1];
        if (nloc == 0u) { xcd_barrier_complete(bar, b.x, nloc, nx); b.st[0] = nloc; b.st[1] = nx; }
        const unsigned old = xb_add(&bar[XB_XSUB(b.x)], 1u);
        const unsigned gen = old / nloc;
        if (old + 1u == (gen + 1u) * nloc) {
            __builtin_amdgcn_fence(__ATOMIC_RELEASE, "agent");
            asm volatile("s_waitcnt vmcnt(0)" ::: "memory");
            const unsigned og = xb_add(&bar[XB_TOP], 1u);
            const unsigned tg = og / nx;
            if (og + 1u == (tg + 1u) * nx) xb_add(&bar[XB_TOPGEN], 1u);
            else XB_SPIN(xb_ld(&bar[XB_TOPGEN]) == tg, bar);
            __builtin_amdgcn_fence(__ATOMIC_ACQUIRE, "agent");
            xb_add(&bar[XB_XGEN(b.x)], 1u);
            asm volatile("s_waitcnt vmcnt(0)" ::: "memory");
        } else {
            XB_SPIN(xb_ld(&bar[XB_XGEN(b.x)]) == gen, bar);
            __builtin_amdgcn_fence(__ATOMIC_ACQUIRE, "agent");
            asm volatile("s_waitcnt vmcnt(0)" ::: "memory");
        }
    }
    __syncthreads();
}

__device__ __forceinline__ float wave_sum(float v) {
#pragma unroll
    for (int o = 1; o < 64; o <<= 1) v += __shfl_xor(v, o);
    return v;
}

struct Frame {
    LAS unsigned char* lds;
    volatile LAS unsigned* MISC;
    gu32* ctl;
    unsigned char* ws;
    int tid, lane, wave;
    int vcu, G;
    const float* in[25];
    float* out;
};
}
#if MK_DEBUG
namespace nv {
using namespace mk;
constexpr int R = T * TOPK;

struct GemmP {
    const float* A; const int* arow;
    const float* B; const float* bias; float* C;
    const int* cnt; const int* base;
    long strideB, strideBias;
    int lda, ldb, ldc, M, N, K;
    int swiglu, pad;
};
__global__ void __launch_bounds__(256) sgemm_k(GemmP p) {
    const int e = blockIdx.z;
    const int M = p.cnt ? p.cnt[e] : p.M;
    const int rbase = p.cnt ? p.base[e] : 0;
    const int m0 = blockIdx.y * 64, n0 = blockIdx.x * 64;
    if (m0 >= M) return;
    const float* B = p.B + (size_t)e * p.strideB;
    const float* bias = p.bias ? p.bias + (size_t)e * p.strideBias : nullptr;
    __shared__ float As[16][68], Bs[16][68], Bs2[16][68];
    const int tid = threadIdx.x, tx = tid & 15, ty = tid >> 4;
    const int ar = tid >> 2, ak = (tid & 3) * 4;
    const int bk = tid >> 4, bn = (tid & 15) * 4;
    long arow_idx = -1;
    if (m0 + ar < M) arow_idx = p.arow ? (long)p.arow[rbase + m0 + ar] : (long)(rbase + m0 + ar);
    const bool bvalid = (n0 + bn) < p.N;
    float acc[4][4] = {}, acc2[4][4] = {};
    for (int k0 = 0; k0 < p.K; k0 += 16) {
        float4 av = make_float4(0.f, 0.f, 0.f, 0.f), bv = make_float4(0.f, 0.f, 0.f, 0.f);
        if (arow_idx >= 0) av = *(const float4*)(p.A + (size_t)arow_idx * p.lda + k0 + ak);
        if (bvalid) bv = *(const float4*)(B + (size_t)(k0 + bk) * p.ldb + n0 + bn);
        As[ak + 0][ar] = av.x; As[ak + 1][ar] = av.y; As[ak + 2][ar] = av.z; As[ak + 3][ar] = av.w;
        *(float4*)&Bs[bk][bn] = bv;
        if (p.swiglu) { float4 bv2 = make_float4(0.f, 0.f, 0.f, 0.f); if (bvalid) bv2 = *(const float4*)(B + (size_t)(k0 + bk) * p.ldb + p.N + n0 + bn); *(float4*)&Bs2[bk][bn] = bv2; }
        __syncthreads();
#pragma unroll
        for (int k = 0; k < 16; ++k) {
            const float4 a4 = *(const float4*)&As[k][ty * 4];
            const float4 b4 = *(const float4*)&Bs[k][tx * 4];
            const float a[4] = {a4.x, a4.y, a4.z, a4.w}, b[4] = {b4.x, b4.y, b4.z, b4.w};
#pragma unroll
            for (int i = 0; i < 4; ++i)
#pragma unroll
                for (int j = 0; j < 4; ++j) acc[i][j] = fmaf(a[i], b[j], acc[i][j]);
            if (p.swiglu) { const float4 c4 = *(const float4*)&Bs2[k][tx * 4]; const float c[4] = {c4.x, c4.y, c4.z, c4.w};
#pragma unroll
                for (int i = 0; i < 4; ++i)
#pragma unroll
                    for (int j = 0; j < 4; ++j) acc2[i][j] = fmaf(a[i], c[j], acc2[i][j]); }
        }
        __syncthreads();
    }
#pragma unroll
    for (int i = 0; i < 4; ++i) {
        const int m = m0 + ty * 4 + i;
        if (m >= M) continue;
#pragma unroll
        for (int j = 0; j < 4; ++j) {
            const int n = n0 + tx * 4 + j;
            if (n < p.N) { float v = acc[i][j] + (bias ? bias[n] : 0.f);
                if (p.swiglu) { float g = fminf(v, 7.f), up = acc2[i][j] + (bias ? bias[p.N + n] : 0.f); up = fminf(fmaxf(up, -7.f), 7.f); v = (up + 1.f) * (g / (1.f + expf(-1.702f * g))); }
                p.C[(size_t)(rbase + m) * p.ldc + n] = v; }
        }
    }
}

__device__ __forceinline__ float block_sum256(float v, float* red) {
#pragma unroll
    for (int o = 32; o > 0; o >>= 1) v += __shfl_xor(v, o);
    __syncthreads();
    if ((threadIdx.x & 63) == 0) red[threadIdx.x >> 6] = v;
    __syncthreads();
    return red[0] + red[1] + red[2] + red[3];
}
__global__ void __launch_bounds__(256) ln_in_k(const float* x, const float* meta, const float* g, const float* b, float* H) {
    __shared__ float red[4];
    const int r = blockIdx.x, bb = r / L, p = r % L;
    const float* src = p < NMETA ? meta + (size_t)p * D : x + ((size_t)bb * SEQ + (p - NMETA)) * D;
    float v[4]; float s = 0.f;
#pragma unroll
    for (int i = 0; i < 4; ++i) { v[i] = src[threadIdx.x + 256 * i]; s += v[i]; }
    const float mu = block_sum256(s, red) * (1.f / D);
    float q = 0.f;
#pragma unroll
    for (int i = 0; i < 4; ++i) { v[i] -= mu; q += v[i] * v[i]; }
    const float rstd = 1.0f / sqrtf(block_sum256(q, red) * (1.f / D) + 1e-5f);
#pragma unroll
    for (int i = 0; i < 4; ++i) { const int c = threadIdx.x + 256 * i; H[(size_t)r * D + c] = v[i] * rstd * g[c] + b[c]; }
}
__global__ void __launch_bounds__(256) res_ln_k(float* H, const float* add, const float* g, const float* b, float* out) {
    __shared__ float red[4];
    const int r = blockIdx.x;
    float v[4]; float s = 0.f;
#pragma unroll
    for (int i = 0; i < 4; ++i) { const int c = threadIdx.x + 256 * i; v[i] = ALPHA * H[(size_t)r * D + c] + add[(size_t)r * D + c]; s += v[i]; }
    const float mu = block_sum256(s, red) * (1.f / D);
    float q = 0.f;
#pragma unroll
    for (int i = 0; i < 4; ++i) { v[i] -= mu; q += v[i] * v[i]; }
    const float rstd = 1.0f / sqrtf(block_sum256(q, red) * (1.f / D) + 1e-5f);
    const int bb = r / L, p = r % L;
#pragma unroll
    for (int i = 0; i < 4; ++i) {
        const int c = threadIdx.x + 256 * i; const float o = v[i] * rstd * g[c] + b[c];
        H[(size_t)r * D + c] = o;
        if (out && p >= NMETA) out[((size_t)bb * SEQ + (p - NMETA)) * D + c] = o;
    }
}
__global__ void __launch_bounds__(256) rms_cols_k(const float* P, int ldp, int col0, int W, const float* g, float* O) {
    __shared__ float red[4];
    const int r = blockIdx.x, c = threadIdx.x;
    const float v = c < W ? P[(size_t)r * ldp + col0 + c] : 0.f;
    const float ss = block_sum256(v * v, red);
    const float rstd = 1.0f / sqrtf(ss / (float)W + 1e-6f);
    if (c < W) O[(size_t)r * W + c] = v * rstd * g[c];
}
__global__ void __launch_bounds__(256) rotary_k(float* QM, const float* P, float* KROT) {
    const int r = blockIdx.x, p = r % L, t = threadIdx.x;
    if (t < 128 + 16) {
        const int i = t & 15;
        const float inv = 1.0f / powf(10000.0f, (float)(2 * i) / 32.0f);
        const float ang = (float)p * inv;
        const float c = cosf(ang), s = sinf(ang);
        if (t < 128) {
            const int h = t >> 4; float* q = QM + (size_t)r * 768 + h * 96 + 64;
            const float x1 = q[i], x2 = q[i + 16];
            q[i] = x1 * c - x2 * s; q[i + 16] = x1 * s + x2 * c;
        } else {
            const float* k = P + (size_t)r * NIN + 1152;
            const float x1 = k[i], x2 = k[i + 16];
            KROT[(size_t)r * 32 + i] = x1 * c - x2 * s; KROT[(size_t)r * 32 + i + 16] = x1 * s + x2 * c;
        }
    }
}

template <int MODE>
__global__ void __launch_bounds__(256) attn_k(const float* P, const float* QM, const float* KVM, const float* KROT, float* O) {
    __shared__ float sc[4][L + 16];
    __shared__ float qs[4][96];
    const int w = threadIdx.x >> 6, lane = threadIdx.x & 63;
    const int t = blockIdx.x * 4 + w, h = blockIdx.y, b = blockIdx.z;
    if (t >= L) return;
    const size_t row = (size_t)b * L + t;
    const int n = MODE == 0 ? t : t + 1;
    float* s = sc[w]; float* q = qs[w];
    if (MODE == 0) { q[lane] = P[row * NIN + h * 64 + lane]; }
    else { q[lane] = QM[row * 768 + h * 96 + lane]; if (lane < 32) q[64 + lane] = QM[row * 768 + h * 96 + 64 + lane]; }
    __syncthreads();
    const float scale = MODE == 0 ? 0.125f : 0.10206207261596575f;
    for (int j = lane; j < n; j += 64) {
        const size_t kr = (size_t)b * L + j; float a = 0.f;
        if (MODE == 0) { const float4* k = (const float4*)(P + kr * NIN + 256 + h * 64);
            for (int d = 0; d < 16; ++d) { const float4 kv = k[d]; a = fmaf(q[4 * d], kv.x, a); a = fmaf(q[4 * d + 1], kv.y, a); a = fmaf(q[4 * d + 2], kv.z, a); a = fmaf(q[4 * d + 3], kv.w, a); } }
        else { const float4* k = (const float4*)(KVM + kr * 1024 + h * 128);
            for (int d = 0; d < 16; ++d) { const float4 kv = k[d]; a = fmaf(q[4 * d], kv.x, a); a = fmaf(q[4 * d + 1], kv.y, a); a = fmaf(q[4 * d + 2], kv.z, a); a = fmaf(q[4 * d + 3], kv.w, a); }
            const float4* kp = (const float4*)(KROT + kr * 32);
            for (int d = 0; d < 8; ++d) { const float4 kv = kp[d]; a = fmaf(q[64 + 4 * d], kv.x, a); a = fmaf(q[64 + 4 * d + 1], kv.y, a); a = fmaf(q[64 + 4 * d + 2], kv.z, a); a = fmaf(q[64 + 4 * d + 3], kv.w, a); } }
        s[j] = a * scale;
    }
    __syncthreads();
    if (MODE == 1) {
        float m = -INFINITY; for (int j = lane; j < n; j += 64) m = fmaxf(m, s[j]);
#pragma unroll
        for (int o = 32; o > 0; o >>= 1) m = fmaxf(m, __shfl_xor(m, o));
        float sum = 0.f; for (int j = lane; j < n; j += 64) { const float e = expf(s[j] - m); s[j] = e; sum += e; }
#pragma unroll
        for (int o = 32; o > 0; o >>= 1) sum += __shfl_xor(sum, o);
        const float inv = 1.0f / sum;
        for (int j = lane; j < n; j += 64) s[j] *= inv;
    } else {
        const int C = (n + 63) / 64, j0 = lane * C, j1 = min(n, j0 + C);
        float cs = 0.f;
        for (int j = j0; j < j1; ++j) { const float z = s[j]; const float a = -(fmaxf(z, 0.f) + log1pf(expf(-fabsf(z)))); cs += a; }
        float incl = cs;
#pragma unroll
        for (int o = 1; o < 64; o <<= 1) { const float v = __shfl_down(incl, o); if (lane + o < 64) incl += v; }
        float run = incl - cs;
        for (int j = j1 - 1; j >= j0; --j) { const float z = s[j]; const float a = -(fmaxf(z, 0.f) + log1pf(expf(-fabsf(z)))); run += a; s[j] = expf(z + run); }
    }
    __syncthreads();
    float o = 0.f;
    if (MODE == 0) { const float* v = P + (size_t)b * L * NIN + 512 + h * 64 + lane; for (int j = 0; j < n; ++j) o = fmaf(s[j], v[(size_t)j * NIN], o); O[row * 256 + h * 64 + lane] = o; }
    else { const float* v = KVM + (size_t)b * L * 1024 + h * 128 + 64 + lane; for (int j = 0; j < n; ++j) o = fmaf(s[j], v[(size_t)j * 1024], o); O[row * 512 + h * 64 + lane] = o; }
}

__global__ void __launch_bounds__(256) mix_norm_k(const float* P, const float* SBO, const float* MLAO, const float* cw, const float* cb, const float* clg, const float* clb,
                                                  const float* gg, float* Y) {
    __shared__ float red[4];
    const int r = blockIdx.x, p = r % L, c = threadIdx.x;
    float acc = cb[c];
    for (int k = 0; k < CONVK; ++k) {
        const int pp = p - (CONVK - 1) + k;
        if (pp >= 0) { const float* pr = P + (size_t)(r - (CONVK - 1) + k) * NIN; const float a = pr[1184 + c], g = pr[1440 + c]; acc = fmaf(a / (1.f + expf(-g)), cw[k * 256 + c], acc); }
    }
    const float mu = block_sum256(acc, red) * (1.f / 256.f);
    const float dv = acc - mu;
    const float var = block_sum256(dv * dv, red) * (1.f / 256.f);
    float y = dv * (1.0f / sqrtf(var + 1e-5f)) * clg[c] + clb[c];
    y = y / (1.f + expf(-y));
    const float ssc = block_sum256(y * y, red);
    Y[(size_t)r * D + 768 + c] = y * (1.0f / sqrtf(ssc / 256.f + 1e-6f)) * gg[768 + c];
    const float sb = SBO[(size_t)r * 256 + c];
    const float sss = block_sum256(sb * sb, red);
    Y[(size_t)r * D + c] = sb * (1.0f / sqrtf(sss / 256.f + 1e-6f)) * gg[c];
    const float m0 = MLAO[(size_t)r * 512 + c], m1 = MLAO[(size_t)r * 512 + 256 + c];
    const float ssm = block_sum256(m0 * m0 + m1 * m1, red);
    const float rm = 1.0f / sqrtf(ssm / 512.f + 1e-6f);
    Y[(size_t)r * D + 256 + c] = m0 * rm * gg[256 + c];
    Y[(size_t)r * D + 512 + c] = m1 * rm * gg[512 + c];
}

__global__ void route_k(const float* LOG, int* cnt, int* te, int* tp, float* tg) {
    const int t = blockIdx.x * blockDim.x + threadIdx.x;
    if (t >= T) return;
    float v[NE];
#pragma unroll
    for (int e = 0; e < NE; ++e) v[e] = LOG[(size_t)t * NE + e];
    float tv[TOPK]; int ti[TOPK];
#pragma unroll
    for (int k = 0; k < TOPK; ++k) {
        float bv = -INFINITY; int bi = 0;
#pragma unroll
        for (int e = 0; e < NE; ++e) if (v[e] > bv) { bv = v[e]; bi = e; }
        tv[k] = bv; ti[k] = bi;
#pragma unroll
        for (int e = 0; e < NE; ++e) if (e == bi) v[e] = -INFINITY;
    }
    float sum = 0.f, ex[TOPK];
#pragma unroll
    for (int k = 0; k < TOPK; ++k) { ex[k] = expf(tv[k] - tv[0]); sum += ex[k]; }
#pragma unroll
    for (int k = 0; k < TOPK; ++k) { te[t * TOPK + k] = ti[k]; tg[t * TOPK + k] = ex[k] / sum; tp[t * TOPK + k] = atomicAdd(&cnt[ti[k]], 1); }
}
__global__ void prefix_k(const int* cnt, int* base) { if (threadIdx.x == 0) { int s = 0; for (int e = 0; e < NE; ++e) { base[e] = s; s += cnt[e]; } } }
__global__ void scatter_k(const int* te, const int* tp, const int* base, int* list, int* slot) {
    const int i = blockIdx.x * blockDim.x + threadIdx.x;
    if (i >= R) return;
    const int s = base[te[i]] + tp[i]; list[s] = i / TOPK; slot[i] = s;
}
__global__ void swiglu_k(const float* GU, float* ACT) {
    const size_t i = (size_t)blockIdx.x * blockDim.x + threadIdx.x;
    if (i >= (size_t)R * FF) return;
    const size_t r = i / FF; const int c = (int)(i % FF);
    float g = GU[r * 2 * FF + c], up = GU[r * 2 * FF + FF + c];
    g = fminf(g, 7.f); up = fminf(fmaxf(up, -7.f), 7.f);
    ACT[i] = (up + 1.f) * (g / (1.f + expf(-1.702f * g)));
}
__global__ void __launch_bounds__(256) combine_k(const float* YS, const int* slot, const float* tg, float* FFN) {
    const int t = blockIdx.x;
#pragma unroll
    for (int i = 0; i < 4; ++i) {
        const int c = threadIdx.x + 256 * i; float a = 0.f;
#pragma unroll
        for (int k = 0; k < TOPK; ++k) a += YS[(size_t)slot[t * TOPK + k] * D + c] * tg[t * TOPK + k];
        FFN[(size_t)t * D + c] = a;
    }
}
}
#endif
namespace mk {
struct MapId { __device__ __forceinline__ int operator()(int n) const { return n; } };
struct MapIn {
    __device__ __forceinline__ int operator()(int n) const {
        if (n < 1184) return n;
        if (n < 1280) return -1;
        const int t = n - 1280, tile = t >> 8, j = t & 255, ch = tile * 128 + (j & 127);
        return (j < 128 ? 1184 : 1440) + ch;
    }
};
struct MapGU {
    __device__ __forceinline__ int operator()(int n) const { const int pn = n >> 8, j = n & 255; return (j < 128 ? 0 : FF) + pn * 128 + (j & 127); }
};
template <class Map>
__device__ __forceinline__ void p0_transpose_item(const float* W, int K, int N, int nblk, bf16* WT, const float* gain, LAS float* scr, int item, int lane, Map map, int ldt = 0) {
    if (ldt == 0) ldt = K;
    const int kb = item / nblk, nb = item % nblk, k0 = 64 * kb, n0 = 32 * nb;
    const int src = map(n0 + (lane & 31));
#pragma unroll 8
    for (int i = 0; i < 32; ++i) { const int kk = 2 * i + (lane >> 5); float v = 0.f; if (src >= 0) v = W[(size_t)(k0 + kk) * N + src]; if (gain) v *= gain[k0 + kk]; scr[kk * 33 + (lane & 31)] = v; }
    LDS_WAIT(); asm volatile("" ::: "memory");
    const int c = lane & 7;
#pragma unroll
    for (int j = 0; j < 4; ++j) { const int n = (lane >> 3) + 8 * j; const LAS float* s = scr + (8 * c) * 33 + n;
        v4u o; o.x = pk2(s[0 * 33], s[1 * 33]); o.y = pk2(s[2 * 33], s[3 * 33]); o.z = pk2(s[4 * 33], s[5 * 33]); o.w = pk2(s[6 * 33], s[7 * 33]);
        *(GAS v4u*)(WT + (size_t)(n0 + n) * ldt + k0 + 8 * c) = o; }
    LDS_WAIT(); asm volatile("" ::: "memory");
}
template <class Map>
__device__ __forceinline__ void p0_tr64_load(const float* W, int N, int nblk, int item, int lane, Map map, f32x4 (&v)[8]) {
    const int kb = item / nblk, nb = item - kb * nblk; const float* src = W + (size_t)(32 * kb + (lane >> 4)) * N + map(64 * nb) + (lane & 15) * 4;
#pragma unroll
    for (int i = 0; i < 8; ++i) v[i] = __builtin_nontemporal_load((const f32x4*)(src + (size_t)(4 * i) * N));
}
__device__ __forceinline__ void p0_tr64_store(const f32x4 (&v)[8], int K, int nblk, int item, bf16* WT, LAS float* scr, int lane) {
    const int kb = item / nblk, nb = item - kb * nblk, k0 = 32 * kb, n0 = 64 * nb;
#pragma unroll
    for (int i = 0; i < 8; ++i) { LAS float* d = scr + (4 * i + (lane >> 4)) * 65 + (lane & 15) * 4; d[0] = v[i].x; d[1] = v[i].y; d[2] = v[i].z; d[3] = v[i].w; }
    LDS_WAIT(); asm volatile("" ::: "memory");
    const int c = lane & 3;
#pragma unroll
    for (int j = 0; j < 4; ++j) { const int n = (lane >> 2) + 16 * j; const LAS float* s = scr + (8 * c) * 65 + n;
        v4u o; o.x = cvtpk_rne(s[0 * 65], s[1 * 65]); o.y = cvtpk_rne(s[2 * 65], s[3 * 65]); o.z = cvtpk_rne(s[4 * 65], s[5 * 65]); o.w = cvtpk_rne(s[6 * 65], s[7 * 65]);
        *(GAS v4u*)(WT + (size_t)(n0 + n) * K + k0 + 8 * c) = o; }
    LDS_WAIT(); asm volatile("" ::: "memory");
}
struct Args { const float* in[25]; float* out; unsigned char* ws; int ph_lo, ph_hi; };
typedef const Args __attribute__((address_space(4)))* KArgs;
__device__ __forceinline__ KArgs kargs() { KArgs p = (KArgs)__builtin_amdgcn_kernarg_segment_ptr(); asm volatile("" : "+s"(p)); return p; }
enum { I_X = 0, I_META, I_LNIN_G, I_LNIN_B, I_WIN, I_QNG, I_WUQ, I_KVNG, I_WUKV, I_CONVW, I_CONVB, I_CLNG, I_CLNB, I_GRPG, I_WOUT, I_LNMIX_G, I_LNMIX_B, I_RW, I_RB, I_WGU, I_BGU, I_WD, I_BD, I_LNFFN_G, I_LNFFN_B };

__device__ __forceinline__ void ln_row16(f32x4 (&v)[4], const float* g, const float* b, int lane) {
    float s = 0.f;
#pragma unroll
    for (int j = 0; j < 4; ++j) s += (v[j].x + v[j].y) + (v[j].z + v[j].w);
    const float mean = wave_sum(s) * (1.f / D); float s2 = 0.f;
#pragma unroll
    for (int j = 0; j < 4; ++j) { v[j] = v[j] - mean; s2 += (v[j].x * v[j].x + v[j].y * v[j].y) + (v[j].z * v[j].z + v[j].w * v[j].w); }
    const float rstd = __builtin_amdgcn_rsqf(wave_sum(s2) * (1.f / D) + LN_EPS);
#pragma unroll
    for (int j = 0; j < 4; ++j) { const f32x4 gg = *(const f32x4*)(g + 4 * lane + 256 * j), bb = *(const f32x4*)(b + 4 * lane + 256 * j); v[j] = v[j] * rstd * gg + bb; }
}
__device__ __forceinline__ void store_row16(const f32x4 (&v)[4], float* hf, bf16* hb, int lane) {
#pragma unroll
    for (int j = 0; j < 4; ++j) {
        if (hf) *(f32x4*)(hf + 4 * lane + 256 * j) = v[j];
        if (hb) *(v2u*)(hb + 4 * lane + 256 * j) = (v2u){pk2(v[j].x, v[j].y), pk2(v[j].z, v[j].w)};
    }
}

__device__ __forceinline__ void p0_prologue(Frame& F, KArgs A) {
    LAS float* scr = (LAS float*)(F.lds + RING_OFF + F.wave * 16384);
    const int gw = F.vcu * NWAVES + F.wave, NGW = F.G * NWAVES, lane = F.lane;
    unsigned char* ws = F.ws;
    constexpr int I_IN = 16 * (NINP / 32), I_UQ = 4 * 24, I_UKV = 2 * 32, I_OUT = 16 * 32, I_GU = 32 * 32, I_DN = 32 * 16;
    constexpr int S0 = DEPTH * I_IN, S1 = S0 + DEPTH * I_UQ, S2 = S1 + DEPTH * I_UKV, S3 = S2 + DEPTH * I_OUT;
    for (int it = gw; it < S3; it += NGW) {
        if (it >= S2) { const int r = it - S2, l = r / I_OUT, i = r % I_OUT;
            p0_transpose_item(A->in[I_WOUT] + (size_t)l * D * D, D, D, D / 32, (bf16*)(ws + WS_WOUT) + (size_t)l * D * D, A->in[I_GRPG] + l * D, scr, i, lane, MapId()); }
        else if (it >= S1) { const int r = it - S1, l = r / I_UKV, i = r % I_UKV;
            p0_transpose_item(A->in[I_WUKV] + (size_t)l * 128 * 1024, 128, 1024, 1024 / 32, (bf16*)(ws + WS_WUKV2) + (size_t)l * 1024 * 256, A->in[I_KVNG] + l * 128, scr, i, lane, MapId(), 256); }
        else if (it >= S0) { const int r = it - S0, l = r / I_UQ, i = r % I_UQ;
            p0_transpose_item(A->in[I_WUQ] + (size_t)l * 256 * 768, 256, 768, 768 / 32, (bf16*)(ws + WS_WUQ) + (size_t)l * 768 * 256, A->in[I_QNG] + l * 256, scr, i, lane, MapId()); }
        else { const int l = it / I_IN, i = it % I_IN;
            p0_transpose_item(A->in[I_WIN] + (size_t)l * D * NIN, D, NIN, NINP / 32, (bf16*)(ws + WS_WIN) + (size_t)l * NINP * D, nullptr, scr, i, lane, MapIn()); }
    }
    const int gt = gw * 64 + lane, NGT = NGW * 64;
    for (int i = gt; i < DEPTH * NE * 2 * FF; i += NGT) { const int m = i / (2 * FF), n = i % (2 * FF); ((float*)(ws + WS_BGU))[i] = A->in[I_BGU][(size_t)m * 2 * FF + MapGU()(n)]; }
    for (int i = gt; i < L * 16; i += NGT) { const int p = i >> 4, k = i & 15; const float inv = 1.0f / powf(10000.0f, (float)(2 * k) / 32.0f); const float ang = (float)p * inv;
        ((f32x2*)(ws + WS_ROPE))[i] = (f32x2){cosf(ang), sinf(ang)}; }
    for (int i = gt; i < DEPTH * NE * D; i += NGT) { const int ll = i / (NE * D), e = (i / D) % NE, k = i % D; const float w = A->in[I_RW][((size_t)ll * D + k) * NE + e]; const unsigned h = f2bf(w);
        bf16* o = (bf16*)(ws + WS_RWT) + (size_t)ll * 2 * NE * D + (size_t)e * D + k; o[0] = (bf16)h; o[NE * D] = (bf16)f2bf(w - bf2f((bf16)h)); }
    for (int i = gt; i < DEPTH * 1024 * 128; i += NGT) ((bf16*)(ws + WS_WUKV2))[(size_t)(i >> 7) * 256 + 128 + (i & 127)] = 0;
    for (int i = gt; i < BATCH * PADF * 256; i += NGT) { const int b = i / (PADF * 256), r = i % (PADF * 256); ((bf16*)(ws + WS_SBV))[(size_t)b * LP * 256 + r] = 0; ((bf16*)(ws + WS_SBK))[(size_t)b * LP * 256 + r] = 0; }
    for (int i = gt; i < BATCH * PADF * 512; i += NGT) { const int b = i / (PADF * 512), r = i % (PADF * 512); ((bf16*)(ws + WS_VM))[(size_t)b * LP * 512 + r] = 0; }
    for (int i = gt; i < BATCH * PADF * 768; i += NGT) { const int b = i / (PADF * 768), r = i % (PADF * 768); ((bf16*)(ws + WS_KM))[(size_t)b * LP * 768 + r] = 0; }
    for (int r = gw; r < TP; r += NGW) {
        bf16* hb = (bf16*)(ws + WS_HB) + (size_t)r * D;
        if (r >= T) { *(v4u*)(hb + 8 * lane) = (v4u){0u, 0u, 0u, 0u}; *(v4u*)(hb + 512 + 8 * lane) = (v4u){0u, 0u, 0u, 0u}; continue; }
        const int bb = r / L, p = r - bb * L;
        const float* src = p < NMETA ? A->in[I_META] + (size_t)p * D : A->in[I_X] + ((size_t)bb * SEQ + (p - NMETA)) * D;
        f32x4 v[4];
#pragma unroll
        for (int j = 0; j < 4; ++j) v[j] = *(const f32x4*)(src + 4 * lane + 256 * j);
        ln_row16(v, A->in[I_LNIN_G], A->in[I_LNIN_B], lane);
        store_row16(v, nullptr, hb, lane);
    }
}


constexpr int CONV_IGU = 32 * 32, CONV_IDN = 32 * 16, CONV_NGU = NE * CONV_IGU, CONV_ITEMS = CONV_NGU + NE * CONV_IDN, CONV_PER_WG = CONV_ITEMS / 256, CONV_PER_WAVE = CONV_PER_WG / NWAVES;
static_assert(CONV_PER_WG * 256 == CONV_ITEMS && CONV_PER_WAVE * NWAVES == CONV_PER_WG, "static conversion partition");
__device__ __forceinline__ void glds16p(const void* gsrc, unsigned lds_dst) { unsigned keep;
    asm volatile("s_mov_b32 %0, m0\n\ts_mov_b32 m0, %2\n\ts_nop 0\n\tglobal_load_lds_dwordx4 %1, off\n\ts_mov_b32 m0, %0" : "=&s"(keep) : "v"(gsrc), "s"(lds_dst) : "memory"); }
struct ConvCtx { const float* wgu; const float* wdn; bf16* tgu; bf16* tdn; int base; unsigned slot; };
__device__ __forceinline__ void cv_decode(int g, bool& isgu, int& m, int& kb, int& nb) {
    isgu = g < CONV_NGU; const int r = isgu ? g : g - CONV_NGU;
    if (isgu) { m = r >> 10; const int i = r & 1023; kb = i >> 6; nb = i & 63; } else { m = r >> 9; const int i = r & 511; kb = i >> 5; nb = i & 31; }
}
constexpr int CV_SLOT = 8416;
__device__ __forceinline__ void cv_issue(const ConvCtx& c, int g, int lane) {
    bool isgu; int m, kb, nb; cv_decode(g, isgu, m, kb, nb);
    const int N = isgu ? 2 * FF : D, scol = isgu ? MapGU()(32 * nb) : 32 * nb;
    const float* sp = (isgu ? c.wgu + (size_t)m * D * 2 * FF : c.wdn + (size_t)m * FF * D) + (size_t)(64 * kb) * N + scol + (size_t)(lane >> 3) * N + 4 * (lane & 7);
#pragma unroll
    for (int i = 0; i < 8; ++i) { glds16p(sp, (unsigned)__builtin_amdgcn_readfirstlane((int)(c.slot + i * 1024 + (i & 3) * 32 + (i >> 2) * 128))); sp += 8 * N; }
}
__device__ __forceinline__ void cv_finish(const ConvCtx& c, int g, int lane, const LAS float* T) {
    bool isgu; int m, kb, nb; cv_decode(g, isgu, m, kb, nb);
    const int cc = lane & 3;
    bf16* dp = (isgu ? c.tgu + (size_t)m * 2 * FF * D : c.tdn + (size_t)m * D * FF) + (size_t)(32 * nb + (lane >> 2)) * 1024 + 64 * kb + 8 * cc;
    const LAS float* s = T + cc * 264 + (lane >> 2);
#pragma unroll
    for (int jn = 0; jn < 2; ++jn)
#pragma unroll
        for (int jk = 0; jk < 2; ++jk) { const LAS float* q = s + 1056 * jk + 16 * jn;
            v4u o; o.x = cvtpk_rne(q[0], q[32]); o.y = cvtpk_rne(q[64], q[96]); o.z = cvtpk_rne(q[128], q[160]); o.w = cvtpk_rne(q[192], q[224]);
            *(GAS v4u*)(dp + (size_t)jn * 16 * 1024 + jk * 32) = o; }
}

typedef pg8::f32x4 (AccT)[2][2][4][2];
__device__ __forceinline__ v2u pk4(f32x4 v) { return (v2u){cvtpk_rne(v.x, v.y), cvtpk_rne(v.z, v.w)}; }
__device__ __forceinline__ float sigmoidf_(float x) { return __builtin_amdgcn_rcpf(1.0f + __builtin_amdgcn_exp2f(x * -LOG2E)); }

struct EpiInProj {
    static constexpr bool PERM = false;
    bf16 *SBQ, *SBK, *SBV, *CQ, *CKV, *KM; float *U, *STQ, *STKV; const f32x2* ROPE;
    __device__ __forceinline__ void operator()(const AccT& acc, const pg8::Unit& u, int wr, int wc, int fr, int fq) const {
        const int pn = u.pn;
#pragma unroll
        for (int ai = 0; ai < 2; ++ai) {
            if (u.pm * 256 + ai * 128 >= T) continue;
#pragma unroll
            for (int m = 0; m < 4; ++m) {
                const int r = u.pm * 256 + ai * 128 + wr * 64 + m * 16 + fr;
                const int bb = r / L, p = r - bb * L; const size_t ar = (size_t)bb * LP + p + PADF;
                if (pn <= 2) {
                    bf16* dst = (pn == 0 ? SBQ : pn == 1 ? SBK : SBV) + ar * 256 + wc * 32 + 4 * fq; const float sc = pn == 0 ? SBQ_SCALE : 1.0f;
#pragma unroll
                    for (int bj = 0; bj < 2; ++bj)
#pragma unroll
                        for (int n = 0; n < 2; ++n) *(v2u*)(dst + bj * 128 + n * 16) = pk4(acc[ai][bj][m][n] * sc);
                } else if (pn == 3) {
                    float ss = 0.f;
#pragma unroll
                    for (int bj = 0; bj < 2; ++bj)
#pragma unroll
                        for (int n = 0; n < 2; ++n) { const f32x4 v = acc[ai][bj][m][n]; ss += (v.x * v.x + v.y * v.y) + (v.z * v.z + v.w * v.w); *(v2u*)(CQ + (size_t)r * 256 + bj * 128 + wc * 32 + n * 16 + 4 * fq) = pk4(v); }
                    ss += __shfl_xor(ss, 16); ss += __shfl_xor(ss, 32);
                    if (fq == 0) STQ[(size_t)r * 4 + wc] = ss;
                } else if (pn == 4) {
                    float ss = 0.f;
#pragma unroll
                    for (int n = 0; n < 2; ++n) { const f32x4 v = acc[ai][0][m][n]; ss += (v.x * v.x + v.y * v.y) + (v.z * v.z + v.w * v.w); *(v2u*)(CKV + (size_t)r * 256 + wc * 32 + n * 16 + 4 * fq) = pk4(v); *(v2u*)(CKV + (size_t)r * 256 + 128 + wc * 32 + n * 16 + 4 * fq) = (v2u){0u, 0u}; }
                    ss += __shfl_xor(ss, 16); ss += __shfl_xor(ss, 32);
                    if (fq == 0) STKV[(size_t)r * 4 + wc] = ss;
                    if (wc == 0) {
                        const f32x4 x1 = acc[ai][1][m][0], x2 = acc[ai][1][m][1]; f32x4 y1, y2;
#pragma unroll
                        for (int j = 0; j < 4; ++j) { const f32x2 cs = ROPE[p * 16 + 4 * fq + j]; y1[j] = x1[j] * cs.x - x2[j] * cs.y; y2[j] = x1[j] * cs.y + x2[j] * cs.x; }
                        const v2u w1 = pk4(y1), w2 = pk4(y2);
#pragma unroll
                        for (int h = 0; h < 8; ++h) { bf16* kd = KM + ar * 768 + h * 96 + 64 + 4 * fq; *(v2u*)kd = w1; *(v2u*)(kd + 16) = w2; }
                    }
                } else {
#pragma unroll
                    for (int n = 0; n < 2; ++n) { const f32x4 a = acc[ai][0][m][n], g = acc[ai][1][m][n]; f32x4 o;
#pragma unroll
                        for (int j = 0; j < 4; ++j) o[j] = a[j] * sigmoidf_(g[j]);
                        *(f32x4*)(U + (size_t)r * 256 + (pn - 5) * 128 + wc * 32 + n * 16 + 4 * fq) = o; }
                }
                asm volatile("" ::: "memory");
            }
        }
    }
};
struct EpiMlaQ {
    static constexpr bool PERM = false;
    bf16* QM; const float* STQ; const f32x2* ROPE;
    __device__ __forceinline__ void operator()(const AccT& acc, const pg8::Unit& u, int wr, int wc, int fr, int fq) const {
#pragma unroll
        for (int ai = 0; ai < 2; ++ai) {
            if (u.pm * 256 + ai * 128 >= T) continue;
#pragma unroll
            for (int m = 0; m < 4; ++m) {
                const int r = u.pm * 256 + ai * 128 + wr * 64 + m * 16 + fr;
                const int bb = r / L, p = r - bb * L; const size_t ar = (size_t)bb * LP + p + PADF;
                const f32x4 st = *(const f32x4*)(STQ + (size_t)r * 4);
                const float rs = MLAQ_SCALE * __builtin_amdgcn_rsqf(((st.x + st.y) + (st.z + st.w)) * (1.f / 256.f) + RMS_EPS);
#pragma unroll
                for (int bj = 0; bj < 2; ++bj) {
                    const int G = 8 * u.pn + 4 * bj + wc, head = G / 3, part = G - 3 * head;
                    f32x4 v0 = acc[ai][bj][m][0] * rs, v1 = acc[ai][bj][m][1] * rs;
                    if (part == 2) {
#pragma unroll
                        for (int j = 0; j < 4; ++j) { const f32x2 cs = ROPE[p * 16 + 4 * fq + j]; const float x1 = v0[j], x2 = v1[j]; v0[j] = x1 * cs.x - x2 * cs.y; v1[j] = x1 * cs.y + x2 * cs.x; }
                    }
                    bf16* dst = QM + ar * 768 + head * 96 + part * 32 + 4 * fq;
                    *(v2u*)dst = pk4(v0); *(v2u*)(dst + 16) = pk4(v1);
                }
                asm volatile("" ::: "memory");
            }
        }
    }
};
struct EpiMlaKV {
    static constexpr bool PERM = false;
    bf16 *KM, *VM; const float* STKV;
    __device__ __forceinline__ void operator()(const AccT& acc, const pg8::Unit& u, int wr, int wc, int fr, int fq) const {
#pragma unroll
        for (int ai = 0; ai < 2; ++ai) {
            if (u.pm * 256 + ai * 128 >= T) continue;
#pragma unroll
            for (int m = 0; m < 4; ++m) {
                const int r = u.pm * 256 + ai * 128 + wr * 64 + m * 16 + fr;
                const int bb = r / L, p = r - bb * L; const size_t ar = (size_t)bb * LP + p + PADF;
                const f32x4 st = *(const f32x4*)(STKV + (size_t)r * 4);
                const float rs = __builtin_amdgcn_rsqf(((st.x + st.y) + (st.z + st.w)) * (1.f / 128.f) + RMS_EPS);
#pragma unroll
                for (int bj = 0; bj < 2; ++bj) {
                    const int G = 8 * u.pn + 4 * bj + wc, head = G >> 2, part = G & 3;
                    bf16* dst = part < 2 ? KM + ar * 768 + head * 96 + part * 32 + 4 * fq : VM + ar * 512 + head * 64 + (part - 2) * 32 + 4 * fq;
                    *(v2u*)dst = pk4(acc[ai][bj][m][0] * rs); *(v2u*)(dst + 16) = pk4(acc[ai][bj][m][1] * rs);
                }
                asm volatile("" ::: "memory");
            }
        }
    }
};
struct EpiMla {
    static constexpr bool PERM = false;
    EpiMlaQ q; EpiMlaKV kv;
    __device__ __forceinline__ void operator()(const AccT& acc, const pg8::Unit& u, int wr, int wc, int fr, int fq) const { if (u.kind == 0) q(acc, u, wr, wc, fr, fq); else kv(acc, u, wr, wc, fr, fq); }
};
struct MlaOrder {
    pg8::StaticOrder sq, sk; int G, c;
    __device__ __forceinline__ bool next(int i, pg8::Unit& u) const {
        const int Lx = i * G + c;
        if (Lx < sq.nwg) { pg8::StaticOrder s = sq; s.G = 1; s.c = 0; const bool ok = s.next(Lx, u); u.kind = 0; return ok; }
        if (Lx - sq.nwg < sk.nwg) { pg8::StaticOrder s = sk; s.G = 1; s.c = 0; const bool ok = s.next(Lx - sq.nwg, u); u.kind = 1; return ok; }
        return false;
    }
};
struct EpiOut {
    static constexpr bool PERM = false;
    const bf16* HBr; float* Z;
    __device__ __forceinline__ void operator()(const AccT& acc, const pg8::Unit& u, int wr, int wc, int fr, int fq) const {
#pragma unroll
        for (int ai = 0; ai < 2; ++ai) {
            if (u.pm * 256 + ai * 128 >= T) continue;
#pragma unroll
            for (int m = 0; m < 4; ++m) {
                const size_t off = (size_t)(u.pm * 256 + ai * 128 + wr * 64 + m * 16 + fr) * D + u.pn * 256 + wc * 32 + 4 * fq;
#pragma unroll
                for (int bj = 0; bj < 2; ++bj)
#pragma unroll
                    for (int n = 0; n < 2; ++n) { const v2u hw = *(const v2u*)(HBr + off + bj * 128 + n * 16); const f32x4 h = (f32x4){bflo(hw.x), bfhi(hw.x), bflo(hw.y), bfhi(hw.y)}; *(f32x4*)(Z + off + bj * 128 + n * 16) = h * ALPHA + acc[ai][bj][m][n]; }
                asm volatile("" ::: "memory");
            }
        }
    }
};
struct EpiOutTail {
    static constexpr bool PERM = false;
    float* ZP;
    __device__ __forceinline__ void operator()(const AccT& acc, const pg8::Unit& u, int wr, int wc, int fr, int fq) const {
        float* base = ZP + (size_t)(u.ko >> 8) * 128 * D;
#pragma unroll
        for (int m = 0; m < 4; ++m) {
            const size_t off = (size_t)(wr * 64 + m * 16 + fr) * D + u.pn * 256 + wc * 32 + 4 * fq;
#pragma unroll
            for (int bj = 0; bj < 2; ++bj)
#pragma unroll
                for (int n = 0; n < 2; ++n) *(f32x4*)(base + off + bj * 128 + n * 16) = acc[0][bj][m][n];
        }
    }
};
struct TailOrder {
    int vcu;
    __device__ __forceinline__ bool next(int i, pg8::Unit& u) const { if (i > 0 || (vcu & 15) != 0) return false; const int j = vcu >> 4; u.pm = 64; u.pn = j & 3; u.pb = j & 3; u.ko = (j >> 2) * 256; u.kind = 0; return true; }
    __device__ __forceinline__ void a_ready(const pg8::Unit&) const {}
    __device__ __forceinline__ const LAS int* rowlist(int) const { return nullptr; }
};
__device__ __forceinline__ void store16_wt(void* p, v4u v) { asm volatile("global_store_dwordx4 %0, %1, off sc1\n\ts_nop 1" :: "v"(p), "v"(v) : "memory"); }
struct EpiMoe1 {
    static constexpr bool PERM = true;
    bf16* ACT; const float* BGU; unsigned* rdy;
    mutable int pend = -1;
    __device__ __forceinline__ void flush(int fr, int fq, bool drain_all) const {
        if (pend < 0) return;
        if (drain_all) asm volatile("s_waitcnt vmcnt(0)" ::: "memory"); else asm volatile("s_waitcnt vmcnt(8)" ::: "memory");
        if (fr == 0 && fq == 0) __hip_atomic_fetch_add(rdy + 16 * pend, 1u, __ATOMIC_RELAXED, __HIP_MEMORY_SCOPE_AGENT);
        pend = -1;
    }
    __device__ __forceinline__ void operator()(const AccT& acc, const pg8::Unit& u, int wr, int wc, int fr, int fq) const {
        flush(fr, fq, false);
        const int c8 = wc * 32 + 8 * fq; const float* bp = BGU + (size_t)u.pb * 256 + c8;
        f32x4 bg[2], bu[2];
#pragma unroll
        for (int n = 0; n < 2; ++n) { bg[n] = *(const f32x4*)(bp + 4 * n); bu[n] = *(const f32x4*)(bp + 128 + 4 * n); }
#pragma unroll
        for (int ai = 0; ai < 2; ++ai)
#pragma unroll
            for (int m = 0; m < 4; ++m) {
                bf16* dst = ACT + (size_t)(u.pm * 256 + ai * 128 + wr * 64 + m * 16 + fr) * FF + u.pn * 128 + c8;
                f32x4 o[2];
#pragma unroll
                for (int n = 0; n < 2; ++n) { const f32x4 g = acc[ai][0][m][n] + bg[n], up = acc[ai][1][m][n] + bu[n];
#pragma unroll
                    for (int j = 0; j < 4; j += 2) { f32x2 gg, uu; gg.x = fminf(g[j], 7.0f); gg.y = fminf(g[j + 1], 7.0f); uu.x = __builtin_amdgcn_fmed3f(up[j], -7.0f, 7.0f); uu.y = __builtin_amdgcn_fmed3f(up[j + 1], -7.0f, 7.0f);
                        const f32x2 t = gg * (-1.702f * LOG2E); f32x2 e; e.x = __builtin_amdgcn_exp2f(t.x); e.y = __builtin_amdgcn_exp2f(t.y);
                        const f32x2 d = e + 1.0f; f32x2 r; r.x = __builtin_amdgcn_rcpf(d.x); r.y = __builtin_amdgcn_rcpf(d.y);
                        const f32x2 res = (uu + 1.0f) * (gg * r); o[n][j] = res.x; o[n][j + 1] = res.y; } }
                v4u w; w.x = cvtpk_rne(o[0].x, o[0].y); w.y = cvtpk_rne(o[0].z, o[0].w); w.z = cvtpk_rne(o[1].x, o[1].y); w.w = cvtpk_rne(o[1].z, o[1].w);
                store16_wt(dst, w);
            }
        pend = u.pm;
    }
};
struct EpiMoe2 {
    static constexpr bool PERM = true;
    bf16* YS; const float* BD;
    __device__ __forceinline__ void operator()(const AccT& acc, const pg8::Unit& u, int wr, int wc, int fr, int fq) const {
        const int c8 = wc * 32 + 8 * fq; const float* bp = BD + (size_t)u.pb * 256 + c8;
        f32x4 bv[2][2];
#pragma unroll
        for (int bj = 0; bj < 2; ++bj)
#pragma unroll
            for (int n = 0; n < 2; ++n) bv[bj][n] = *(const f32x4*)(bp + bj * 128 + 4 * n);
#pragma unroll
        for (int ai = 0; ai < 2; ++ai)
#pragma unroll
            for (int m = 0; m < 4; ++m) {
                bf16* dst = YS + (size_t)(u.pm * 256 + ai * 128 + wr * 64 + m * 16 + fr) * D + u.pn * 256 + c8;
#pragma unroll
                for (int bj = 0; bj < 2; ++bj) { const f32x4 v0 = acc[ai][bj][m][0] + bv[bj][0], v1 = acc[ai][bj][m][1] + bv[bj][1];
                    v4u w; w.x = cvtpk_rne(v0.x, v0.y); w.y = cvtpk_rne(v0.z, v0.w); w.z = cvtpk_rne(v1.x, v1.y); w.w = cvtpk_rne(v1.z, v1.w);
                    *(v4u*)(dst + bj * 128) = w; }
                asm volatile("" ::: "memory");
            }
    }
};

struct EpiMoe12 {
    static constexpr bool PERM = true;
    EpiMoe1 e1; EpiMoe2 e2;
    __device__ __forceinline__ void operator()(const AccT& acc, const pg8::Unit& u, int wr, int wc, int fr, int fq) const { if (u.kind == 0) e1(acc, u, wr, wc, fr, fq); else { e1.flush(fr, fq, false); e2(acc, u, wr, wc, fr, fq); } }
};
#ifndef MOE_GM
#define MOE_GM 4
#endif
struct MoeOrder {
    const LAS int* tb; int G, vcu;
    __device__ __forceinline__ bool next(int i, pg8::Unit& u) const {
        const int TM = tb[NE]; int Lx = i * G + vcu; if (Lx >= TM * 12) return false;
        const int kind = Lx >= TM * 8 ? 1 : 0, NT = kind ? 4 : 8; if (kind) Lx -= TM * 8;
        constexpr int GM = MOE_GM;
        const int grp = Lx / (GM * NT), rem = Lx - grp * GM * NT, gs = (TM - GM * grp) < GM ? (TM - GM * grp) : GM;
        const int pn = rem / gs, pm = GM * grp + (rem - pn * gs);
        int e = 0;
#pragma unroll 1
        for (int k = 1; k < NE; ++k) e += (tb[k] <= pm) ? 1 : 0;
        u.pm = pm; u.pn = pn; u.pb = e * NT + pn; u.ko = 0; u.kind = kind; return true;
    }
};
__device__ __forceinline__ void moe_tile_prefix(Frame& F, int l, LAS int* tb) {
    if (F.tid == 0) { int s = 0; for (int e = 0; e < NE; ++e) { tb[e] = s; s += ((int)__hip_atomic_load(F.ctl + CW_CNT + l * 64 + e, RLX_AGENT) + 255) >> 8; } tb[NE] = s; }
    __syncthreads();
}

constexpr int CONV_RUN = 9;
__device__ __forceinline__ void phase_norm_conv(Frame& F, KArgs A, int l) {
    unsigned char* ws = F.ws; int lane = F.lane; asm volatile("" : "+v"(lane));
    LAS float* cw = (LAS float*)(F.lds + RING_OFF);
    const float* cwg = A->in[I_CONVW] + (size_t)l * CONVK * 256;
    for (int i = F.wave * 64 + lane; i < 47 * 256; i += NWAVES * 64) { const int k = (i >> 8) - 8; cw[i] = (k >= 0 && k < CONVK) ? cwg[k * 256 + (i & 255)] : 0.f; }
    __syncthreads();
    const bf16* OATT = (const bf16*)(ws + WS_OATT); const float* U = (const float*)(ws + WS_U); bf16* Y = (bf16*)(ws + WS_Y);
    const f32x4 cb = *(const f32x4*)(A->in[I_CONVB] + l * 256 + 4 * lane), lg = *(const f32x4*)(A->in[I_CLNG] + l * 256 + 4 * lane), lb = *(const f32x4*)(A->in[I_CLNB] + l * 256 + 4 * lane);
    const int gw = F.vcu * NWAVES + F.wave, wpb = (F.G * NWAVES) / BATCH;
    const LAS f32x4* cwl = (const LAS f32x4*)(cw + 4 * lane);
    if (gw < wpb * BATCH) {
        const int b = gw / wpb, wi = gw - b * wpb, ps = (wi * L) / wpb, pe = ((wi + 1) * L) / wpb;
        const size_t rb = (size_t)b * L;
#pragma unroll 1
        for (int p0 = ps; p0 < pe; p0 += CONV_RUN) {
            const int n = (pe - p0) < CONV_RUN ? (pe - p0) : CONV_RUN;
            f32x4 acc[CONV_RUN];
#pragma unroll
            for (int i = 0; i < CONV_RUN; ++i) acc[i] = cb;
#pragma unroll 1
            for (int c = 0; c < 3; ++c) {
                f32x4 u[13];
#pragma unroll
                for (int jj = 0; jj < 13; ++jj) { const int j = -(CONVK - 1) + c * 13 + jj; int pr = p0 + j; const bool ok = pr >= 0; pr = pr < 0 ? 0 : (pr > L - 1 ? L - 1 : pr);
                    u[jj] = *(const f32x4*)(U + (rb + pr) * 256 + 4 * lane); if (!ok) u[jj] = (f32x4){0.f, 0.f, 0.f, 0.f}; }
                const LAS f32x4* wc = cwl + (c * 13) * 64;
#pragma unroll
                for (int jj = 0; jj < 13; ++jj)
#pragma unroll
                    for (int i = 0; i < CONV_RUN; ++i) acc[i] += u[jj] * wc[(jj - i + 8) * 64];
            }
#pragma unroll
            for (int i0 = 0; i0 < CONV_RUN; i0 += 3) {
                f32x4 o[3][3];
#pragma unroll
                for (int ii = 0; ii < 3; ++ii) { const int i = (i0 + ii) < n ? (i0 + ii) : 0;
#pragma unroll
                    for (int j = 0; j < 3; ++j) { const v2u w = *(const v2u*)(OATT + (rb + p0 + i) * 768 + 4 * lane + 256 * j); o[ii][j] = (f32x4){bflo(w.x), bfhi(w.x), bflo(w.y), bfhi(w.y)}; } }
#pragma unroll
                for (int ii = 0; ii < 3; ++ii) {
                    const int i = i0 + ii; const size_t r = rb + p0 + i;
                    f32x4 c = acc[i];
                    const float mu = wave_sum((c.x + c.y) + (c.z + c.w)) * (1.f / 256.f); c = c - mu;
                    const float var = wave_sum((c.x * c.x + c.y * c.y) + (c.z * c.z + c.w * c.w)) * (1.f / 256.f);
                    c = c * __builtin_amdgcn_rsqf(var + LN_EPS) * lg + lb;
#pragma unroll
                    for (int j = 0; j < 4; ++j) c[j] = c[j] * sigmoidf_(c[j]);
                    const float rc = __builtin_amdgcn_rsqf(wave_sum((c.x * c.x + c.y * c.y) + (c.z * c.z + c.w * c.w)) * (1.f / 256.f) + RMS_EPS);
                    const f32x4 o0 = o[ii][0], o1 = o[ii][1], o2 = o[ii][2];
                    const float s0 = wave_sum((o0.x * o0.x + o0.y * o0.y) + (o0.z * o0.z + o0.w * o0.w));
                    const float s1 = wave_sum(((o1.x * o1.x + o1.y * o1.y) + (o1.z * o1.z + o1.w * o1.w)) + ((o2.x * o2.x + o2.y * o2.y) + (o2.z * o2.z + o2.w * o2.w)));
                    const float r0s = __builtin_amdgcn_rsqf(s0 * (1.f / 256.f) + RMS_EPS), r1s = __builtin_amdgcn_rsqf(s1 * (1.f / 512.f) + RMS_EPS);
                    if (i < n) {
                        *(v2u*)(Y + r * D + 768 + 4 * lane) = pk4(c * rc);
                        *(v2u*)(Y + r * D + 4 * lane) = pk4(o0 * r0s);
                        *(v2u*)(Y + r * D + 256 + 4 * lane) = pk4(o1 * r1s);
                        *(v2u*)(Y + r * D + 512 + 4 * lane) = pk4(o2 * r1s);
                    }
                }
            }
        }
    }
    __syncthreads();
}

#ifndef RT_ROWS
#define RT_ROWS 4
#endif
__device__ __forceinline__ void phase_router(Frame& F, KArgs A, int l, bool dry = false) {
    typedef __attribute__((ext_vector_type(16))) float f32x16;
    unsigned char* ws = F.ws; int tid = F.tid; asm volatile("" : "+v"(tid)); const int lane = tid & 63, wave = F.wave;
    LAS float* PART = (LAS float*)(F.lds + RING_OFF);
    LAS int* lcnt = (LAS int*)(F.lds + TAIL_OFF); LAS int* lbase = lcnt + 32; LAS int* sel = lbase + 32;
    if (tid < 32) lcnt[tid] = 0;
    const int start = (int)(((long)F.vcu * T) / F.G), end = (int)(((long)(F.vcu + 1) * T) / F.G);
    const float* Z = (const float*)(ws + WS_Z); bf16* HL = (bf16*)(ws + WS_HL); bf16* HB = (bf16*)(ws + WS_HB);
    int* TOKE = (int*)(ws + WS_TOKE); int* TOKP = (int*)(ws + WS_TOKP); float* TOKG = (float*)(ws + WS_TOKG); int* LIST = (int*)(ws + WS_LIST);
    const float* lng = A->in[I_LNMIX_G] + l * D; const float* lnb = A->in[I_LNMIX_B] + l * D;
#pragma unroll 1
    for (int t0 = start + wave; t0 < end; t0 += RT_ROWS * NWAVES) {
        f32x4 v[RT_ROWS][4];
#pragma unroll
        for (int s = 0; s < RT_ROWS; ++s) { const int t = (t0 + s * NWAVES) < end ? (t0 + s * NWAVES) : t0;
#pragma unroll
            for (int j = 0; j < 4; ++j) v[s][j] = *(const f32x4*)(Z + (size_t)t * D + 4 * lane + 256 * j); }
#pragma unroll
        for (int s = 0; s < RT_ROWS; ++s) { ln_row16(v[s], lng, lnb, lane); const int t = t0 + s * NWAVES;
            if (t < end) {
#pragma unroll
                for (int j = 0; j < 4; ++j) { const v2u hw = (v2u){pk2(v[s][j].x, v[s][j].y), pk2(v[s][j].z, v[s][j].w)};
                    *(v2u*)(HB + (size_t)t * D + 4 * lane + 256 * j) = hw;
                    *(v2u*)(HL + (size_t)t * D + 4 * lane + 256 * j) = (v2u){pk2(v[s][j].x - bflo(hw.x), v[s][j].y - bfhi(hw.x)), pk2(v[s][j].z - bflo(hw.y), v[s][j].w - bfhi(hw.y))}; } } }
    }
    asm volatile("s_waitcnt vmcnt(0)" ::: "memory");
    __syncthreads();
    const bf16* rwh = (const bf16*)(ws + WS_RWT) + (size_t)l * 2 * NE * D; const bf16* rwl = rwh + NE * D;
    const int r32 = lane & 31, hi = lane >> 5;
#pragma unroll 1
    for (int g0 = start; g0 < end; g0 += 96) {
        const int ng = (end - g0) < 96 ? (end - g0) : 96;
        f32x16 acc[3]; acc[0] = f32x16{}; acc[1] = f32x16{}; acc[2] = f32x16{};
        int tok[3];
#pragma unroll
        for (int g = 0; g < 3; ++g) tok[g] = g0 + ((32 * g + r32) < ng ? (32 * g + r32) : 0);
#pragma unroll 2
        for (int ks = 0; ks < 8; ++ks) {
            const int kk = 128 * wave + 16 * ks + 8 * hi;
            const bf16x8 bh = *(const bf16x8*)(rwh + (size_t)r32 * D + kk), bl = *(const bf16x8*)(rwl + (size_t)r32 * D + kk);
#pragma unroll
            for (int g = 0; g < 3; ++g) {
                const v4u aw = *(const v4u*)(HB + (size_t)tok[g] * D + kk), lw = *(const v4u*)(HL + (size_t)tok[g] * D + kk);
                const bf16x8 ah = __builtin_bit_cast(bf16x8, aw), al = __builtin_bit_cast(bf16x8, lw);
                acc[g] = __builtin_amdgcn_mfma_f32_32x32x16_bf16(ah, bh, acc[g], 0, 0, 0);
                acc[g] = __builtin_amdgcn_mfma_f32_32x32x16_bf16(ah, bl, acc[g], 0, 0, 0);
                acc[g] = __builtin_amdgcn_mfma_f32_32x32x16_bf16(al, bh, acc[g], 0, 0, 0);
            }
        }
#pragma unroll
        for (int g = 0; g < 3; ++g)
#pragma unroll
            for (int r = 0; r < 16; ++r) PART[(wave * 96 + 32 * g + (r & 3) + 8 * (r >> 2) + 4 * hi) * 33 + r32] = acc[g][r];
        __syncthreads();
        if (tid < ng) {
            const int t = g0 + tid; float v[32];
#pragma unroll
            for (int e = 0; e < 32; ++e) { float s = A->in[I_RB][l * NE + e];
#pragma unroll
                for (int w = 0; w < 8; ++w) s += PART[(w * 96 + tid) * 33 + e];
                v[e] = s; }
            float tv[4]; int ti[4];
#pragma unroll
            for (int k = 0; k < 4; ++k) {
                float bv = -INFINITY; int bi = 0;
#pragma unroll
                for (int e = 0; e < 32; ++e) if (v[e] > bv) { bv = v[e]; bi = e; }
                tv[k] = bv; ti[k] = bi;
#pragma unroll
                for (int e = 0; e < 32; ++e) if (e == bi) v[e] = -INFINITY;
            }
            float ex[4], sum = 0.f;
#pragma unroll
            for (int k = 0; k < 4; ++k) { ex[k] = __expf(tv[k] - tv[0]); sum += ex[k]; }
            const float inv = 1.0f / sum;
            *(v4u*)(TOKE + t * 4) = (v4u){(unsigned)ti[0], (unsigned)ti[1], (unsigned)ti[2], (unsigned)ti[3]};
            *(f32x4*)(TOKG + t * 4) = (f32x4){ex[0] * inv, ex[1] * inv, ex[2] * inv, ex[3] * inv};
#pragma unroll
            for (int k = 0; k < 4; ++k) { const int rank = __hip_atomic_fetch_add(lcnt + ti[k], 1, __ATOMIC_RELAXED, __HIP_MEMORY_SCOPE_WORKGROUP);
                sel[((t - start) * 4 + k) * 2] = ti[k]; sel[((t - start) * 4 + k) * 2 + 1] = rank; }
        }
        __syncthreads();
    }
    if (tid < 32) lbase[tid] = (int)__hip_atomic_fetch_add(F.ctl + CW_CNT + (dry ? 128 : 0) + l * 64 + tid, (unsigned)lcnt[tid], RLX_AGENT);
    __syncthreads();
    if (!dry) for (int i = tid; i < (end - start) * 4; i += NWAVES * 64) { const int e = sel[i * 2], pos = lbase[e] + sel[i * 2 + 1]; TOKP[(start + (i >> 2)) * 4 + (i & 3)] = pos; LIST[(size_t)e * T + pos] = start + (i >> 2); }
    __syncthreads();
}

__device__ __forceinline__ void phase_combine(Frame& F, KArgs A, int l, bool dry = false) {
    unsigned char* ws = F.ws; int lane = F.lane; asm volatile("" : "+v"(lane));
    bf16* HB = (bf16*)(ws + WS_HB); const bf16* YS = (const bf16*)(ws + WS_YS);
    const int* TOKE = (const int*)(ws + WS_TOKE); const int* TOKP = (const int*)(ws + WS_TOKP); const float* TOKG = (const float*)(ws + WS_TOKG);
    int tiles = 0; if (lane < NE) tiles = ((int)__hip_atomic_load(F.ctl + CW_CNT + l * 64 + lane, RLX_AGENT) + 255) >> 8;
    int incl = tiles;
#pragma unroll
    for (int o = 1; o < 32; o <<= 1) { const int v = __shfl_up(incl, o); if (lane >= o) incl += v; }
    const int tbl = incl - tiles;
    const float* lng = A->in[I_LNFFN_G] + l * D; const float* lnb = A->in[I_LNFFN_B] + l * D;
    f32x4 gg[4], bb[4];
#pragma unroll
    for (int q = 0; q < 4; ++q) { const int c = 8 * lane + 512 * (q >> 1) + 4 * (q & 1); gg[q] = *(const f32x4*)(lng + c); bb[q] = *(const f32x4*)(lnb + c); }
    const int gw = F.vcu * NWAVES + F.wave, NGW = F.G * NWAVES;
#pragma unroll 1
    for (int t0 = gw; t0 < T; t0 += 2 * NGW) {
        int tt[2]; tt[0] = t0; tt[1] = (t0 + NGW) < T ? (t0 + NGW) : t0; const bool ok1 = (t0 + NGW) < T;
        f32x4 v[2][4]; v4u y[2][4][2]; float g[2][4];
#pragma unroll
        for (int s = 0; s < 2; ++s) {
            const int t = tt[s];
            const v4u e4 = *(const v4u*)(TOKE + t * 4), p4 = *(const v4u*)(TOKP + t * 4); const f32x4 g4 = *(const f32x4*)(TOKG + t * 4);
#pragma unroll
            for (int jj = 0; jj < 2; ++jj) { const v4u hw = *(const v4u*)(HB + (size_t)t * D + 8 * lane + 512 * jj); v[s][2 * jj] = (f32x4){bflo(hw.x), bfhi(hw.x), bflo(hw.y), bfhi(hw.y)}; v[s][2 * jj + 1] = (f32x4){bflo(hw.z), bfhi(hw.z), bflo(hw.w), bfhi(hw.w)}; }
#pragma unroll
            for (int k = 0; k < 4; ++k) { const size_t row = (size_t)__shfl(tbl, (int)e4[k]) * 256 + p4[k]; g[s][k] = g4[k];
#pragma unroll
                for (int jj = 0; jj < 2; ++jj) y[s][k][jj] = *(const v4u*)(YS + row * D + 8 * lane + 512 * jj); }
        }
#pragma unroll
        for (int s = 0; s < 2; ++s) {
#pragma unroll
            for (int q = 0; q < 4; ++q) v[s][q] = v[s][q] * ALPHA;
#pragma unroll
            for (int k = 0; k < 4; ++k)
#pragma unroll
                for (int jj = 0; jj < 2; ++jj) { const v4u w = y[s][k][jj]; const float gk = g[s][k];
                    v[s][2 * jj] += (f32x4){bflo(w.x), bfhi(w.x), bflo(w.y), bfhi(w.y)} * gk; v[s][2 * jj + 1] += (f32x4){bflo(w.z), bfhi(w.z), bflo(w.w), bfhi(w.w)} * gk; }
            float sm = 0.f;
#pragma unroll
            for (int q = 0; q < 4; ++q) sm += (v[s][q].x + v[s][q].y) + (v[s][q].z + v[s][q].w);
            const float mean = wave_sum(sm) * (1.f / D); float s2 = 0.f;
#pragma unroll
            for (int q = 0; q < 4; ++q) { v[s][q] = v[s][q] - mean; s2 += (v[s][q].x * v[s][q].x + v[s][q].y * v[s][q].y) + (v[s][q].z * v[s][q].z + v[s][q].w * v[s][q].w); }
            const float rstd = __builtin_amdgcn_rsqf(wave_sum(s2) * (1.f / D) + LN_EPS);
#pragma unroll
            for (int q = 0; q < 4; ++q) v[s][q] = v[s][q] * rstd * gg[q] + bb[q];
            if (s == 0 || ok1) {
                const int t = tt[s];
                if (dry) { bf16* ob = (bf16*)(ws + WS_Z) + (size_t)t * D + 8 * lane;
#pragma unroll
                    for (int jj = 0; jj < 2; ++jj) *(v4u*)(ob + 512 * jj) = (v4u){pk2(v[s][2 * jj].x, v[s][2 * jj].y), pk2(v[s][2 * jj].z, v[s][2 * jj].w), pk2(v[s][2 * jj + 1].x, v[s][2 * jj + 1].y), pk2(v[s][2 * jj + 1].z, v[s][2 * jj + 1].w)};
                } else if (l == DEPTH - 1) {
                    const int bi = t / L, pp = t - bi * L;
                    if (pp >= NMETA) { float* o = F.out + ((size_t)bi * SEQ + (pp - NMETA)) * D + 8 * lane;
#pragma unroll
                        for (int q = 0; q < 4; ++q) *(f32x4*)(o + 512 * (q >> 1) + 4 * (q & 1)) = v[s][q]; }
                } else {
                    bf16* ob = HB + (size_t)t * D + 8 * lane;
#pragma unroll
                    for (int jj = 0; jj < 2; ++jj) *(v4u*)(ob + 512 * jj) = (v4u){pk2(v[s][2 * jj].x, v[s][2 * jj].y), pk2(v[s][2 * jj].z, v[s][2 * jj].w), pk2(v[s][2 * jj + 1].x, v[s][2 * jj + 1].y), pk2(v[s][2 * jj + 1].z, v[s][2 * jj + 1].w)};
                }
            }
        }
    }
}
}
namespace att {
using namespace mk;
typedef __attribute__((ext_vector_type(4))) short s16x4;
typedef __attribute__((ext_vector_type(16))) float f32x16;
typedef short v4i16_t __attribute__((ext_vector_type(4)));
typedef LAS const char* lds_cptr;
constexpr int KSLOT = 12288, VSLOT = 8192;
constexpr int NSLOT = 3;
constexpr int A_K = 0, A_V = NSLOT * KSLOT, A_WS = A_V + NSLOT * VSLOT, A_Q = A_WS + NWAVES * 256, A_BYTES = A_Q + 64;
constexpr float NEGBIG = -1.0e30f;
__device__ __forceinline__ int crow(int r, int hi) { return (r & 3) + 8 * (r >> 2) + 4 * hi; }
__device__ __forceinline__ void glds16(const void* gsrc, unsigned lds_dst) { unsigned keep;
    asm volatile("s_mov_b32 %0, m0\n\ts_mov_b32 m0, %2\n\ts_nop 0\n\tglobal_load_lds_dwordx4 %1, off\n\ts_mov_b32 m0, %0" : "=&s"(keep) : "v"(gsrc), "s"(lds_dst) : "memory"); }
__device__ __forceinline__ s16x4 vtr(lds_cptr p) { return __builtin_bit_cast(s16x4, __builtin_amdgcn_ds_read_tr16_b64_v4i16((LAS v4i16_t*)p)); }
__device__ __forceinline__ unsigned cvtpk(float lo, float hi) { typedef float f2 __attribute__((ext_vector_type(2))); typedef __bf16 b2 __attribute__((ext_vector_type(2))); f2 v = {lo, hi}; b2 b = __builtin_convertvector(v, b2); return __builtin_bit_cast(unsigned, b); }
__device__ __forceinline__ float max3f(float a, float b, float c) { float r; asm("v_max3_f32 %0, %1, %2, %3" : "=v"(r) : "v"(a), "v"(b), "v"(c)); return r; }
__device__ __forceinline__ float min2f(float a, float b) { float r; asm("v_min_f32_e32 %0, %1, %2" : "=v"(r) : "v"(a), "v"(b)); return r; }
#define ATT_WAIT_BAR(N) asm volatile("s_waitcnt vmcnt(" #N ") lgkmcnt(0)\n\ts_barrier" ::: "memory")

template <int MODE>
__device__ __forceinline__ void attn_unit(int b, int h, int qb  , const bf16* Q, const bf16* Kg, const bf16* Vg, bf16* OATT, char* shm, const ConvCtx cv, const LAS float* cvT, int& cnext, int& cpend) {
    constexpr int DQK = MODE == 0 ? 64 : 96, NKS = DQK / 16, NCH = DQK / 8;
    constexpr int QP = MODE == 0 ? 256 : 768, VP = MODE == 0 ? 256 : 512;
    int tid = threadIdx.x; asm volatile("" : "+v"(tid));
    const int lane = tid & 63, r32 = lane & 31, hi = lane >> 5; const int wid = __builtin_amdgcn_readfirstlane(tid >> 6);
    const int q0 = qb < 0 ? 0 : 64 + 256 * qb;
    const int NT = qb < 0 ? 1 : 4 * qb + 5;
    const size_t rowbase = (size_t)b * LP;
    const bf16* Qw = Q + (rowbase + q0 + wid * 32) * QP + h * DQK;
    const bf16* Kh = Kg + rowbase * QP + h * DQK; const bf16* Vh = Vg + rowbase * VP + h * 64;
    const unsigned lds0 = (unsigned)(uintptr_t)shm;
    LAS float* wsf = (LAS float*)(shm + A_WS) + wid * 64;
    const bf16* ksrc0 = Kh + (size_t)lane * QP + wid * 8; const bf16* ksrc1 = ksrc0 + 64;
    const bf16* vsrc = Vh + (size_t)(16 * (wid & 3) + (lane >> 2)) * VP + (wid >> 2) * 32 + (lane & 3) * 8;
    const unsigned kdst = lds0 + A_K + wid * 1024, vdst = lds0 + A_V + wid * 1024;
#define DMA_TILE(t, slot) do { glds16(ksrc0 + (size_t)(t) * 64 * QP, (unsigned)__builtin_amdgcn_readfirstlane(kdst + (slot) * KSLOT)); \
        if (NCH > 8 && wid < NCH - 8) glds16(ksrc1 + (size_t)(t) * 64 * QP, (unsigned)__builtin_amdgcn_readfirstlane(kdst + (slot) * KSLOT + 8192)); \
        glds16(vsrc + (size_t)(t) * 64 * VP, (unsigned)__builtin_amdgcn_readfirstlane(vdst + (slot) * VSLOT)); } while (0)
    const lds_cptr shm3 = (lds_cptr)shm;
    const lds_cptr kp0 = shm3 + A_K + hi * 1024 + r32 * 16;
    const lds_cptr vp0 = shm3 + A_V + ((lane >> 4) & 1) * 32 + (lane & 3) * 8 + (4 * hi + ((lane & 15) >> 2)) * 64;
    bf16x8 qr[NKS];
#pragma unroll
    for (int d0 = 0; d0 < NKS; ++d0) qr[d0] = *(const bf16x8*)(Qw + (size_t)r32 * QP + d0 * 16 + hi * 8);
    DMA_TILE(NT - 1, 0);
    if (NT > 1) DMA_TILE(NT - 2, 1);
#pragma unroll
    for (int d0 = 0; d0 < NKS; ++d0) asm volatile("" : "+v"(qr[d0]));
    const bool npt3 = (MODE == 1) && (wid < NCH - 8);
    f32x16 o[2]; o[0] = f32x16{}; o[1] = f32x16{};
    float mrun = NEGBIG, lrun = MODE == 0 ? 1.0f : 0.f;
    const int qpos = q0 + wid * 32 + r32;
    bf16x8 kf[2 * NKS];
#define LOAD_KF(slot_) do { const lds_cptr kb_ = kp0 + (slot_) * KSLOT; _Pragma("unroll") for (int d0 = 0; d0 < NKS; ++d0) { kf[2 * d0] = *(const LAS bf16x8*)(kb_ + d0 * 2048); kf[2 * d0 + 1] = *(const LAS bf16x8*)(kb_ + d0 * 2048 + 512); } } while (0)
    if (NT > 1) { if (npt3) ATT_WAIT_BAR(3); else ATT_WAIT_BAR(2); } else ATT_WAIT_BAR(0);
    int cur = 0, nx1 = 1, nx2 = 2, cage = 0;
    for (int i = 0; i < NT; ++i) {
        const int t = NT - 1 - i;
        if (cpend >= 0 && cage == 0) ATT_WAIT_BAR(8); else ATT_WAIT_BAR(0);
        __builtin_amdgcn_sched_barrier(0);
        if (cpend >= 0) { if (cage) { cv_finish(cv, cpend, lane, cvT); cpend = -1; } else cage = 1; }
        if (i + 2 < NT) {
            DMA_TILE(t - 2, nx2);
            if (cpend < 0 && cnext < CONV_PER_WAVE) { LDS_WAIT(); const int g_ = cv.base + 8 * cnext; cv_issue(cv, g_, lane); cpend = g_; ++cnext; cage = 0; }
        }
        __builtin_amdgcn_sched_barrier(0);
        const int slot = cur, slot1 = nx1; cur = nx1; nx1 = nx2; nx2 = nx2 == NSLOT - 1 ? 0 : nx2 + 1;
        const bool band = (64 * t + 63 >= q0);
        const bool skip = band && (64 * t > q0 + wid * 32 + 31 - (MODE == 0 ? 1 : 0));
        if (skip) continue;
        LOAD_KF(slot);
        __builtin_amdgcn_sched_barrier(0);
        f32x16 p0 = f32x16{}, p1 = f32x16{};
#pragma unroll
        for (int d0 = 0; d0 < NKS; ++d0) { p0 = __builtin_amdgcn_mfma_f32_32x32x16_bf16(kf[2 * d0], qr[d0], p0, 0, 0, 0); p1 = __builtin_amdgcn_mfma_f32_32x32x16_bf16(kf[2 * d0 + 1], qr[d0], p1, 0, 0, 0); }
        const lds_cptr vp = vp0 + slot * VSLOT; s16x4 vlo[4], vhh[4];
#pragma unroll
        for (int ks = 0; ks < 4; ++ks) { vlo[ks] = vtr(vp + ks * 1024); vhh[ks] = vtr(vp + ks * 1024 + 512); }
        __builtin_amdgcn_sched_barrier(0);
        if (band || t == 0) {
            const int kb0 = 64 * t + 4 * hi;
#pragma unroll
            for (int r = 0; r < 16; ++r) { const int kv = kb0 + (r & 3) + 8 * (r >> 2);
                const bool m0 = (MODE == 0 ? kv >= qpos : kv > qpos) || kv < PADF, m1 = (MODE == 0 ? kv + 32 >= qpos : kv + 32 > qpos) || (kv + 32) < PADF;
                if (m0) p0[r] = NEGBIG; if (m1) p1[r] = NEGBIG; }
        }
        if (MODE == 1) {
            float rm = max3f(p0[0], p1[0], p0[1]), rm2 = max3f(p1[1], p0[2], p1[2]);
#pragma unroll
            for (int r = 3; r < 15; r += 2) { rm = max3f(rm, p0[r], p1[r]); rm2 = max3f(rm2, p0[r + 1], p1[r + 1]); }
            rm = max3f(rm, p0[15], p1[15]); rm = max3f(rm, rm2, rm2);
            { auto rr = __builtin_amdgcn_permlane32_swap(__float_as_uint(rm), __float_as_uint(rm), false, false); rm = fmaxf(__uint_as_float(rr[0]), __uint_as_float(rr[1])); }
            if (__any(rm > mrun + 8.0f)) {
                const float mn = fmaxf(mrun, rm), f = __builtin_amdgcn_exp2f(mrun - mn); mrun = mn; lrun *= f;
                if (hi == 0) wsf[r32] = f;
                LDS_WAIT();
#pragma unroll
                for (int r = 0; r < 16; ++r) { const float fr_ = wsf[crow(r, hi)]; o[0][r] *= fr_; o[1][r] *= fr_; }
            }
            float sacc = 0.f;
#pragma unroll
            for (int r = 0; r < 16; ++r) { p0[r] = __builtin_amdgcn_exp2f(p0[r] - mrun); p1[r] = __builtin_amdgcn_exp2f(p1[r] - mrun); sacc += p0[r] + p1[r]; }
            lrun += sacc;
        } else {
            f32x16 a0, a1;
#pragma unroll
            for (int r = 0; r < 16; ++r) { p0[r] = __builtin_amdgcn_exp2f(min2f(p0[r], 80.0f)); p1[r] = __builtin_amdgcn_exp2f(min2f(p1[r], 80.0f));
                a0[r] = __builtin_amdgcn_rcpf(1.0f + p0[r]); a1[r] = __builtin_amdgcn_rcpf(1.0f + p1[r]); }
            float seg[16];
#pragma unroll
            for (int k = 0; k < 4; ++k) {
                const float s0 = (a0[4 * k] * a0[4 * k + 1]) * (a0[4 * k + 2] * a0[4 * k + 3]), s1 = (a1[4 * k] * a1[4 * k + 1]) * (a1[4 * k + 2] * a1[4 * k + 3]);
                auto r0 = __builtin_amdgcn_permlane32_swap(__float_as_uint(s0), __float_as_uint(s0), false, false);
                auto r1 = __builtin_amdgcn_permlane32_swap(__float_as_uint(s1), __float_as_uint(s1), false, false);
                seg[2 * k] = __uint_as_float(r0[0]); seg[2 * k + 1] = __uint_as_float(r0[1]); seg[8 + 2 * k] = __uint_as_float(r1[0]); seg[8 + 2 * k + 1] = __uint_as_float(r1[1]);
            }
            float run = lrun; float sfx[16];
#pragma unroll
            for (int g = 15; g >= 0; --g) { sfx[g] = run; run *= seg[g]; }
            lrun = run;
#pragma unroll
            for (int k = 0; k < 4; ++k) {
                float c0 = hi ? sfx[2 * k + 1] : sfx[2 * k], c1 = hi ? sfx[8 + 2 * k + 1] : sfx[8 + 2 * k];
#pragma unroll
                for (int j = 3; j >= 0; --j) { c0 *= a0[4 * k + j]; p0[4 * k + j] *= c0; c1 *= a1[4 * k + j]; p1[4 * k + j] *= c1; }
            }
        }
        v4u pw[4];
        pw[0] = (v4u){cvtpk(p0[0], p0[1]), cvtpk(p0[2], p0[3]), cvtpk(p0[4], p0[5]), cvtpk(p0[6], p0[7])};
        pw[1] = (v4u){cvtpk(p0[8], p0[9]), cvtpk(p0[10], p0[11]), cvtpk(p0[12], p0[13]), cvtpk(p0[14], p0[15])};
        pw[2] = (v4u){cvtpk(p1[0], p1[1]), cvtpk(p1[2], p1[3]), cvtpk(p1[4], p1[5]), cvtpk(p1[6], p1[7])};
        pw[3] = (v4u){cvtpk(p1[8], p1[9]), cvtpk(p1[10], p1[11]), cvtpk(p1[12], p1[13]), cvtpk(p1[14], p1[15])};
        __builtin_amdgcn_sched_barrier(0);
        s16x4 wlo[4], whh[4];
#pragma unroll
        for (int ks = 0; ks < 4; ++ks) { wlo[ks] = vtr(vp + 4096 + ks * 1024); whh[ks] = vtr(vp + 4096 + ks * 1024 + 512); }
#pragma unroll
        for (int ks = 0; ks < 4; ++ks) { const bf16x8 vf = (bf16x8){vlo[ks][0], vlo[ks][1], vlo[ks][2], vlo[ks][3], vhh[ks][0], vhh[ks][1], vhh[ks][2], vhh[ks][3]};
            o[0] = __builtin_amdgcn_mfma_f32_32x32x16_bf16(__builtin_bit_cast(bf16x8, pw[ks]), vf, o[0], 0, 0, 0); }
        __builtin_amdgcn_sched_barrier(0);
#pragma unroll
        for (int ks = 0; ks < 4; ++ks) { const bf16x8 vf = (bf16x8){wlo[ks][0], wlo[ks][1], wlo[ks][2], wlo[ks][3], whh[ks][0], whh[ks][1], whh[ks][2], whh[ks][3]};
            o[1] = __builtin_amdgcn_mfma_f32_32x32x16_bf16(__builtin_bit_cast(bf16x8, pw[ks]), vf, o[1], 0, 0, 0); }
    }
#undef LOAD_KF
    if (MODE == 1) {
        { auto rr = __builtin_amdgcn_permlane32_swap(__float_as_uint(lrun), __float_as_uint(lrun), false, false); lrun = __uint_as_float(rr[0]) + __uint_as_float(rr[1]); }
        if (hi == 0) wsf[32 + r32] = lrun;
        LDS_WAIT();
    }
    bf16* Ow = OATT + (size_t)(MODE == 0 ? 0 : 256) + h * 64 + r32;
#pragma unroll
    for (int r = 0; r < 16; ++r) {
        const int pp = q0 + wid * 32 + crow(r, hi);
        const float sc = MODE == 1 ? __builtin_amdgcn_rcpf(wsf[32 + crow(r, hi)]) : 1.0f;
        const bool valid = qb < 0 ? (pp >= PADF && pp < 64) : true;
        if (valid) { bf16* dst = Ow + ((size_t)b * L + (pp - PADF)) * 768; dst[0] = (bf16)f2bf(o[0][r] * sc); dst[32] = (bf16)f2bf(o[1][r] * sc); }
    }
    asm volatile("s_waitcnt lgkmcnt(0)\n\ts_barrier" ::: "memory");
#undef DMA_TILE
}

constexpr int A_CONV = 63616;
static_assert(A_BYTES <= A_CONV && A_CONV + NWAVES * CV_SLOT <= 131072, "attention scratch vs conversion slots");
__device__ __forceinline__ void attn_phase(Frame& F, KArgs A, int l, int qi  , char* shm) {
    unsigned char* ws = F.ws;
    LAS int* qw = (LAS int*)((LAS char*)F.lds + A_Q);
    bf16* OATT = (bf16*)(ws + WS_OATT);
    int lane = F.tid & 63; asm volatile("" : "+v"(lane));
    const LAS float* cvT = (const LAS float*)(F.lds + RING_OFF + A_CONV + F.wave * CV_SLOT);
    ConvCtx cv; cv.wgu = A->in[I_WGU] + (size_t)l * NE * D * 2 * FF; cv.wdn = A->in[I_WD] + (size_t)l * NE * FF * D;
    cv.tgu = (bf16*)(ws + WS_WGU) + (size_t)l * NE * 2 * FF * D; cv.tdn = (bf16*)(ws + WS_WD) + (size_t)l * NE * D * FF;
    cv.base = F.vcu * CONV_PER_WG + F.wave; int cnext = (qi & 3) ? CONV_PER_WAVE : 0, cpend = -1;
    cv.slot = (unsigned)__builtin_amdgcn_readfirstlane((int)(unsigned)(size_t)(F.lds + RING_OFF + A_CONV + F.wave * CV_SLOT));
    for (;;) {
        if (F.tid == 0) *qw = (int)__hip_atomic_fetch_add(F.ctl + CW_AQ + qi * 64, 1u, RLX_AGENT);
        __syncthreads();
        const int u = __builtin_amdgcn_readfirstlane(*qw);
        if (u >= 9 * 96) break;
        const int level = u / 96, w = u - level * 96, qb = 7 - level;
        if (w < 64) attn_unit<1>(w >> 3, w & 7, qb, (const bf16*)(ws + WS_QM), (const bf16*)(ws + WS_KM), (const bf16*)(ws + WS_VM), OATT, shm, cv, cvT, cnext, cpend);
        else attn_unit<0>((w - 64) >> 2, (w - 64) & 3, qb, (const bf16*)(ws + WS_SBQ), (const bf16*)(ws + WS_SBK), (const bf16*)(ws + WS_SBV), OATT, shm, cv, cvT, cnext, cpend);
    }
    while (cpend >= 0 || cnext < CONV_PER_WAVE) {
        if (cpend >= 0) { asm volatile("s_waitcnt vmcnt(0)" ::: "memory"); cv_finish(cv, cpend, lane, cvT); cpend = -1; }
        if (cnext < CONV_PER_WAVE) { LDS_WAIT(); const int g_ = cv.base + 8 * cnext; cv_issue(cv, g_, lane); cpend = g_; ++cnext; }
    }
    __syncthreads();
}
}
namespace mk {
constexpr int PH_PER_LAYER = 9, N_PHASES = 1 + DEPTH * PH_PER_LAYER;

__global__ void __launch_bounds__(NWAVES * 64, 2) mega_fwd(Args args) {
    extern __shared__ __attribute__((aligned(16))) unsigned char lds[];
    Frame F;
    F.lds = (LAS unsigned char*)lds;
    F.MISC = (volatile LAS unsigned*)(F.lds + MISC_OFF);
    F.tid = threadIdx.x; F.lane = F.tid & 63; F.wave = __builtin_amdgcn_readfirstlane(F.tid >> 6);
    F.G = gridDim.x; { const int bx = blockIdx.x; F.vcu = (F.G % 8 == 0) ? (bx % 8) * (F.G / 8) + bx / 8 : bx; }
    F.ws = args.ws; F.ctl = (gu32*)(args.ws + WS_CTL); F.out = args.out;
    unsigned char* ws = args.ws;
    for (int u = F.tid; u < (TAIL_OFF - LDSCTL_OFF) / 4; u += NWAVES * 64) ((LAS unsigned*)(F.lds + LDSCTL_OFF))[u] = 0u;
    __syncthreads();
    const int lo = args.ph_lo, hi = args.ph_hi;
    const bool use_bar = (hi - lo) > 1;
    XcdBarrier bar; bar.bar = (unsigned*)(F.ctl + CW_BAR); bar.x = 0; bar.st = nullptr;
    if (use_bar) bar = xcd_barrier_post((unsigned*)(F.ctl + CW_BAR), F.MISC + 8);
#ifndef MK_PT_MASK
#define MK_PT_MASK 0x3ff
#endif
#define IN(k) (lo <= (k) && (k) < hi)
#define PT(b) ((MK_PT_MASK >> (b)) & 1)
#ifndef MK_REP
#define MK_REP 0
#endif
#define REPS(b) (1 + ((MK_REP >> (b)) & 1))
#define SEAM(k) do { if (IN(k) && IN((k) + 1)) xcd_barrier(bar); } while (0)

    if (PT(0) && IN(0)) { _Pragma("unroll") for (int rep = 0; rep < REPS(0); ++rep) p0_prologue(F, kargs()); SEAM(0); }
#pragma unroll 1
    for (int l = 0; l < DEPTH; ++l) {
        const int pb = 1 + l * PH_PER_LAYER;
        const f32x2* ROPE = (const f32x2*)(ws + WS_ROPE);
        if (PT(1) && IN(pb + 0)) _Pragma("unroll") for (int rep = 0; rep < REPS(1); ++rep) {
            pg8::Gemm g{(const bf16*)(ws + WS_HB), (const bf16*)(ws + WS_WIN) + (size_t)l * NINP * D, TP, NINP, D};
            pg8::StaticOrder S; S.init(TP, NINP, F.G, (int)blockIdx.x);
            EpiInProj E{(bf16*)(ws + WS_SBQ), (bf16*)(ws + WS_SBK), (bf16*)(ws + WS_SBV), (bf16*)(ws + WS_CQ), (bf16*)(ws + WS_CKV2), (bf16*)(ws + WS_KM), (float*)(ws + WS_U), (float*)(ws + WS_STQ), (float*)(ws + WS_STKV), ROPE};
            { const pg8::ListOrder LO = pg8::make_list(S, (LAS int*)(F.lds + TAIL_OFF + 14336), nullptr); pg8::gemm_phase<EpiInProj, pg8::ListOrder, true, false>(F.lds + RING_OFF, g, LO, E); }
            SEAM(pb + 0);
        }
        if (PT(2) && IN(pb + 1)) _Pragma("unroll") for (int rep = 0; rep < REPS(2); ++rep) {
            { pg8::Gemm g{(const bf16*)(ws + WS_CQ), (const bf16*)(ws + WS_WUQ) + (size_t)l * 768 * 256, TP, 768, 256, 0, (const bf16*)(ws + WS_CKV2), (const bf16*)(ws + WS_WUKV2) + (size_t)l * 1024 * 256};
              MlaOrder S; S.sq.init(TP, 768, 1, 0); S.sk.init(TP, 1024, 1, 0); S.G = F.G; S.c = (int)blockIdx.x;
              EpiMla E{EpiMlaQ{(bf16*)(ws + WS_QM), (const float*)(ws + WS_STQ), ROPE}, EpiMlaKV{(bf16*)(ws + WS_KM), (bf16*)(ws + WS_VM), (const float*)(ws + WS_STKV)}};
              const pg8::ListOrder LO = pg8::make_list(S, (LAS int*)(F.lds + TAIL_OFF + 14336), nullptr);
              pg8::gemm_phase<EpiMla, pg8::ListOrder, true, false>(F.lds + RING_OFF, g, LO, E); }
            SEAM(pb + 1);
        }
        if (PT(3) && IN(pb + 2)) _Pragma("unroll") for (int rep = 0; rep < REPS(3); ++rep) { att::attn_phase(F, kargs(), l, l * 4 + rep, (char*)lds + RING_OFF); SEAM(pb + 2); }
        if (PT(4) && IN(pb + 3)) _Pragma("unroll") for (int rep = 0; rep < REPS(4); ++rep) { phase_norm_conv(F, kargs(), l); SEAM(pb + 3); }
        if (PT(5) && IN(pb + 4)) _Pragma("unroll") for (int rep = 0; rep < REPS(5); ++rep) {
            pg8::Gemm g{(const bf16*)(ws + WS_Y), (const bf16*)(ws + WS_WOUT) + (size_t)l * D * D, TP, D, D};
            pg8::StaticOrder S; S.init(64 * 256, D, F.G, (int)blockIdx.x);
            EpiOut E{(const bf16*)(ws + WS_HB), (float*)(ws + WS_Z)};
            { const pg8::ListOrder LO = pg8::make_list(S, (LAS int*)(F.lds + TAIL_OFF + 14336), nullptr); pg8::gemm_phase<EpiOut, pg8::ListOrder, true, false>(F.lds + RING_OFF, g, LO, E); }
            { pg8::Gemm gt{(const bf16*)(ws + WS_Y), (const bf16*)(ws + WS_WOUT) + (size_t)l * D * D, TP, D, 256, D};
              TailOrder ST{F.vcu}; EpiOutTail ET{(float*)(ws + WS_ZP)};
              pg8::gemm_phase<EpiOutTail, TailOrder, true, false>(F.lds + RING_OFF, gt, ST, ET);
              if ((F.vcu & 15) == 0) {
                  asm volatile("s_waitcnt vmcnt(0)" ::: "memory"); __syncthreads();
                  if (F.tid == 0) {
                      __builtin_amdgcn_fence(__ATOMIC_RELEASE, "agent"); asm volatile("s_waitcnt vmcnt(0)" ::: "memory");
                      unsigned* cw = (unsigned*)(F.ctl + CW_TAIL + l * 64); (void)xb_add(cw, 1u);
                      unsigned sp = 0; while (xb_ld(cw) < 16u * (unsigned)(rep + 1) && ++sp < (1u << 22)) __builtin_amdgcn_s_sleep(1);
                      __builtin_amdgcn_fence(__ATOMIC_ACQUIRE, "agent"); asm volatile("s_waitcnt vmcnt(0)" ::: "memory");
                  }
                  __syncthreads();
                  int tid_ = F.tid; asm volatile("" : "+v"(tid_));
                  const int row = (F.vcu >> 4) * 8 + (tid_ >> 6), c4 = (tid_ & 63) * 4; const float* ZP = (const float*)(ws + WS_ZP);
                  const bf16* hb = (const bf16*)(ws + WS_HB) + (size_t)(64 * 256 + row) * D; float* zr = (float*)(ws + WS_Z) + (size_t)(64 * 256 + row) * D;
#pragma unroll
                  for (int q = 0; q < 4; ++q) { const int c = c4 + 256 * q; const v2u hw = *(const v2u*)(hb + c); f32x4 a = (f32x4){bflo(hw.x), bfhi(hw.x), bflo(hw.y), bfhi(hw.y)} * ALPHA;
#pragma unroll
                      for (int k = 0; k < 4; ++k) a += *(const f32x4*)(ZP + ((size_t)k * 128 + row) * D + c);
                      *(f32x4*)(zr + c) = a; }
              } }
            SEAM(pb + 4);
        }
        if (PT(6) && IN(pb + 5)) { if (REPS(6) > 1) { phase_router(F, kargs(), l, true); SEAM(pb + 5); } phase_router(F, kargs(), l); SEAM(pb + 5); }
        if (PT(7) && IN(pb + 6)) _Pragma("unroll") for (int rep = 0; rep < REPS(7); ++rep) {
            LAS int* tb = (LAS int*)(F.lds + TAIL_OFF); LAS int* rows = tb + 64;
            moe_tile_prefix(F, l, tb);
            MoeOrder S{tb, F.G, F.vcu};
            { pg8::Unit u; const int* LIST = (const int*)(ws + WS_LIST); int tid_ = F.tid; asm volatile("" : "+v"(tid_));
              for (int i = 0; i < 13 && S.next(i, u) && u.kind == 0; ++i) {
                  const int e = u.pb / 8, mt = u.pm - tb[e], cnt = (int)__hip_atomic_load(F.ctl + CW_CNT + l * 64 + e, RLX_AGENT);
                  if (tid_ < 256) { const int idx = mt * 256 + tid_; rows[i * 256 + tid_] = idx < cnt ? LIST[(size_t)e * T + idx] : 0; }
              } }
            __syncthreads();
            pg8::Gemm g{(const bf16*)(ws + WS_HB), (const bf16*)(ws + WS_WGU) + (size_t)l * NE * 2 * FF * D, RP, 2 * FF, D, 0, (const bf16*)(ws + WS_ACT), (const bf16*)(ws + WS_WD) + (size_t)l * NE * D * FF};
            unsigned* rdy = (unsigned*)(F.ctl + CW_RDY + (l * 2 + rep) * 320 * 16);
            EpiMoe12 E{EpiMoe1{(bf16*)(ws + WS_ACT), (const float*)(ws + WS_BGU) + (size_t)l * NE * 2 * FF, rdy}, EpiMoe2{(bf16*)(ws + WS_YS), kargs()->in[I_BD] + (size_t)l * NE * D}};
            { pg8::ListOrder LO = pg8::make_list(S, (LAS int*)(F.lds + TAIL_OFF + 14336), rows); LO.rdy = rdy; LO.need = 64u;
              pg8::gemm_phase<EpiMoe12, pg8::ListOrder, true, true>(F.lds + RING_OFF, g, LO, E);
              { int t2 = F.tid; asm volatile("" : "+v"(t2)); E.e1.flush(t2 & 15, (t2 & 63) >> 4, true); } }
            SEAM(pb + 6);
        }
        if (PT(9) && IN(pb + 8)) { if (REPS(9) > 1) { phase_combine(F, kargs(), l, true); xcd_barrier(bar); } phase_combine(F, kargs(), l); SEAM(pb + 8); }
    }
#undef IN
#undef SEAM
}
}
#ifndef MK_DEBUG
#define MK_DEBUG 0
#endif
#if MK_DEBUG
namespace dbg {
using namespace mk;
struct CkSpec {
    const void* M; const float* N; const float* mgain; long ldm, ldn;
    int mtype  , mrowmap  , mcol0, mhstride, ncol0, nhstride, hc, nh; float scale; int pad;
};
__device__ __forceinline__ void blk_acc(float d2, float r2, double* acc) {
    __shared__ float sd[4], sr[4];
#pragma unroll
    for (int o = 32; o > 0; o >>= 1) { d2 += __shfl_xor(d2, o); r2 += __shfl_xor(r2, o); }
    if ((threadIdx.x & 63) == 0) { sd[threadIdx.x >> 6] = d2; sr[threadIdx.x >> 6] = r2; }
    __syncthreads();
    if (threadIdx.x == 0) { atomicAdd(acc, (double)(sd[0] + sd[1] + sd[2] + sd[3])); atomicAdd(acc + 1, (double)(sr[0] + sr[1] + sr[2] + sr[3])); }
}
__global__ void __launch_bounds__(256) check_k(CkSpec s, double* acc) {
    const long n = (long)T * s.nh * s.hc; float d2 = 0.f, r2 = 0.f;
    for (long i = (long)blockIdx.x * 256 + threadIdx.x; i < n; i += (long)gridDim.x * 256) {
        const long r = i / (s.nh * s.hc); const int cc = (int)(i % (s.nh * s.hc)), h = cc / s.hc, j = cc % s.hc;
        const int mcol = s.mcol0 + h * s.mhstride + j, ncol = s.ncol0 + h * s.nhstride + j;
        long mr = r; if (s.mrowmap) { const long bb = r / L; mr = bb * LP + (r - bb * L) + PADF; }
        float a = s.mtype ? ((const float*)s.M)[mr * s.ldm + mcol] : bf2f(((const bf16*)s.M)[mr * s.ldm + mcol]);
        if (s.mgain) a *= s.mgain[mcol];
        const float b = s.N[r * s.ldn + ncol] * s.scale;
        float d = a - b; if (!(d == d)) d = 1e18f; d2 += d * d; r2 += b * b;
    }
    blk_acc(d2, r2, acc);
}
__global__ void __launch_bounds__(256) check_u_k(const float* U, const float* P, double* acc) {
    const long n = (long)T * 256; float d2 = 0.f, r2 = 0.f;
    for (long i = (long)blockIdx.x * 256 + threadIdx.x; i < n; i += (long)gridDim.x * 256) {
        const long r = i >> 8; const int c = (int)(i & 255);
        const float a = U[i], g = P[r * NIN + 1440 + c], b = P[r * NIN + 1184 + c] / (1.f + expf(-g));
        float d = a - b; if (!(d == d)) d = 1e18f; d2 += d * d; r2 += b * b;
    }
    blk_acc(d2, r2, acc);
}
__global__ void __launch_bounds__(256) check_route_k(const int* TOKE, const float* TOKG, const int* te, const float* tg, double* acc, double* acc2) {
    float mm = 0.f, d2 = 0.f, r2 = 0.f;
    for (int t = blockIdx.x * 256 + threadIdx.x; t < T; t += gridDim.x * 256) {
        bool same = true;
        for (int k = 0; k < 4; ++k) same = same && (TOKE[t * 4 + k] == te[t * 4 + k]);
        if (!same) mm += 1.f; else for (int k = 0; k < 4; ++k) { const float d = TOKG[t * 4 + k] - tg[t * 4 + k]; d2 += d * d; r2 += tg[t * 4 + k] * tg[t * 4 + k]; }
    }
    blk_acc(mm, threadIdx.x == 0 && blockIdx.x == 0 ? (float)T : 0.f, acc);
    __syncthreads();
    blk_acc(d2, r2, acc2);
}
__global__ void tb_k(const unsigned* cnt, int* tb) { if (threadIdx.x == 0) { int s = 0; for (int e = 0; e < NE; ++e) { tb[e] = s; s += ((int)cnt[e] + 255) >> 8; } tb[NE] = s; } }
__global__ void __launch_bounds__(256) check_rows_k(const bf16* Mg, const int* tb, const int* TOKE, const int* TOKP, const float* Nv, const int* slot, const int* te, double* acc) {
    float d2 = 0.f, r2 = 0.f;
    for (long i = (long)blockIdx.x * 256 + threadIdx.x; i < (long)T * 4 * 1024; i += (long)gridDim.x * 256) {
        const int tk = (int)(i >> 10), c = (int)(i & 1023), t = tk >> 2;
        bool same = true;
        for (int k = 0; k < 4; ++k) same = same && (TOKE[t * 4 + k] == te[t * 4 + k]);
        if (!same) continue;
        const float a = bf2f(Mg[((size_t)tb[TOKE[tk]] * 256 + TOKP[tk]) * 1024 + c]), b = Nv[(size_t)slot[tk] * 1024 + c];
        float d = a - b; if (!(d == d)) d = 1e18f; d2 += d * d; r2 += b * b;
    }
    blk_acc(d2, r2, acc);
}
__global__ void __launch_bounds__(256) check_out_k(const float* out, const float* H, double* acc) {
    float d2 = 0.f, r2 = 0.f;
    for (long i = (long)blockIdx.x * 256 + threadIdx.x; i < (long)BATCH * SEQ * D; i += (long)gridDim.x * 256) {
        const long row = i >> 10; const int c = (int)(i & 1023); const long bb = row / SEQ, p = row - bb * SEQ;
        const float a = out[i], b = H[(bb * L + p + NMETA) * D + c]; float d = a - b; if (!(d == d)) d = 1e18f; d2 += d * d; r2 += b * b;
    }
    blk_acc(d2, r2, acc);
}
__global__ void __launch_bounds__(256) verdict_k(const double* acc, int nck, float tol, float* out, long nout) {
    int bad = -1; float cls = 0.f;
    for (int k = 0; k < nck; ++k) { const double d = acc[2 * k], r = acc[2 * k + 1]; if (r == 0.0 && d == 0.0) continue; const double q = r > 0.0 ? d / r : 1e30;
        const double tl = (k < 38 && (k - 2) % 18 == 14) ? 0.06 : (double)tol;
        if (!(q <= tl)) { bad = k; cls = q < 1e-3 ? 0.f : q < 1e-2 ? 1.f : q < 1e-1 ? 2.f : q < 1.0 ? 3.f : 4.f; break; } }
    if (bad < 0) return;
    const float c = sqrtf((10.f + (float)bad) * powf(10.f, cls));
    for (long i = (long)blockIdx.x * 256 + threadIdx.x; i < nout; i += (long)gridDim.x * 256) out[i] += c;
}
}
#endif

static void run_gemm(hipStream_t s, const float* A, int lda, const int* arow, const float* B, int ldb, long strideB, const float* bias, long strideBias, float* C, int ldc,
                     int M, int N, int K, const int* cnt, const int* base, int groups, int swiglu = 0) {
#if MK_DEBUG
    nv::GemmP p{A, arow, B, bias, C, cnt, base, strideB, strideBias, lda, ldb, ldc, M, N, K, swiglu, 0};
    dim3 grid((N + 63) / 64, (M + 63) / 64, groups);
    hipLaunchKernelGGL(nv::sgemm_k, grid, dim3(256), 0, s, p);
#endif
}

extern "C" void kernel_launch(void* const* d_in, const int* in_sizes, int n_in, void* d_out, int out_size, void* d_ws, size_t ws_size, hipStream_t stream) {
    using namespace mk;
    static int grid = 0;
    if (grid == 0) {
        int dev = 0, cus = 0;
        if (n_in != 25 || out_size != BATCH * SEQ * D || ws_size < (size_t)2040 * MiB) { fprintf(stderr, "kernel_launch: unexpected shapes (n_in %d out %d ws %zu)\n", n_in, out_size, ws_size); grid = -1; return; }
        if (hipGetDevice(&dev) != hipSuccess || hipDeviceGetAttribute(&cus, hipDeviceAttributeMultiprocessorCount, dev) != hipSuccess) { grid = -1; return; }
        if (hipFuncSetAttribute((const void*)mega_fwd, hipFuncAttributeMaxDynamicSharedMemorySize, LDS_BYTES) != hipSuccess) { fprintf(stderr, "kernel_launch: hipFuncSetAttribute failed\n"); grid = -1; return; }
        int per_cu = 0;
        if (hipOccupancyMaxActiveBlocksPerMultiprocessor(&per_cu, (const void*)mega_fwd, NWAVES * 64, LDS_BYTES) != hipSuccess || per_cu < 1) fprintf(stderr, "kernel_launch: occupancy query says %d\n", per_cu);
        (void)hipGetLastError();
        grid = cus;
    }
    if (grid < 0) return;
    (void)hipMemsetAsync((char*)d_ws + WS_CTL, 0, CTL_ZERO_BYTES, stream);
    Args a{};
    for (int i = 0; i < 25; ++i) a.in[i] = (const float*)d_in[i];
    a.out = (float*)d_out; a.ws = (unsigned char*)d_ws;
#if !MK_DEBUG
    a.ph_lo = 0; a.ph_hi = N_PHASES;
    hipLaunchKernelGGL(mega_fwd, dim3(grid), dim3(NWAVES * 64), LDS_BYTES, stream, a);
#else
    using namespace nv;
    auto mega = [&](int ph) { a.ph_lo = ph; a.ph_hi = ph + 1; hipLaunchKernelGGL(mega_fwd, dim3(grid), dim3(NWAVES * 64), LDS_BYTES, stream, a); };
    const float* x = (const float*)d_in[0]; const float* meta = (const float*)d_in[1];
    const float* ln_in_g = (const float*)d_in[2]; const float* ln_in_b = (const float*)d_in[3];
    const float* w_in = (const float*)d_in[4]; const float* q_norm_g = (const float*)d_in[5]; const float* w_uq = (const float*)d_in[6];
    const float* kv_norm_g = (const float*)d_in[7]; const float* w_ukv = (const float*)d_in[8]; const float* conv_w = (const float*)d_in[9];
    const float* conv_b = (const float*)d_in[10]; const float* conv_ln_g = (const float*)d_in[11]; const float* conv_ln_b = (const float*)d_in[12];
    const float* grp_norm_g = (const float*)d_in[13]; const float* w_out = (const float*)d_in[14]; const float* ln_mix_g = (const float*)d_in[15];
    const float* ln_mix_b = (const float*)d_in[16]; const float* router_w = (const float*)d_in[17]; const float* router_b = (const float*)d_in[18];
    const float* w_gate_up = (const float*)d_in[19]; const float* b_gate_up = (const float*)d_in[20]; const float* w_down = (const float*)d_in[21];
    const float* b_down = (const float*)d_in[22]; const float* ln_ffn_g = (const float*)d_in[23]; const float* ln_ffn_b = (const float*)d_in[24];
    float* out = (float*)d_out;
    unsigned char* mw = (unsigned char*)d_ws;
    char* w = (char*)d_ws; size_t off = (size_t)1088 * MiB;
    auto take = [&](size_t bytes) { char* p = w + off; off += (bytes + 255) & ~(size_t)255; return p; };
    double* acc = (double*)take(64 * 16); int* tbd = (int*)take(256);
    int* cnt = (int*)take(256); int* base = (int*)take(256);
    int* te = (int*)take((size_t)R * 4); int* tp = (int*)take((size_t)R * 4); float* tg = (float*)take((size_t)R * 4);
    int* list = (int*)take((size_t)R * 4); int* slot = (int*)take((size_t)R * 4);
    float* H = (float*)take((size_t)T * D * 4);
    float* MIX = (float*)take((size_t)T * D * 4);
    float* LOG = (float*)take((size_t)T * NE * 4);
    float* ACT = (float*)take((size_t)R * FF * 4);
    char* alias0 = w + off;
    float* P = (float*)take((size_t)T * NIN * 4);
    float* CQN = (float*)take((size_t)T * 256 * 4); float* CKVN = (float*)take((size_t)T * 128 * 4);
    float* QM = (float*)take((size_t)T * 768 * 4); float* KVM = (float*)take((size_t)T * 1024 * 4); float* KROT = (float*)take((size_t)T * 32 * 4);
    float* SBO = (float*)take((size_t)T * 256 * 4); float* MLAO = (float*)take((size_t)T * 512 * 4);
    float* Y = (float*)take((size_t)T * D * 4);
    float* YS = (float*)alias0;
    if ((size_t)(w + off - alias0) < (size_t)R * D * 4) { fprintf(stderr, "alias too small\n"); return; }
    if (off > ws_size) { fprintf(stderr, "workspace too small: need %zu have %zu\n", off, ws_size); return; }
    (void)hipMemsetAsync(acc, 0, 64 * 16, stream);
    const int CG = 1024;
    auto ck = [&](int id, const void* M, int mtype, int mrowmap, long ldm, int mcol0, int mhstride, const float* N, long ldn, int ncol0, int nhstride, int hc, int nh, float scale, const float* mgain) {
        dbg::CkSpec s{M, N, mgain, ldm, ldn, mtype, mrowmap, mcol0, mhstride, ncol0, nhstride, hc, nh, scale, 0};
        hipLaunchKernelGGL(dbg::check_k, dim3(CG), dim3(256), 0, stream, s, acc + 2 * id);
    };
    mega(0);
    hipLaunchKernelGGL(ln_in_k, dim3(T), dim3(256), 0, stream, x, meta, ln_in_g, ln_in_b, H);
    ck(1, mw + WS_HB, 0, 0, D, 0, 0, H, D, 0, 0, D, 1, 1.f, nullptr);
    for (int l = 0; l < DEPTH; ++l) {
        const int pb = 1 + l * PH_PER_LAYER, cb = 2 + 18 * l;
        mega(pb + 0);
        run_gemm(stream, H, D, nullptr, w_in + (size_t)l * D * NIN, NIN, 0, nullptr, 0, P, NIN, T, NIN, D, nullptr, nullptr, 1);
        ck(cb + 0, mw + WS_SBQ, 0, 1, 256, 0, 0, P, NIN, 0, 0, 256, 1, SBQ_SCALE, nullptr);
        ck(cb + 1, mw + WS_SBK, 0, 1, 256, 0, 0, P, NIN, 256, 0, 256, 1, 1.f, nullptr);
        ck(cb + 2, mw + WS_SBV, 0, 1, 256, 0, 0, P, NIN, 512, 0, 256, 1, 1.f, nullptr);
        ck(cb + 3, mw + WS_CQ, 0, 0, 256, 0, 0, P, NIN, 768, 0, 256, 1, 1.f, nullptr);
        ck(cb + 4, mw + WS_CKV2, 0, 0, 256, 0, 0, P, NIN, 1024, 0, 128, 1, 1.f, nullptr);
        hipLaunchKernelGGL(dbg::check_u_k, dim3(CG), dim3(256), 0, stream, (const float*)(mw + WS_U), P, acc + 2 * (cb + 5));
        mega(pb + 1);
        hipLaunchKernelGGL(rms_cols_k, dim3(T), dim3(256), 0, stream, P, NIN, 768, 256, q_norm_g + l * 256, CQN);
        hipLaunchKernelGGL(rms_cols_k, dim3(T), dim3(256), 0, stream, P, NIN, 1024, 128, kv_norm_g + l * 128, CKVN);
        run_gemm(stream, CQN, 256, nullptr, w_uq + (size_t)l * 256 * 768, 768, 0, nullptr, 0, QM, 768, T, 768, 256, nullptr, nullptr, 1);
        run_gemm(stream, CKVN, 128, nullptr, w_ukv + (size_t)l * 128 * 1024, 1024, 0, nullptr, 0, KVM, 1024, T, 1024, 128, nullptr, nullptr, 1);
        hipLaunchKernelGGL(rotary_k, dim3(T), dim3(256), 0, stream, QM, P, KROT);
        ck(cb + 6, mw + WS_QM, 0, 1, 768, 0, 0, QM, 768, 0, 0, 768, 1, MLAQ_SCALE, nullptr);
        ck(cb + 7, mw + WS_KM, 0, 1, 768, 0, 96, KVM, 1024, 0, 128, 64, 8, 1.f, nullptr);
        ck(cb + 8, mw + WS_KM, 0, 1, 768, 64, 96, KROT, 32, 0, 0, 32, 8, 1.f, nullptr);
        ck(cb + 9, mw + WS_VM, 0, 1, 512, 0, 64, KVM, 1024, 64, 128, 64, 8, 1.f, nullptr);
        mega(pb + 2);
        hipLaunchKernelGGL(attn_k<0>, dim3((L + 3) / 4, 4, BATCH), dim3(256), 0, stream, P, QM, KVM, KROT, SBO);
        hipLaunchKernelGGL(attn_k<1>, dim3((L + 3) / 4, 8, BATCH), dim3(256), 0, stream, P, QM, KVM, KROT, MLAO);
        ck(cb + 10, mw + WS_OATT, 0, 0, 768, 0, 0, SBO, 256, 0, 0, 256, 1, 1.f, nullptr);
        ck(cb + 11, mw + WS_OATT, 0, 0, 768, 256, 0, MLAO, 512, 0, 0, 512, 1, 1.f, nullptr);
        mega(pb + 3);
        hipLaunchKernelGGL(mix_norm_k, dim3(T), dim3(256), 0, stream, P, SBO, MLAO, conv_w + (size_t)l * CONVK * 256, conv_b + l * 256, conv_ln_g + l * 256, conv_ln_b + l * 256,
                           grp_norm_g + l * D, Y);
        ck(cb + 12, mw + WS_Y, 0, 0, D, 0, 0, Y, D, 0, 0, D, 1, 1.f, grp_norm_g + l * D);
        mega(pb + 4);
        mega(pb + 5);
        run_gemm(stream, Y, D, nullptr, w_out + (size_t)l * D * D, D, 0, nullptr, 0, MIX, D, T, D, D, nullptr, nullptr, 1);
        hipLaunchKernelGGL(res_ln_k, dim3(T), dim3(256), 0, stream, H, MIX, ln_mix_g + l * D, ln_mix_b + l * D, (float*)nullptr);
        ck(cb + 13, mw + WS_HB, 0, 0, D, 0, 0, H, D, 0, 0, D, 1, 1.f, nullptr);
        run_gemm(stream, H, D, nullptr, router_w + (size_t)l * D * NE, NE, 0, router_b + l * NE, 0, LOG, NE, T, NE, D, nullptr, nullptr, 1);
        (void)hipMemsetAsync(cnt, 0, 256, stream);
        hipLaunchKernelGGL(route_k, dim3((T + 255) / 256), dim3(256), 0, stream, LOG, cnt, te, tp, tg);
        hipLaunchKernelGGL(prefix_k, dim3(1), dim3(64), 0, stream, cnt, base);
        hipLaunchKernelGGL(scatter_k, dim3((R + 255) / 256), dim3(256), 0, stream, te, tp, base, list, slot);
        hipLaunchKernelGGL(dbg::check_route_k, dim3(64), dim3(256), 0, stream, (const int*)(mw + WS_TOKE), (const float*)(mw + WS_TOKG), te, tg, acc + 2 * (cb + 14), acc + 2 * (38 + l));
        hipLaunchKernelGGL(dbg::tb_k, dim3(1), dim3(64), 0, stream, (const unsigned*)(mw + WS_CTL) + CW_CNT + l * 64, tbd);
        mega(pb + 6);
        run_gemm(stream, H, D, list, w_gate_up + (size_t)l * NE * D * 2 * FF, 2 * FF, (long)D * 2 * FF, b_gate_up + (size_t)l * NE * 2 * FF, 2 * FF, ACT, FF, T, FF, D, cnt, base, NE, 1);
        hipLaunchKernelGGL(dbg::check_rows_k, dim3(CG), dim3(256), 0, stream, (const bf16*)(mw + WS_ACT), tbd, (const int*)(mw + WS_TOKE), (const int*)(mw + WS_TOKP), ACT, slot, te, acc + 2 * (cb + 15));
        mega(pb + 7);
        run_gemm(stream, ACT, FF, nullptr, w_down + (size_t)l * NE * FF * D, D, (long)FF * D, b_down + (size_t)l * NE * D, D, YS, D, T, D, FF, cnt, base, NE);
        hipLaunchKernelGGL(dbg::check_rows_k, dim3(CG), dim3(256), 0, stream, (const bf16*)(mw + WS_YS), tbd, (const int*)(mw + WS_TOKE), (const int*)(mw + WS_TOKP), YS, slot, te, acc + 2 * (cb + 16));
        mega(pb + 8);
        hipLaunchKernelGGL(combine_k, dim3(T), dim3(256), 0, stream, YS, slot, tg, MIX);
        hipLaunchKernelGGL(res_ln_k, dim3(T), dim3(256), 0, stream, H, MIX, ln_ffn_g + l * D, ln_ffn_b + l * D, (float*)nullptr);
        if (l < DEPTH - 1) ck(cb + 17, mw + WS_HB, 0, 0, D, 0, 0, H, D, 0, 0, D, 1, 1.f, nullptr);
        else hipLaunchKernelGGL(dbg::check_out_k, dim3(CG), dim3(256), 0, stream, (const float*)out, (const float*)H, acc + 2 * (cb + 17));
    }
    hipLaunchKernelGGL(dbg::verdict_k, dim3(1024), dim3(256), 0, stream, acc, 40, MK_TOL, out, (long)BATCH * SEQ * D);
#endif
}
```

```cpp
#include <hip/hip_runtime.h>
#include <cstdio>
#include <cstdint>
#include <cmath>
#define MK_DEBUG 0
#define MK_TOL 1e-3f
#define MK_REP 0
namespace pg8 {
#define PG8_LAS __attribute__((address_space(3)))
typedef unsigned short bf16_t;
typedef short bf16x8 __attribute__((ext_vector_type(8)));
typedef float f32x4 __attribute__((ext_vector_type(4)));
typedef float f32x2 __attribute__((ext_vector_type(2)));
typedef unsigned u32x4 __attribute__((ext_vector_type(4)));
typedef unsigned u32x2 __attribute__((ext_vector_type(2)));
constexpr int BM = 256, BK = 64, HALF = 128, HTB = HALF * BK * 2  , STAGE_BYTES = 8 * HTB, NXCD = 8, WGM = 8;

__host__ __device__ __forceinline__ int lds_byte(int r, int c) { const int st = (r >> 4) * 2 + (c >> 5), rr = r & 15, cc = c & 31, ob = rr * 64 + cc * 2; return st * 1024 + (ob ^ (((ob >> 9) & 1) << 5)); }
__host__ __device__ __forceinline__ void stage_rc(int b, int& R, int& C) { const int st = b / 1024, sb = b % 1024, swz = sb ^ (((sb >> 9) & 1) << 5); R = (st >> 1) * 16 + swz / 64; C = (st & 1) * 32 + (swz % 64) / 2; }
__host__ __device__ __forceinline__ int perm32(int rho) { const int n = rho >> 4, i = rho & 15; return 8 * (i >> 2) + 4 * n + (i & 3); }

struct Unit { int pm, pn, pb, ko, kind; };
struct Gemm { const bf16_t* A; const bf16_t* Bt; int M, N, K; int ld = 0; const bf16_t* A2 = nullptr; const bf16_t* Bt2 = nullptr; };

struct StaticOrder {
    int nM, nN, nwg, G, c;
    __host__ __device__ void init(int M, int N, int G_, int c_) { nM = M / BM; nN = N / BM; nwg = nM * nN; G = G_; c = c_; }
    __host__ __device__ bool next(int i, Unit& u) const {
        const long L = (long)i * G + c; if (L >= nwg) return false;
        int wgid = (int)L; { const int q = nwg / NXCD, r = nwg % NXCD, xcd = wgid % NXCD, off = wgid / NXCD; wgid = (xcd < r ? xcd * (q + 1) : r * (q + 1) + (xcd - r) * q) + off; }
        const int nig = WGM * nN, gid = wgid / nig, fm = gid * WGM, gsz = (nM - fm) < WGM ? (nM - fm) : WGM;
        u.pm = fm + ((wgid % nig) % gsz); u.pn = (wgid % nig) / gsz; u.pb = u.pn; u.ko = 0; u.kind = 0; return true;
    }
    __device__ __forceinline__ const PG8_LAS int* rowlist(int) const { return nullptr; }
    __device__ __forceinline__ void a_ready(const Unit&) const {}
};

struct ListOrder {
    const PG8_LAS int* tab; const PG8_LAS int* rows; int n;
    unsigned* rdy = nullptr; unsigned need = 0;
    __device__ __forceinline__ bool next(int i, Unit& u) const { if (i >= n) return false;
        u.pm = __builtin_amdgcn_readfirstlane(tab[4 * i]); u.pn = __builtin_amdgcn_readfirstlane(tab[4 * i + 1]); u.pb = __builtin_amdgcn_readfirstlane(tab[4 * i + 2]); u.kind = __builtin_amdgcn_readfirstlane(tab[4 * i + 3]); u.ko = 0; return true; }
    __device__ __forceinline__ const PG8_LAS int* rowlist(int ui) const { return rows + ui * 256; }
    __device__ __forceinline__ void a_ready(const Unit& u) const {
        if (u.kind != 1 || rdy == nullptr) return;
        if (threadIdx.x < 64) {
            unsigned sp = 0;
            while ((unsigned)__builtin_amdgcn_readfirstlane(__hip_atomic_load(rdy + 16 * u.pm, __ATOMIC_RELAXED, __HIP_MEMORY_SCOPE_AGENT)) < need) { __builtin_amdgcn_s_sleep(2); if (++sp > (1u << 20)) break; }
            __builtin_amdgcn_fence(__ATOMIC_ACQUIRE, "agent");
            asm volatile("s_waitcnt vmcnt(0)" ::: "memory");
        }
        asm volatile("" ::: "memory"); __builtin_amdgcn_s_barrier(); asm volatile("" ::: "memory");
    }
};
template <class Sched> __device__ __forceinline__ ListOrder make_list(const Sched& S, PG8_LAS int* tab, const PG8_LAS int* rows) {
    if (threadIdx.x == 0) { Unit u; int n = 0;
#pragma unroll 1
        while (n < 24 && S.next(n, u)) { tab[4 * n] = u.pm; tab[4 * n + 1] = u.pn; tab[4 * n + 2] = u.pb; tab[4 * n + 3] = u.kind; ++n; } tab[127] = n; }
    __syncthreads();
    ListOrder Lo; Lo.tab = tab; Lo.rows = rows; Lo.n = __builtin_amdgcn_readfirstlane(tab[127]); return Lo;
}
__device__ __forceinline__ unsigned cvt_pk_bf16(float lo, float hi) { unsigned r; asm volatile("v_cvt_pk_bf16_f32 %0, %1, %2" : "=v"(r) : "v"(lo), "v"(hi)); return r; }

template <class Epi, class Sched, bool ALIGN_EPI, bool GATHER>
__device__ __forceinline__ void gemm_phase(PG8_LAS unsigned char* lds, const Gemm g, const Sched& S, const Epi& E) {
    int tid = threadIdx.x; asm volatile("" : "+v"(tid));
    const int wid = __builtin_amdgcn_readfirstlane(tid >> 6), wr = wid >> 2, wc = wid & 3;
    int K = g.K; asm volatile("" : "+s"(K));
    const int nt = K / BK;
    int LD = g.ld ? g.ld : g.K; asm volatile("" : "+s"(LD));
    unsigned voffA[2], voffB[2];
#pragma unroll
    for (int i = 0; i < 2; ++i) { int R, C; stage_rc(tid * 16 + i * 8192, R, C); const int Rb = Epi::PERM ? ((R & ~31) + perm32(R & 31)) : R;
        voffA[i] = (unsigned)(R * LD + C) * 2u; voffB[i] = (unsigned)(Rb * LD + C) * 2u; }
    unsigned voffG[2][2] = {{0u, 0u}, {0u, 0u}};
#define PG8_LOADG(ui_, u_) do { const PG8_LAS int* rl_ = S.rowlist(ui_); _Pragma("unroll") for (int i_ = 0; i_ < 2; ++i_) { int R_, C_; stage_rc(tid * 16 + i_ * 8192, R_, C_);     \
        _Pragma("unroll") for (int h_ = 0; h_ < 2; ++h_) voffG[h_][i_] = (unsigned)((u_).kind ? (u_).pm * BM + h_ * HALF + R_ : rl_[h_ * HALF + R_]) * (unsigned)(LD * 2) + (unsigned)C_ * 2u; } } while (0)
    const size_t kstep = (size_t)(BK * 2);
    const size_t hstep = (size_t)HALF * LD * 2;
    const size_t tstep = 2 * hstep;
    const unsigned ldsw = (unsigned)wid * 1024u;
    const int aoff = lds_byte(wr * 64 + (tid & 15), ((tid & 63) >> 4) * 8), boff = lds_byte(wc * 32 + (tid & 15), ((tid & 63) >> 4) * 8);
#define PG8_SA(b, h) (((b) * 2 + (h)) * HTB)
#define PG8_SB(b, h) ((4 + (b) * 2 + (h)) * HTB)
#define PG8_STAGE(bufoff, gbase, voff) do { _Pragma("unroll") for (int _i = 0; _i < 2; ++_i) \
        __builtin_amdgcn_global_load_lds((const unsigned*)((const char*)(gbase) + (voff)[_i]), (PG8_LAS unsigned*)(lds + (bufoff) + ldsw + _i * 8192), 16, 0, 0); } while (0)
#define PG8_STAGE_A(bufoff, kptr, h) do { if constexpr (GATHER) { PG8_STAGE(bufoff, kptr, voffG[h]); } else { PG8_STAGE(bufoff, (kptr) + (h) * hstep, voffA); } } while (0)
#define PG8_LDA(dst, b, h) do { _Pragma("unroll") for (int m = 0; m < 4; ++m) _Pragma("unroll") for (int k = 0; k < 2; ++k) dst[m][k] = *(const PG8_LAS bf16x8*)(lds + PG8_SA(b, h) + aoff + m * 2048 + k * 1024); } while (0)
#define PG8_LDB(dst, b, h) do { _Pragma("unroll") for (int n = 0; n < 2; ++n) _Pragma("unroll") for (int k = 0; k < 2; ++k) dst[n][k] = *(const PG8_LAS bf16x8*)(lds + PG8_SB(b, h) + boff + n * 2048 + k * 1024); } while (0)
#define PG8_MMA(ai, bj, At, Bt) do { __builtin_amdgcn_s_setprio(1); _Pragma("unroll") for (int m = 0; m < 4; ++m) _Pragma("unroll") for (int n = 0; n < 2; ++n) _Pragma("unroll") for (int k = 0; k < 2; ++k) \
        acc[ai][bj][m][n] = __builtin_amdgcn_mfma_f32_16x16x32_bf16(Bt[n][k], At[m][k], acc[ai][bj][m][n], 0, 0, 0); __builtin_amdgcn_s_setprio(0); } while (0)
#define PG8_WAIT_V(n) asm volatile("s_waitcnt vmcnt(" #n ")" ::: "memory")
#define PG8_WAIT_L(n) asm volatile("s_waitcnt lgkmcnt(" #n ")" ::: "memory")
#define PG8_BAR __builtin_amdgcn_s_barrier()
#define PG8_SCHED __builtin_amdgcn_sched_barrier(0)
    Unit cur, nxt; int ui = 0;
    if (!S.next(0, cur)) return;
    f32x4 acc[2][2][4][2];
#pragma unroll
    for (int a = 0; a < 2; ++a)
#pragma unroll
        for (int b = 0; b < 2; ++b)
#pragma unroll
            for (int m = 0; m < 4; ++m)
#pragma unroll
                for (int n = 0; n < 2; ++n) acc[a][b][m][n] = (f32x4){0.f, 0.f, 0.f, 0.f};
    bf16x8 At[4][2], B0[2][2], B1[2][2];
#define PG8_BASEA(u_) ((const char*)((u_).kind ? g.A2 : g.A) + (GATHER ? (size_t)0 : (size_t)(u_).pm * tstep) + (size_t)(u_).ko * 2)
#define PG8_BASEB(u_) ((const char*)((u_).kind ? g.Bt2 : g.Bt) + (size_t)(u_).pb * tstep + (size_t)(u_).ko * 2)
    const char* cA = PG8_BASEA(cur); const char* cB = PG8_BASEB(cur);
    S.a_ready(cur);
    if constexpr (GATHER) { PG8_LOADG(0, cur); }
    PG8_STAGE(PG8_SB(0, 0), cB, voffB); PG8_STAGE(PG8_SB(0, 1), cB + hstep, voffB); PG8_STAGE_A(PG8_SA(0, 0), cA, 0); PG8_STAGE_A(PG8_SA(0, 1), cA, 1);
    if (wr == 1) PG8_BAR;
    PG8_WAIT_V(2); PG8_BAR;
    PG8_STAGE(PG8_SB(1, 0), cB + kstep, voffB); PG8_STAGE_A(PG8_SA(1, 0), cA + kstep, 0); PG8_STAGE(PG8_SB(1, 1), cB + hstep + kstep, voffB);
    PG8_WAIT_V(6); PG8_BAR;
    for (;;) {
        const bool has_next = S.next(ui + 1, nxt);
        const char* nA = has_next ? PG8_BASEA(nxt) : cA; const char* nB = has_next ? PG8_BASEB(nxt) : cB;
        for (int t = 0; t < nt; t += 2) {
            const bool last = (t == nt - 2);
            const char* a1 = cA + (size_t)(t + 1) * kstep;
            const char* a2 = last ? nA : cA + (size_t)(t + 2) * kstep; const char* b2 = last ? nB : cB + (size_t)(t + 2) * kstep;
            const char* a3 = a2 + kstep; const char* b3 = b2 + kstep;
            if (last && has_next) S.a_ready(nxt);
            PG8_LDB(B0, 0, 0); PG8_LDB(B1, 0, 1); PG8_SCHED; PG8_LDA(At, 0, 0); PG8_STAGE_A(PG8_SA(1, 1), a1, 1);
            if constexpr (GATHER) { if (last && has_next) { PG8_LOADG(ui + 1, nxt); } }
            PG8_WAIT_V(8); PG8_WAIT_L(0); PG8_BAR; PG8_MMA(0, 0, At, B0); PG8_MMA(0, 1, At, B1); PG8_BAR; PG8_SCHED;
            PG8_LDA(At, 0, 1); PG8_STAGE(PG8_SB(0, 0), b2, voffB); PG8_STAGE(PG8_SB(0, 1), b2 + hstep, voffB); PG8_STAGE_A(PG8_SA(0, 0), a2, 0);
            PG8_WAIT_V(8); PG8_WAIT_L(0); PG8_BAR; PG8_MMA(1, 0, At, B0); PG8_MMA(1, 1, At, B1); PG8_BAR; PG8_SCHED;
            PG8_LDB(B0, 1, 0); PG8_LDB(B1, 1, 1); PG8_SCHED; PG8_LDA(At, 1, 0); PG8_STAGE_A(PG8_SA(0, 1), a2, 1);
            PG8_WAIT_V(8); PG8_WAIT_L(0); PG8_BAR; PG8_MMA(0, 0, At, B0); PG8_MMA(0, 1, At, B1); PG8_BAR; PG8_SCHED;
            PG8_LDA(At, 1, 1); PG8_STAGE(PG8_SB(1, 0), b3, voffB); PG8_STAGE(PG8_SB(1, 1), b3 + hstep, voffB); PG8_STAGE_A(PG8_SA(1, 0), a3, 0);
            PG8_WAIT_V(8); PG8_WAIT_L(0); PG8_BAR; PG8_MMA(1, 0, At, B0); PG8_MMA(1, 1, At, B1); PG8_BAR; PG8_SCHED;
        }
        if constexpr (ALIGN_EPI) { if (wr == 0) PG8_BAR; }
        { int t2 = tid; asm volatile("" : "+v"(t2)); E(acc, cur, wr, wc, t2 & 15, (t2 & 63) >> 4); }
        if (!has_next) break;
#pragma unroll
        for (int a = 0; a < 2; ++a)
#pragma unroll
            for (int b = 0; b < 2; ++b)
#pragma unroll
                for (int m = 0; m < 4; ++m)
#pragma unroll
                    for (int n = 0; n < 2; ++n) acc[a][b][m][n] = (f32x4){0.f, 0.f, 0.f, 0.f};
        cur = nxt; cA = nA; cB = nB; ++ui;
        if constexpr (ALIGN_EPI) { if (wr == 1) PG8_BAR; }
    }
    PG8_WAIT_V(0);
    if constexpr (!ALIGN_EPI) { if (wr == 0) PG8_BAR; }
    PG8_BAR;
#undef PG8_LOADG
#undef PG8_BASEA
#undef PG8_BASEB
#undef PG8_SA
#undef PG8_SB
#undef PG8_STAGE
#undef PG8_STAGE_A
#undef PG8_LDA
#undef PG8_LDB
#undef PG8_MMA
#undef PG8_WAIT_V
#undef PG8_WAIT_L
#undef PG8_BAR
#undef PG8_SCHED
}
}
namespace mk {
constexpr int NWAVES = 8;
constexpr int D = 1024, BATCH = 8, SEQ = 2048, NMETA = 16, L = SEQ + NMETA, T = BATCH * L, TP = 16640;
constexpr int LP = 2112, PADF = 48;
constexpr int DEPTH = 2, NE = 32, TOPK = 4, FF = 1024, CONVK = 31, NIN = 1696, NINP = 1792;
constexpr int RP = 74240;
constexpr float ALPHA = 1.4142135623730951f, LN_EPS = 1e-5f, RMS_EPS = 1e-6f;
constexpr float LOG2E = 1.4426950408889634f;
constexpr float SBQ_SCALE = 0.125f * LOG2E;
constexpr float MLAQ_SCALE = 0.10206207261596575f * LOG2E;

constexpr size_t MiB = 1u << 20;
constexpr size_t WS_CTL = 0, CTL_ZERO_BYTES = 1 * MiB;
constexpr size_t WS_WIN = 2 * MiB, WS_WUQ = 9 * MiB, WS_WUKV = 10 * MiB, WS_WOUT = 11 * MiB, WS_BGU = 15 * MiB, WS_ROPE = 16 * MiB, WS_STQ = 17 * MiB, WS_STKV = 17 * MiB + 512 * 1024;
constexpr size_t WS_TOKE = 18 * MiB, WS_TOKP = 18 * MiB + 512 * 1024, WS_TOKG = 19 * MiB, WS_LIST = 20 * MiB, WS_RWT = 24 * MiB, WS_ZP = 26 * MiB;
constexpr size_t WS_WGU = 32 * MiB, WS_WD = 288 * MiB, WS_HL = 416 * MiB  , WS_HB = 481 * MiB, WS_Z = 514 * MiB;
constexpr size_t WS_SBQ = 579 * MiB, WS_SBK = 588 * MiB, WS_SBV = 597 * MiB, WS_CQ = 606 * MiB, WS_CKV = 615 * MiB, WS_U = 620 * MiB;
constexpr size_t WS_QM = 637 * MiB, WS_KM = 662 * MiB, WS_VM = 687 * MiB, WS_OATT = 704 * MiB, WS_Y = 753 * MiB, WS_ACT = 786 * MiB, WS_YS = 931 * MiB, WS_MEGA_END = 1076 * MiB;
constexpr size_t WS_CKV2 = 1077 * MiB  , WS_WUKV2 = 1086 * MiB  ;
static_assert(WS_WIN + (size_t)DEPTH * NINP * D * 2 <= WS_WUQ && WS_WOUT + (size_t)DEPTH * D * D * 2 <= WS_BGU && WS_BGU + (size_t)DEPTH * NE * 2 * FF * 4 <= WS_ROPE, "ws map 1");
static_assert(WS_ROPE + (size_t)L * 16 * 8 <= WS_STQ && WS_STQ + (size_t)TP * 16 <= WS_STKV && WS_STKV + (size_t)TP * 16 <= WS_TOKE && WS_TOKE + (size_t)T * 16 <= WS_TOKP && WS_LIST + (size_t)NE * T * 4 <= WS_WGU, "ws map 2");
static_assert(WS_WGU + (size_t)DEPTH * NE * 2 * FF * D * 2 <= WS_WD && WS_WD + (size_t)DEPTH * NE * FF * D * 2 <= WS_HL && WS_HL + (size_t)TP * D * 2 <= WS_HB && WS_HB + (size_t)TP * D * 2 <= WS_Z && WS_Z + (size_t)T * D * 4 <= WS_SBQ, "ws map 3");
static_assert(WS_SBQ + (size_t)BATCH * LP * 256 * 2 <= WS_SBK && WS_SBV + (size_t)BATCH * LP * 256 * 2 <= WS_CQ && WS_CQ + (size_t)TP * 256 * 2 <= WS_CKV && WS_CKV + (size_t)TP * 128 * 2 <= WS_U && WS_U + (size_t)T * 256 * 4 <= WS_QM, "ws map 4");
static_assert(WS_QM + (size_t)BATCH * LP * 768 * 2 <= WS_KM && WS_KM + (size_t)BATCH * LP * 768 * 2 <= WS_VM && WS_VM + (size_t)BATCH * LP * 512 * 2 <= WS_OATT && WS_OATT + (size_t)T * 768 * 4 <= WS_Y && WS_Y + (size_t)TP * D * 2 <= WS_ACT, "ws map 5");
static_assert(WS_ACT + (size_t)RP * FF * 2 <= WS_YS && WS_YS + (size_t)RP * D * 2 <= WS_MEGA_END, "ws map 6");
constexpr int CW_CNT = 1024;
constexpr int CW_CONV = 1536;
constexpr int CW_TAIL = 1600;
constexpr int CW_AQ = 2048;
constexpr int CW_BAR = 4096;
constexpr int CW_RDY = 8192;

constexpr int RING_OFF = 0, RING_BYTES = 131072;
constexpr int LDSCTL_OFF = RING_BYTES, MISC_OFF = LDSCTL_OFF + 320;
constexpr int TAIL_OFF = RING_BYTES + 1024;
constexpr int LDS_BYTES = 147456;

#define GAS __attribute__((address_space(1)))
#define LAS __attribute__((address_space(3)))
typedef unsigned short bf16;
typedef unsigned v4u __attribute__((ext_vector_type(4)));
typedef unsigned v2u __attribute__((ext_vector_type(2)));
typedef float f32x4 __attribute__((ext_vector_type(4)));
typedef float f32x2 __attribute__((ext_vector_type(2)));
typedef short bf16x8 __attribute__((ext_vector_type(8)));
typedef GAS unsigned gu32;
#define RLX_AGENT __ATOMIC_RELAXED, __HIP_MEMORY_SCOPE_AGENT
#define LDS_WAIT() asm volatile("s_waitcnt lgkmcnt(0)" ::: "memory")
#define VM_WAIT() asm volatile("s_waitcnt vmcnt(0)" ::: "memory")
__device__ __forceinline__ unsigned f2bf(float f) { unsigned u = __builtin_bit_cast(unsigned, f); return (u + 0x7fffu + ((u >> 16) & 1u)) >> 16; }
__device__ __forceinline__ unsigned pk2(float lo, float hi) { return f2bf(lo) | (f2bf(hi) << 16); }
__device__ __forceinline__ unsigned cvtpk_rne(float lo, float hi) { typedef float f2_ __attribute__((ext_vector_type(2))); typedef __bf16 b2_ __attribute__((ext_vector_type(2))); f2_ v = {lo, hi}; b2_ b = __builtin_convertvector(v, b2_); return __builtin_bit_cast(unsigned, b); }
__device__ __forceinline__ float bf2f(unsigned short b) { return __builtin_bit_cast(float, (unsigned)b << 16); }
__device__ __forceinline__ float bflo(unsigned w) { return __builtin_bit_cast(float, w << 16); }
__device__ __forceinline__ float bfhi(unsigned w) { return __builtin_bit_cast(float, w & 0xffff0000u); }

#define XB_TMO      128
#define XB_XCNT(j)  (256  + 64 * (j))
#define XB_XSUB(j)  (1280 + 64 * (j))
#define XB_XGEN(j)  (2304 + 64 * (j))
#define XB_TOP      3328
#define XB_TOPGEN   3392
#define XCD_BAR_WORDS 3456
#define XB_SPIN_CAP (1u << 18)

__device__ __forceinline__ unsigned xb_ld(unsigned* p)              { return __hip_atomic_load(p, __ATOMIC_RELAXED, __HIP_MEMORY_SCOPE_AGENT); }
__device__ __forceinline__ unsigned xb_add(unsigned* p, unsigned v) { return __hip_atomic_fetch_add(p, v, __ATOMIC_RELAXED, __HIP_MEMORY_SCOPE_AGENT); }
__device__ __forceinline__ unsigned xb_xcc_id() { return (unsigned)__builtin_amdgcn_s_getreg((3 << 11) | 20) & 0xFu; }
#define XB_SPIN(cond, bar) do { unsigned _sp = 0; while (cond) { __builtin_amdgcn_s_sleep(1); \
    if ((++_sp & 255u) == 0u) { if (xb_ld(&(bar)[XB_TMO])) break; if (_sp > XB_SPIN_CAP) { atomicAdd(&(bar)[XB_TMO], 1u); break; } } } } while (0)

struct XcdBarrier {
    unsigned* bar; unsigned x;
    volatile LAS unsigned* st;
};
__device__ __forceinline__ XcdBarrier xcd_barrier_post(unsigned* bar, volatile LAS unsigned* st) {
    XcdBarrier b; b.bar = bar; b.x = xb_xcc_id(); b.st = st;
    if (threadIdx.x == 0) (void)xb_add(&bar[XB_XCNT(b.x)], 1u);
    return b;
}
__device__ __forceinline__ void xcd_barrier_complete(unsigned* bar, unsigned x, unsigned& nloc, unsigned& nx) {
    const unsigned G = gridDim.x * gridDim.y * gridDim.z;
    unsigned sum, cnt, mine, sp = 0u;
    for (;;) {
        sum = 0u; cnt = 0u; mine = 0u;
#pragma unroll 1
        for (unsigned j = 0; j < 16; ++j) { const unsigned c = xb_ld(&bar[XB_XCNT(j)]); sum += c; cnt += (c > 0u) ? 1u : 0u; mine = (j == x) ? c : mine; }
        if (sum == G) break;
        __builtin_amdgcn_s_sleep(1);
        if ((++sp & 255u) == 0u) { if (xb_ld(&bar[XB_TMO])) break; if (sp > XB_SPIN_CAP) { atomicAdd(&bar[XB_TMO], 1u); break; } }
    }
    nloc = mine > 0u ? mine : 1u; nx = cnt > 0u ? cnt : 1u;
}
__device__ __forceinline__ void xcd_barrier(const XcdBarrier& b) {
    asm volatile("s_waitcnt vmcnt(0)" ::: "memory");
    __syncthreads();
    if (threadIdx.x == 0) {
        unsigned* bar = b.bar;
        __builtin_amdgcn_s_waitcnt(0);
        unsigned nloc = b.st[0], nx = b.st[1];
        if (nloc == 0u) { xcd_barrier_complete(bar, b.x, nloc, nx); b.st[0] = nloc; b.st[1] = nx; }
        const unsigned old = xb_add(&bar[XB_XSUB(b.x)], 1u);
        const unsigned gen = old / nloc;
        if (old + 1u == (gen + 1u) * nloc) {
            __builtin_amdgcn_fence(__ATOMIC_RELEASE, "agent");
            asm volatile("s_waitcnt vmcnt(0)" ::: "memory");
            const unsigned og = xb_add(&bar[XB_TOP], 1u);
            const unsigned tg = og / nx;
            if (og + 1u == (tg + 1u) * nx) xb_add(&bar[XB_TOPGEN], 1u);
            else XB_SPIN(xb_ld(&bar[XB_TOPGEN]) == tg, bar);
            __builtin_amdgcn_fence(__ATOMIC_ACQUIRE, "agent");
            xb_add(&bar[XB_XGEN(b.x)], 1u);
            asm volatile("s_waitcnt vmcnt(0)" ::: "memory");
        } else {
            XB_SPIN(xb_ld(&bar[XB_XGEN(b.x)]) == gen, bar);
            __builtin_amdgcn_fence(__ATOMIC_ACQUIRE, "agent");
            asm volatile("s_waitcnt vmcnt(0)" ::: "memory");
        }
    }
    __syncthreads();
}

__device__ __forceinline__ float wave_sum(float v) {
#pragma unroll
    for (int o = 1; o < 64; o <<= 1) v += __shfl_xor(v, o);
    return v;
}

struct Frame {
    LAS unsigned char* lds;
    volatile LAS unsigned* MISC;
    gu32* ctl;
    unsigned char* ws;
    int tid, lane, wave;
    int vcu, G;
    const float* in[25];
    float* out;
};
}
#if MK_DEBUG
namespace nv {
using namespace mk;
constexpr int R = T * TOPK;

struct GemmP {
    const float* A; const int* arow;
    const float* B; const float* bias; float* C;
    const int* cnt; const int* base;
    long strideB, strideBias;
    int lda, ldb, ldc, M, N, K;
    int swiglu, pad;
};
__global__ void __launch_bounds__(256) sgemm_k(GemmP p) {
    const int e = blockIdx.z;
    const int M = p.cnt ? p.cnt[e] : p.M;
    const int rbase = p.cnt ? p.base[e] : 0;
    const int m0 = blockIdx.y * 64, n0 = blockIdx.x * 64;
    if (m0 >= M) return;
    const float* B = p.B + (size_t)e * p.strideB;
    const float* bias = p.bias ? p.bias + (size_t)e * p.strideBias : nullptr;
    __shared__ float As[16][68], Bs[16][68], Bs2[16][68];
    const int tid = threadIdx.x, tx = tid & 15, ty = tid >> 4;
    const int ar = tid >> 2, ak = (tid & 3) * 4;
    const int bk = tid >> 4, bn = (tid & 15) * 4;
    long arow_idx = -1;
    if (m0 + ar < M) arow_idx = p.arow ? (long)p.arow[rbase + m0 + ar] : (long)(rbase + m0 + ar);
    const bool bvalid = (n0 + bn) < p.N;
    float acc[4][4] = {}, acc2[4][4] = {};
    for (int k0 = 0; k0 < p.K; k0 += 16) {
        float4 av = make_float4(0.f, 0.f, 0.f, 0.f), bv = make_float4(0.f, 0.f, 0.f, 0.f);
        if (arow_idx >= 0) av = *(const float4*)(p.A + (size_t)arow_idx * p.lda + k0 + ak);
        if (bvalid) bv = *(const float4*)(B + (size_t)(k0 + bk) * p.ldb + n0 + bn);
        As[ak + 0][ar] = av.x; As[ak + 1][ar] = av.y; As[ak + 2][ar] = av.z; As[ak + 3][ar] = av.w;
        *(float4*)&Bs[bk][bn] = bv;
        if (p.swiglu) { float4 bv2 = make_float4(0.f, 0.f, 0.f, 0.f); if (bvalid) bv2 = *(const float4*)(B + (size_t)(k0 + bk) * p.ldb + p.N + n0 + bn); *(float4*)&Bs2[bk][bn] = bv2; }
        __syncthreads();
#pragma unroll
        for (int k = 0; k < 16; ++k) {
            const float4 a4 = *(const float4*)&As[k][ty * 4];
            const float4 b4 = *(const float4*)&Bs[k][tx * 4];
            const float a[4] = {a4.x, a4.y, a4.z, a4.w}, b[4] = {b4.x, b4.y, b4.z, b4.w};
#pragma unroll
            for (int i = 0; i < 4; ++i)
#pragma unroll
                for (int j = 0; j < 4; ++j) acc[i][j] = fmaf(a[i], b[j], acc[i][j]);
            if (p.swiglu) { const float4 c4 = *(const float4*)&Bs2[k][tx * 4]; const float c[4] = {c4.x, c4.y, c4.z, c4.w};
#pragma unroll
                for (int i = 0; i < 4; ++i)
#pragma unroll
                    for (int j = 0; j < 4; ++j) acc2[i][j] = fmaf(a[i], c[j], acc2[i][j]); }
        }
        __syncthreads();
    }
#pragma unroll
    for (int i = 0; i < 4; ++i) {
        const int m = m0 + ty * 4 + i;
        if (m >= M) continue;
#pragma unroll
        for (int j = 0; j < 4; ++j) {
            const int n = n0 + tx * 4 + j;
            if (n < p.N) { float v = acc[i][j] + (bias ? bias[n] : 0.f);
                if (p.swiglu) { float g = fminf(v, 7.f), up = acc2[i][j] + (bias ? bias[p.N + n] : 0.f); up = fminf(fmaxf(up, -7.f), 7.f); v = (up + 1.f) * (g / (1.f + expf(-1.702f * g))); }
                p.C[(size_t)(rbase + m) * p.ldc + n] = v; }
        }
    }
}

__device__ __forceinline__ float block_sum256(float v, float* red) {
#pragma unroll
    for (int o = 32; o > 0; o >>= 1) v += __shfl_xor(v, o);
    __syncthreads();
    if ((threadIdx.x & 63) == 0) red[threadIdx.x >> 6] = v;
    __syncthreads();
    return red[0] + red[1] + red[2] + red[3];
}
__global__ void __launch_bounds__(256) ln_in_k(const float* x, const float* meta, const float* g, const float* b, float* H) {
    __shared__ float red[4];
    const int r = blockIdx.x, bb = r / L, p = r % L;
    const float* src = p < NMETA ? meta + (size_t)p * D : x + ((size_t)bb * SEQ + (p - NMETA)) * D;
    float v[4]; float s = 0.f;
#pragma unroll
    for (int i = 0; i < 4; ++i) { v[i] = src[threadIdx.x + 256 * i]; s += v[i]; }
    const float mu = block_sum256(s, red) * (1.f / D);
    float q = 0.f;
#pragma unroll
    for (int i = 0; i < 4; ++i) { v[i] -= mu; q += v[i] * v[i]; }
    const float rstd = 1.0f / sqrtf(block_sum256(q, red) * (1.f / D) + 1e-5f);
#pragma unroll
    for (int i = 0; i < 4; ++i) { const int c = threadIdx.x + 256 * i; H[(size_t)r * D + c] = v[i] * rstd * g[c] + b[c]; }
}
__global__ void __launch_bounds__(256) res_ln_k(float* H, const float* add, const float* g, const float* b, float* out) {
    __shared__ float red[4];
    const int r = blockIdx.x;
    float v[4]; float s = 0.f;
#pragma unroll
    for (int i = 0; i < 4; ++i) { const int c = threadIdx.x + 256 * i; v[i] = ALPHA * H[(size_t)r * D + c] + add[(size_t)r * D + c]; s += v[i]; }
    const float mu = block_sum256(s, red) * (1.f / D);
    float q = 0.f;
#pragma unroll
    for (int i = 0; i < 4; ++i) { v[i] -= mu; q += v[i] * v[i]; }
    const float rstd = 1.0f / sqrtf(block_sum256(q, red) * (1.f / D) + 1e-5f);
    const int bb = r / L, p = r % L;
#pragma unroll
    for (int i = 0; i < 4; ++i) {
        const int c = threadIdx.x + 256 * i; const float o = v[i] * rstd * g[c] + b[c];
        H[(size_t)r * D + c] = o;
        if (out && p >= NMETA) out[((size_t)bb * SEQ + (p - NMETA)) * D + c] = o;
    }
}
__global__ void __launch_bounds__(256) rms_cols_k(const float* P, int ldp, int col0, int W, const float* g, float* O) {
    __shared__ float red[4];
    const int r = blockIdx.x, c = threadIdx.x;
    const float v = c < W ? P[(size_t)r * ldp + col0 + c] : 0.f;
    const float ss = block_sum256(v * v, red);
    const float rstd = 1.0f / sqrtf(ss / (float)W + 1e-6f);
    if (c < W) O[(size_t)r * W + c] = v * rstd * g[c];
}
__global__ void __launch_bounds__(256) rotary_k(float* QM, const float* P, float* KROT) {
    const int r = blockIdx.x, p = r % L, t = threadIdx.x;
    if (t < 128 + 16) {
        const int i = t & 15;
        const float inv = 1.0f / powf(10000.0f, (float)(2 * i) / 32.0f);
        const float ang = (float)p * inv;
        const float c = cosf(ang), s = sinf(ang);
        if (t < 128) {
            const int h = t >> 4; float* q = QM + (size_t)r * 768 + h * 96 + 64;
            const float x1 = q[i], x2 = q[i + 16];
            q[i] = x1 * c - x2 * s; q[i + 16] = x1 * s + x2 * c;
        } else {
            const float* k = P + (size_t)r * NIN + 1152;
            const float x1 = k[i], x2 = k[i + 16];
            KROT[(size_t)r * 32 + i] = x1 * c - x2 * s; KROT[(size_t)r * 32 + i + 16] = x1 * s + x2 * c;
        }
    }
}

template <int MODE>
__global__ void __launch_bounds__(256) attn_k(const float* P, const float* QM, const float* KVM, const float* KROT, float* O) {
    __shared__ float sc[4][L + 16];
    __shared__ float qs[4][96];
    const int w = threadIdx.x >> 6, lane = threadIdx.x & 63;
    const int t = blockIdx.x * 4 + w, h = blockIdx.y, b = blockIdx.z;
    if (t >= L) return;
    const size_t row = (size_t)b * L + t;
    const int n = MODE == 0 ? t : t + 1;
    float* s = sc[w]; float* q = qs[w];
    if (MODE == 0) { q[lane] = P[row * NIN + h * 64 + lane]; }
    else { q[lane] = QM[row * 768 + h * 96 + lane]; if (lane < 32) q[64 + lane] = QM[row * 768 + h * 96 + 64 + lane]; }
    __syncthreads();
    const float scale = MODE == 0 ? 0.125f : 0.10206207261596575f;
    for (int j = lane; j < n; j += 64) {
        const size_t kr = (size_t)b * L + j; float a = 0.f;
        if (MODE == 0) { const float4* k = (const float4*)(P + kr * NIN + 256 + h * 64);
            for (int d = 0; d < 16; ++d) { const float4 kv = k[d]; a = fmaf(q[4 * d], kv.x, a); a = fmaf(q[4 * d + 1], kv.y, a); a = fmaf(q[4 * d + 2], kv.z, a); a = fmaf(q[4 * d + 3], kv.w, a); } }
        else { const float4* k = (const float4*)(KVM + kr * 1024 + h * 128);
            for (int d = 0; d < 16; ++d) { const float4 kv = k[d]; a = fmaf(q[4 * d], kv.x, a); a = fmaf(q[4 * d + 1], kv.y, a); a = fmaf(q[4 * d + 2], kv.z, a); a = fmaf(q[4 * d + 3], kv.w, a); }
            const float4* kp = (const float4*)(KROT + kr * 32);
            for (int d = 0; d < 8; ++d) { const float4 kv = kp[d]; a = fmaf(q[64 + 4 * d], kv.x, a); a = fmaf(q[64 + 4 * d + 1], kv.y, a); a = fmaf(q[64 + 4 * d + 2], kv.z, a); a = fmaf(q[64 + 4 * d + 3], kv.w, a); } }
        s[j] = a * scale;
    }
    __syncthreads();
    if (MODE == 1) {
        float m = -INFINITY; for (int j = lane; j < n; j += 64) m = fmaxf(m, s[j]);
#pragma unroll
        for (int o = 32; o > 0; o >>= 1) m = fmaxf(m, __shfl_xor(m, o));
        float sum = 0.f; for (int j = lane; j < n; j += 64) { const float e = expf(s[j] - m); s[j] = e; sum += e; }
#pragma unroll
        for (int o = 32; o > 0; o >>= 1) sum += __shfl_xor(sum, o);
        const float inv = 1.0f / sum;
        for (int j = lane; j < n; j += 64) s[j] *= inv;
    } else {
        const int C = (n + 63) / 64, j0 = lane * C, j1 = min(n, j0 + C);
        float cs = 0.f;
        for (int j = j0; j < j1; ++j) { const float z = s[j]; const float a = -(fmaxf(z, 0.f) + log1pf(expf(-fabsf(z)))); cs += a; }
        float incl = cs;
#pragma unroll
        for (int o = 1; o < 64; o <<= 1) { const float v = __shfl_down(incl, o); if (lane + o < 64) incl += v; }
        float run = incl - cs;
        for (int j = j1 - 1; j >= j0; --j) { const float z = s[j]; const float a = -(fmaxf(z, 0.f) + log1pf(expf(-fabsf(z)))); run += a; s[j] = expf(z + run); }
    }
    __syncthreads();
    float o = 0.f;
    if (MODE == 0) { const float* v = P + (size_t)b * L * NIN + 512 + h * 64 + lane; for (int j = 0; j < n; ++j) o = fmaf(s[j], v[(size_t)j * NIN], o); O[row * 256 + h * 64 + lane] = o; }
    else { const float* v = KVM + (size_t)b * L * 1024 + h * 128 + 64 + lane; for (int j = 0; j < n; ++j) o = fmaf(s[j], v[(size_t)j * 1024], o); O[row * 512 + h * 64 + lane] = o; }
}

__global__ void __launch_bounds__(256) mix_norm_k(const float* P, const float* SBO, const float* MLAO, const float* cw, const float* cb, const float* clg, const float* clb,
                                                  const float* gg, float* Y) {
    __shared__ float red[4];
    const int r = blockIdx.x, p = r % L, c = threadIdx.x;
    float acc = cb[c];
    for (int k = 0; k < CONVK; ++k) {
        const int pp = p - (CONVK - 1) + k;
        if (pp >= 0) { const float* pr = P + (size_t)(r - (CONVK - 1) + k) * NIN; const float a = pr[1184 + c], g = pr[1440 + c]; acc = fmaf(a / (1.f + expf(-g)), cw[k * 256 + c], acc); }
    }
    const float mu = block_sum256(acc, red) * (1.f / 256.f);
    const float dv = acc - mu;
    const float var = block_sum256(dv * dv, red) * (1.f / 256.f);
    float y = dv * (1.0f / sqrtf(var + 1e-5f)) * clg[c] + clb[c];
    y = y / (1.f + expf(-y));
    const float ssc = block_sum256(y * y, red);
    Y[(size_t)r * D + 768 + c] = y * (1.0f / sqrtf(ssc / 256.f + 1e-6f)) * gg[768 + c];
    const float sb = SBO[(size_t)r * 256 + c];
    const float sss = block_sum256(sb * sb, red);
    Y[(size_t)r * D + c] = sb * (1.0f / sqrtf(sss / 256.f + 1e-6f)) * gg[c];
    const float m0 = MLAO[(size_t)r * 512 + c], m1 = MLAO[(size_t)r * 512 + 256 + c];
    const float ssm = block_sum256(m0 * m0 + m1 * m1, red);
    const float rm = 1.0f / sqrtf(ssm / 512.f + 1e-6f);
    Y[(size_t)r * D + 256 + c] = m0 * rm * gg[256 + c];
    Y[(size_t)r * D + 512 + c] = m1 * rm * gg[512 + c];
}

__global__ void route_k(const float* LOG, int* cnt, int* te, int* tp, float* tg) {
    const int t = blockIdx.x * blockDim.x + threadIdx.x;
    if (t >= T) return;
    float v[NE];
#pragma unroll
    for (int e = 0; e < NE; ++e) v[e] = LOG[(size_t)t * NE + e];
    float tv[TOPK]; int ti[TOPK];
#pragma unroll
    for (int k = 0; k < TOPK; ++k) {
        float bv = -INFINITY; int bi = 0;
#pragma unroll
        for (int e = 0; e < NE; ++e) if (v[e] > bv) { bv = v[e]; bi = e; }
        tv[k] = bv; ti[k] = bi;
#pragma unroll
        for (int e = 0; e < NE; ++e) if (e == bi) v[e] = -INFINITY;
    }
    float sum = 0.f, ex[TOPK];
#pragma unroll
    for (int k = 0; k < TOPK; ++k) { ex[k] = expf(tv[k] - tv[0]); sum += ex[k]; }
#pragma unroll
    for (int k = 0; k < TOPK; ++k) { te[t * TOPK + k] = ti[k]; tg[t * TOPK + k] = ex[k] / sum; tp[t * TOPK + k] = atomicAdd(&cnt[ti[k]], 1); }
}
__global__ void prefix_k(const int* cnt, int* base) { if (threadIdx.x == 0) { int s = 0; for (int e = 0; e < NE; ++e) { base[e] = s; s += cnt[e]; } } }
__global__ void scatter_k(const int* te, const int* tp, const int* base, int* list, int* slot) {
    const int i = blockIdx.x * blockDim.x + threadIdx.x;
    if (i >= R) return;
    const int s = base[te[i]] + tp[i]; list[s] = i / TOPK; slot[i] = s;
}
__global__ void swiglu_k(const float* GU, float* ACT) {
    const size_t i = (size_t)blockIdx.x * blockDim.x + threadIdx.x;
    if (i >= (size_t)R * FF) return;
    const size_t r = i / FF; const int c = (int)(i % FF);
    float g = GU[r * 2 * FF + c], up = GU[r * 2 * FF + FF + c];
    g = fminf(g, 7.f); up = fminf(fmaxf(up, -7.f), 7.f);
    ACT[i] = (up + 1.f) * (g / (1.f + expf(-1.702f * g)));
}
__global__ void __launch_bounds__(256) combine_k(const float* YS, const int* slot, const float* tg, float* FFN) {
    const int t = blockIdx.x;
#pragma unroll
    for (int i = 0; i < 4; ++i) {
        const int c = threadIdx.x + 256 * i; float a = 0.f;
#pragma unroll
        for (int k = 0; k < TOPK; ++k) a += YS[(size_t)slot[t * TOPK + k] * D + c] * tg[t * TOPK + k];
        FFN[(size_t)t * D + c] = a;
    }
}
}
#endif
namespace mk {
struct MapId { __device__ __forceinline__ int operator()(int n) const { return n; } };
struct MapIn {
    __device__ __forceinline__ int operator()(int n) const {
        if (n < 1184) return n;
        if (n < 1280) return -1;
        const int t = n - 1280, tile = t >> 8, j = t & 255, ch = tile * 128 + (j & 127);
        return (j < 128 ? 1184 : 1440) + ch;
    }
};
struct MapGU {
    __device__ __forceinline__ int operator()(int n) const { const int pn = n >> 8, j = n & 255; return (j < 128 ? 0 : FF) + pn * 128 + (j & 127); }
};
template <class Map>
__device__ __forceinline__ void p0_transpose_item(const float* W, int K, int N, int nblk, bf16* WT, const float* gain, LAS float* scr, int item, int lane, Map map, int ldt = 0) {
    if (ldt == 0) ldt = K;
    const int kb = item / nblk, nb = item % nblk, k0 = 64 * kb, n0 = 32 * nb;
    const int src = map(n0 + (lane & 31));
#pragma unroll 8
    for (int i = 0; i < 32; ++i) { const int kk = 2 * i + (lane >> 5); float v = 0.f; if (src >= 0) v = W[(size_t)(k0 + kk) * N + src]; if (gain) v *= gain[k0 + kk]; scr[kk * 33 + (lane & 31)] = v; }
    LDS_WAIT(); asm volatile("" ::: "memory");
    const int c = lane & 7;
#pragma unroll
    for (int j = 0; j < 4; ++j) { const int n = (lane >> 3) + 8 * j; const LAS float* s = scr + (8 * c) * 33 + n;
        v4u o; o.x = pk2(s[0 * 33], s[1 * 33]); o.y = pk2(s[2 * 33], s[3 * 33]); o.z = pk2(s[4 * 33], s[5 * 33]); o.w = pk2(s[6 * 33], s[7 * 33]);
        *(GAS v4u*)(WT + (size_t)(n0 + n) * ldt + k0 + 8 * c) = o; }
    LDS_WAIT(); asm volatile("" ::: "memory");
}
template <class Map>
__device__ __forceinline__ void p0_tr64_load(const float* W, int N, int nblk, int item, int lane, Map map, f32x4 (&v)[8]) {
    const int kb = item / nblk, nb = item - kb * nblk; const float* src = W + (size_t)(32 * kb + (lane >> 4)) * N + map(64 * nb) + (lane & 15) * 4;
#pragma unroll
    for (int i = 0; i < 8; ++i) v[i] = __builtin_nontemporal_load((const f32x4*)(src + (size_t)(4 * i) * N));
}
__device__ __forceinline__ void p0_tr64_store(const f32x4 (&v)[8], int K, int nblk, int item, bf16* WT, LAS float* scr, int lane) {
    const int kb = item / nblk, nb = item - kb * nblk, k0 = 32 * kb, n0 = 64 * nb;
#pragma unroll
    for (int i = 0; i < 8; ++i) { LAS float* d = scr + (4 * i + (lane >> 4)) * 65 + (lane & 15) * 4; d[0] = v[i].x; d[1] = v[i].y; d[2] = v[i].z; d[3] = v[i].w; }
    LDS_WAIT(); asm volatile("" ::: "memory");
    const int c = lane & 3;
#pragma unroll
    for (int j = 0; j < 4; ++j) { const int n = (lane >> 2) + 16 * j; const LAS float* s = scr + (8 * c) * 65 + n;
        v4u o; o.x = cvtpk_rne(s[0 * 65], s[1 * 65]); o.y = cvtpk_rne(s[2 * 65], s[3 * 65]); o.z = cvtpk_rne(s[4 * 65], s[5 * 65]); o.w = cvtpk_rne(s[6 * 65], s[7 * 65]);
        *(GAS v4u*)(WT + (size_t)(n0 + n) * K + k0 + 8 * c) = o; }
    LDS_WAIT(); asm volatile("" ::: "memory");
}
struct Args { const float* in[25]; float* out; unsigned char* ws; int ph_lo, ph_hi; };
typedef const Args __attribute__((address_space(4)))* KArgs;
__device__ __forceinline__ KArgs kargs() { KArgs p = (KArgs)__builtin_amdgcn_kernarg_segment_ptr(); asm volatile("" : "+s"(p)); return p; }
enum { I_X = 0, I_META, I_LNIN_G, I_LNIN_B, I_WIN, I_QNG, I_WUQ, I_KVNG, I_WUKV, I_CONVW, I_CONVB, I_CLNG, I_CLNB, I_GRPG, I_WOUT, I_LNMIX_G, I_LNMIX_B, I_RW, I_RB, I_WGU, I_BGU, I_WD, I_BD, I_LNFFN_G, I_LNFFN_B };

__device__ __forceinline__ void ln_row16(f32x4 (&v)[4], const float* g, const float* b, int lane) {
    float s = 0.f;
#pragma unroll
    for (int j = 0; j < 4; ++j) s += (v[j].x + v[j].y) + (v[j].z + v[j].w);
    const float mean = wave_sum(s) * (1.f / D); float s2 = 0.f;
#pragma unroll
    for (int j = 0; j < 4; ++j) { v[j] = v[j] - mean; s2 += (v[j].x * v[j].x + v[j].y * v[j].y) + (v[j].z * v[j].z + v[j].w * v[j].w); }
    const float rstd = __builtin_amdgcn_rsqf(wave_sum(s2) * (1.f / D) + LN_EPS);
#pragma unroll
    for (int j = 0; j < 4; ++j) { const f32x4 gg = *(const f32x4*)(g + 4 * lane + 256 * j), bb = *(const f32x4*)(b + 4 * lane + 256 * j); v[j] = v[j] * rstd * gg + bb; }
}
__device__ __forceinline__ void store_row16(const f32x4 (&v)[4], float* hf, bf16* hb, int lane) {
#pragma unroll
    for (int j = 0; j < 4; ++j) {
        if (hf) *(f32x4*)(hf + 4 * lane + 256 * j) = v[j];
        if (hb) *(v2u*)(hb + 4 * lane + 256 * j) = (v2u){pk2(v[j].x, v[j].y), pk2(v[j].z, v[j].w)};
    }
}

__device__ __forceinline__ void p0_prologue(Frame& F, KArgs A) {
    LAS float* scr = (LAS float*)(F.lds + RING_OFF + F.wave * 16384);
    const int gw = F.vcu * NWAVES + F.wave, NGW = F.G * NWAVES, lane = F.lane;
    unsigned char* ws = F.ws;
    constexpr int I_IN = 16 * (NINP / 32), I_UQ = 4 * 24, I_UKV = 2 * 32, I_OUT = 16 * 32, I_GU = 32 * 32, I_DN = 32 * 16;
    constexpr int S0 = DEPTH * I_IN, S1 = S0 + DEPTH * I_UQ, S2 = S1 + DEPTH * I_UKV, S3 = S2 + DEPTH * I_OUT;
    for (int it = gw; it < S3; it += NGW) {
        if (it >= S2) { const int r = it - S2, l = r / I_OUT, i = r % I_OUT;
            p0_transpose_item(A->in[I_WOUT] + (size_t)l * D * D, D, D, D / 32, (bf16*)(ws + WS_WOUT) + (size_t)l * D * D, A->in[I_GRPG] + l * D, scr, i, lane, MapId()); }
        else if (it >= S1) { const int r = it - S1, l = r / I_UKV, i = r % I_UKV;
            p0_transpose_item(A->in[I_WUKV] + (size_t)l * 128 * 1024, 128, 1024, 1024 / 32, (bf16*)(ws + WS_WUKV2) + (size_t)l * 1024 * 256, A->in[I_KVNG] + l * 128, scr, i, lane, MapId(), 256); }
        else if (it >= S0) { const int r = it - S0, l = r / I_UQ, i = r % I_UQ;
            p0_transpose_item(A->in[I_WUQ] + (size_t)l * 256 * 768, 256, 768, 768 / 32, (bf16*)(ws + WS_WUQ) + (size_t)l * 768 * 256, A->in[I_QNG] + l * 256, scr, i, lane, MapId()); }
        else { const int l = it / I_IN, i = it % I_IN;
            p0_transpose_item(A->in[I_WIN] + (size_t)l * D * NIN, D, NIN, NINP / 32, (bf16*)(ws + WS_WIN) + (size_t)l * NINP * D, nullptr, scr, i, lane, MapIn()); }
    }
    const int gt = gw * 64 + lane, NGT = NGW * 64;
    for (int i = gt; i < DEPTH * NE * 2 * FF; i += NGT) { const int m = i / (2 * FF), n = i % (2 * FF); ((float*)(ws + WS_BGU))[i] = A->in[I_BGU][(size_t)m * 2 * FF + MapGU()(n)]; }
    for (int i = gt; i < L * 16; i += NGT) { const int p = i >> 4, k = i & 15; const float inv = 1.0f / powf(10000.0f, (float)(2 * k) / 32.0f); const float ang = (float)p * inv;
        ((f32x2*)(ws + WS_ROPE))[i] = (f32x2){cosf(ang), sinf(ang)}; }
    for (int i = gt; i < DEPTH * NE * D; i += NGT) { const int ll = i / (NE * D), e = (i / D) % NE, k = i % D; const float w = A->in[I_RW][((size_t)ll * D + k) * NE + e]; const unsigned h = f2bf(w);
        bf16* o = (bf16*)(ws + WS_RWT) + (size_t)ll * 2 * NE * D + (size_t)e * D + k; o[0] = (bf16)h; o[NE * D] = (bf16)f2bf(w - bf2f((bf16)h)); }
    for (int i = gt; i < DEPTH * 1024 * 128; i += NGT) ((bf16*)(ws + WS_WUKV2))[(size_t)(i >> 7) * 256 + 128 + (i & 127)] = 0;
    for (int i = gt; i < BATCH * PADF * 256; i += NGT) { const int b = i / (PADF * 256), r = i % (PADF * 256); ((bf16*)(ws + WS_SBV))[(size_t)b * LP * 256 + r] = 0; ((bf16*)(ws + WS_SBK))[(size_t)b * LP * 256 + r] = 0; }
    for (int i = gt; i < BATCH * PADF * 512; i += NGT) { const int b = i / (PADF * 512), r = i % (PADF * 512); ((bf16*)(ws + WS_VM))[(size_t)b * LP * 512 + r] = 0; }
    for (int i = gt; i < BATCH * PADF * 768; i += NGT) { const int b = i / (PADF * 768), r = i % (PADF * 768); ((bf16*)(ws + WS_KM))[(size_t)b * LP * 768 + r] = 0; }
    for (int r = gw; r < TP; r += NGW) {
        bf16* hb = (bf16*)(ws + WS_HB) + (size_t)r * D;
        if (r >= T) { *(v4u*)(hb + 8 * lane) = (v4u){0u, 0u, 0u, 0u}; *(v4u*)(hb + 512 + 8 * lane) = (v4u){0u, 0u, 0u, 0u}; continue; }
        const int bb = r / L, p = r - bb * L;
        const float* src = p < NMETA ? A->in[I_META] + (size_t)p * D : A->in[I_X] + ((size_t)bb * SEQ + (p - NMETA)) * D;
        f32x4 v[4];
#pragma unroll
        for (int j = 0; j < 4; ++j) v[j] = *(const f32x4*)(src + 4 * lane + 256 * j);
        ln_row16(v, A->in[I_LNIN_G], A->in[I_LNIN_B], lane);
        store_row16(v, nullptr, hb, lane);
    }
}


constexpr int CONV_IGU = 32 * 32, CONV_IDN = 32 * 16, CONV_NGU = NE * CONV_IGU, CONV_ITEMS = CONV_NGU + NE * CONV_IDN, CONV_PER_WG = CONV_ITEMS / 256, CONV_PER_WAVE = CONV_PER_WG / NWAVES;
static_assert(CONV_PER_WG * 256 == CONV_ITEMS && CONV_PER_WAVE * NWAVES == CONV_PER_WG, "static conversion partition");
__device__ __forceinline__ void glds16p(const void* gsrc, unsigned lds_dst) { unsigned keep;
    asm volatile("s_mov_b32 %0, m0\n\ts_mov_b32 m0, %2\n\ts_nop 0\n\tglobal_load_lds_dwordx4 %1, off nt\n\ts_mov_b32 m0, %0" : "=&s"(keep) : "v"(gsrc), "s"(lds_dst) : "memory"); }
struct ConvCtx { const float* wgu; const float* wdn; bf16* tgu; bf16* tdn; int base; unsigned slot; int rot; int nofin; };
__device__ __forceinline__ void cv_decode(int g, int rot, bool& isgu, int& m, int& kb, int& nb) {
    isgu = g < CONV_NGU; const int r = isgu ? g : g - CONV_NGU;
    if (isgu) { m = r >> 10; const int i = r & 1023; kb = i >> 6; nb = (i + rot) & 63; } else { m = r >> 9; const int i = r & 511; kb = i >> 5; nb = (i + rot) & 31; }
}
constexpr int CV_SLOT = 8320;
__device__ __forceinline__ void cv_issue(const ConvCtx& c, int g, int lane) {
    bool isgu; int m, kb, nb; cv_decode(g, c.rot, isgu, m, kb, nb);
    const int N = isgu ? 2 * FF : D, scol = isgu ? MapGU()(32 * nb) : 32 * nb;
    const float* sp = (isgu ? c.wgu + (size_t)m * D * 2 * FF : c.wdn + (size_t)m * FF * D) + (size_t)(64 * kb) * N + scol + (size_t)(lane >> 3) * N + 4 * (lane & 7);
#pragma unroll
    for (int i = 0; i < 8; ++i) { glds16p(sp, (unsigned)__builtin_amdgcn_readfirstlane((int)(c.slot + i * 1040))); sp += 8 * N; }
}
__device__ __forceinline__ void cv_finish(const ConvCtx& c, int g, int lane, const LAS float* T) {
    bool isgu; int m, kb, nb; cv_decode(g, c.rot, isgu, m, kb, nb);
    const int cc = lane & 7;
    bf16* dp = (isgu ? c.tgu + (size_t)m * 2 * FF * D : c.tdn + (size_t)m * D * FF) + (size_t)(32 * nb + (lane >> 3)) * 1024 + 64 * kb + 8 * cc;
    const LAS float* s = T + cc * 260 + (lane >> 3);
#pragma unroll
    for (int j = 0; j < 4; ++j) { const LAS float* q = s + 8 * j;
        v4u o; o.x = cvtpk_rne(q[0], q[32]); o.y = cvtpk_rne(q[64], q[96]); o.z = cvtpk_rne(q[128], q[160]); o.w = cvtpk_rne(q[192], q[224]);
        *(GAS v4u*)(dp + (size_t)j * 8 * 1024) = o; }
}

typedef pg8::f32x4 (AccT)[2][2][4][2];
__device__ __forceinline__ v2u pk4(f32x4 v) { return (v2u){cvtpk_rne(v.x, v.y), cvtpk_rne(v.z, v.w)}; }
__device__ __forceinline__ float sigmoidf_(float x) { return __builtin_amdgcn_rcpf(1.0f + __builtin_amdgcn_exp2f(x * -LOG2E)); }

struct EpiInProj {
    static constexpr bool PERM = false;
    bf16 *SBQ, *SBK, *SBV, *CQ, *CKV, *KM; float *U, *STQ, *STKV; const f32x2* ROPE;
    __device__ __forceinline__ void operator()(const AccT& acc, const pg8::Unit& u, int wr, int wc, int fr, int fq) const {
        const int pn = u.pn;
#pragma unroll
        for (int ai = 0; ai < 2; ++ai) {
            if (u.pm * 256 + ai * 128 >= T) continue;
#pragma unroll
            for (int m = 0; m < 4; ++m) {
                const int r = u.pm * 256 + ai * 128 + wr * 64 + m * 16 + fr;
                const int bb = r / L, p = r - bb * L; const size_t ar = (size_t)bb * LP + p + PADF;
                if (pn <= 2) {
                    bf16* dst = (pn == 0 ? SBQ : pn == 1 ? SBK : SBV) + ar * 256 + wc * 32 + 4 * fq; const float sc = pn == 0 ? SBQ_SCALE : 1.0f;
#pragma unroll
                    for (int bj = 0; bj < 2; ++bj)
#pragma unroll
                        for (int n = 0; n < 2; ++n) *(v2u*)(dst + bj * 128 + n * 16) = pk4(acc[ai][bj][m][n] * sc);
                } else if (pn == 3) {
                    float ss = 0.f;
#pragma unroll
                    for (int bj = 0; bj < 2; ++bj)
#pragma unroll
                        for (int n = 0; n < 2; ++n) { const f32x4 v = acc[ai][bj][m][n]; ss += (v.x * v.x + v.y * v.y) + (v.z * v.z + v.w * v.w); *(v2u*)(CQ + (size_t)r * 256 + bj * 128 + wc * 32 + n * 16 + 4 * fq) = pk4(v); }
                    ss += __shfl_xor(ss, 16); ss += __shfl_xor(ss, 32);
                    if (fq == 0) STQ[(size_t)r * 4 + wc] = ss;
                } else if (pn == 4) {
                    float ss = 0.f;
#pragma unroll
                    for (int n = 0; n < 2; ++n) { const f32x4 v = acc[ai][0][m][n]; ss += (v.x * v.x + v.y * v.y) + (v.z * v.z + v.w * v.w); *(v2u*)(CKV + (size_t)r * 256 + wc * 32 + n * 16 + 4 * fq) = pk4(v); *(v2u*)(CKV + (size_t)r * 256 + 128 + wc * 32 + n * 16 + 4 * fq) = (v2u){0u, 0u}; }
                    ss += __shfl_xor(ss, 16); ss += __shfl_xor(ss, 32);
                    if (fq == 0) STKV[(size_t)r * 4 + wc] = ss;
                    if (wc == 0) {
                        const f32x4 x1 = acc[ai][1][m][0], x2 = acc[ai][1][m][1]; f32x4 y1, y2;
#pragma unroll
                        for (int j = 0; j < 4; ++j) { const f32x2 cs = ROPE[p * 16 + 4 * fq + j]; y1[j] = x1[j] * cs.x - x2[j] * cs.y; y2[j] = x1[j] * cs.y + x2[j] * cs.x; }
                        const v2u w1 = pk4(y1), w2 = pk4(y2);
#pragma unroll
                        for (int h = 0; h < 8; ++h) { bf16* kd = KM + ar * 768 + h * 96 + 64 + 4 * fq; *(v2u*)kd = w1; *(v2u*)(kd + 16) = w2; }
                    }
                } else {
#pragma unroll
                    for (int n = 0; n < 2; ++n) { const f32x4 a = acc[ai][0][m][n], g = acc[ai][1][m][n]; f32x4 o;
#pragma unroll
                        for (int j = 0; j < 4; ++j) o[j] = a[j] * sigmoidf_(g[j]);
                        *(f32x4*)(U + (size_t)r * 256 + (pn - 5) * 128 + wc * 32 + n * 16 + 4 * fq) = o; }
                }
                asm volatile("" ::: "memory");
            }
        }
    }
};
struct EpiMlaQ {
    static constexpr bool PERM = false;
    bf16* QM; const float* STQ; const f32x2* ROPE;
    __device__ __forceinline__ void operator()(const AccT& acc, const pg8::Unit& u, int wr, int wc, int fr, int fq) const {
#pragma unroll
        for (int ai = 0; ai < 2; ++ai) {
            if (u.pm * 256 + ai * 128 >= T) continue;
#pragma unroll
            for (int m = 0; m < 4; ++m) {
                const int r = u.pm * 256 + ai * 128 + wr * 64 + m * 16 + fr;
                const int bb = r / L, p = r - bb * L; const size_t ar = (size_t)bb * LP + p + PADF;
                const f32x4 st = *(const f32x4*)(STQ + (size_t)r * 4);
                const float rs = MLAQ_SCALE * __builtin_amdgcn_rsqf(((st.x + st.y) + (st.z + st.w)) * (1.f / 256.f) + RMS_EPS);
#pragma unroll
                for (int bj = 0; bj < 2; ++bj) {
                    const int G = 8 * u.pn + 4 * bj + wc, head = G / 3, part = G - 3 * head;
                    f32x4 v0 = acc[ai][bj][m][0] * rs, v1 = acc[ai][bj][m][1] * rs;
                    if (part == 2) {
#pragma unroll
                        for (int j = 0; j < 4; ++j) { const f32x2 cs = ROPE[p * 16 + 4 * fq + j]; const float x1 = v0[j], x2 = v1[j]; v0[j] = x1 * cs.x - x2 * cs.y; v1[j] = x1 * cs.y + x2 * cs.x; }
                    }
                    bf16* dst = QM + ar * 768 + head * 96 + part * 32 + 4 * fq;
                    *(v2u*)dst = pk4(v0); *(v2u*)(dst + 16) = pk4(v1);
                }
                asm volatile("" ::: "memory");
            }
        }
    }
};
struct EpiMlaKV {
    static constexpr bool PERM = false;
    bf16 *KM, *VM; const float* STKV;
    __device__ __forceinline__ void operator()(const AccT& acc, const pg8::Unit& u, int wr, int wc, int fr, int fq) const {
#pragma unroll
        for (int ai = 0; ai < 2; ++ai) {
            if (u.pm * 256 + ai * 128 >= T) continue;
#pragma unroll
            for (int m = 0; m < 4; ++m) {
                const int r = u.pm * 256 + ai * 128 + wr * 64 + m * 16 + fr;
                const int bb = r / L, p = r - bb * L; const size_t ar = (size_t)bb * LP + p + PADF;
                const f32x4 st = *(const f32x4*)(STKV + (size_t)r * 4);
                const float rs = __builtin_amdgcn_rsqf(((st.x + st.y) + (st.z + st.w)) * (1.f / 128.f) + RMS_EPS);
#pragma unroll
                for (int bj = 0; bj < 2; ++bj) {
                    const int G = 8 * u.pn + 4 * bj + wc, head = G >> 2, part = G & 3;
                    bf16* dst = part < 2 ? KM + ar * 768 + head * 96 + part * 32 + 4 * fq : VM + ar * 512 + head * 64 + (part - 2) * 32 + 4 * fq;
                    *(v2u*)dst = pk4(acc[ai][bj][m][0] * rs); *(v2u*)(dst + 16) = pk4(acc[ai][bj][m][1] * rs);
                }
                asm volatile("" ::: "memory");
            }
        }
    }
};
struct EpiMla {
    static constexpr bool PERM = false;
    EpiMlaQ q; EpiMlaKV kv;
    __device__ __forceinline__ void operator()(const AccT& acc, const pg8::Unit& u, int wr, int wc, int fr, int fq) const { if (u.kind == 0) q(acc, u, wr, wc, fr, fq); else kv(acc, u, wr, wc, fr, fq); }
};
struct MlaOrder {
    pg8::StaticOrder sq, sk; int G, c;
    __device__ __forceinline__ bool next(int i, pg8::Unit& u) const {
        const int Lx = i * G + c;
        if (Lx < sq.nwg) { pg8::StaticOrder s = sq; s.G = 1; s.c = 0; const bool ok = s.next(Lx, u); u.kind = 0; return ok; }
        if (Lx - sq.nwg < sk.nwg) { pg8::StaticOrder s = sk; s.G = 1; s.c = 0; const bool ok = s.next(Lx - sq.nwg, u); u.kind = 1; return ok; }
        return false;
    }
};
struct EpiOut {
    static constexpr bool PERM = false;
    const bf16* HBr; float* Z;
    __device__ __forceinline__ void operator()(const AccT& acc, const pg8::Unit& u, int wr, int wc, int fr, int fq) const {
#pragma unroll
        for (int ai = 0; ai < 2; ++ai) {
            if (u.pm * 256 + ai * 128 >= T) continue;
#pragma unroll
            for (int m = 0; m < 4; ++m) {
                const size_t off = (size_t)(u.pm * 256 + ai * 128 + wr * 64 + m * 16 + fr) * D + u.pn * 256 + wc * 32 + 4 * fq;
#pragma unroll
                for (int bj = 0; bj < 2; ++bj)
#pragma unroll
                    for (int n = 0; n < 2; ++n) { const v2u hw = *(const v2u*)(HBr + off + bj * 128 + n * 16); const f32x4 h = (f32x4){bflo(hw.x), bfhi(hw.x), bflo(hw.y), bfhi(hw.y)}; *(f32x4*)(Z + off + bj * 128 + n * 16) = h * ALPHA + acc[ai][bj][m][n]; }
                asm volatile("" ::: "memory");
            }
        }
    }
};
struct EpiOutTail {
    static constexpr bool PERM = false;
    float* ZP;
    __device__ __forceinline__ void operator()(const AccT& acc, const pg8::Unit& u, int wr, int wc, int fr, int fq) const {
        float* base = ZP + (size_t)(u.ko >> 8) * 128 * D;
#pragma unroll
        for (int m = 0; m < 4; ++m) {
            const size_t off = (size_t)(wr * 64 + m * 16 + fr) * D + u.pn * 256 + wc * 32 + 4 * fq;
#pragma unroll
            for (int bj = 0; bj < 2; ++bj)
#pragma unroll
                for (int n = 0; n < 2; ++n) *(f32x4*)(base + off + bj * 128 + n * 16) = acc[0][bj][m][n];
        }
    }
};
struct TailOrder {
    int vcu;
    __device__ __forceinline__ bool next(int i, pg8::Unit& u) const { if (i > 0 || (vcu & 15) != 0) return false; const int j = vcu >> 4; u.pm = 64; u.pn = j & 3; u.pb = j & 3; u.ko = (j >> 2) * 256; u.kind = 0; return true; }
    __device__ __forceinline__ void a_ready(const pg8::Unit&) const {}
    __device__ __forceinline__ const LAS int* rowlist(int) const { return nullptr; }
};
__device__ __forceinline__ void store16_wt(void* p, v4u v) { asm volatile("global_store_dwordx4 %0, %1, off sc1\n\ts_nop 1" :: "v"(p), "v"(v) : "memory"); }
struct EpiMoe1 {
    static constexpr bool PERM = true;
    bf16* ACT; const float* BGU; unsigned* rdy;
    mutable int pend = -1;
    __device__ __forceinline__ void flush(int fr, int fq, bool drain_all) const {
        if (pend < 0) return;
        if (drain_all) asm volatile("s_waitcnt vmcnt(0)" ::: "memory"); else asm volatile("s_waitcnt vmcnt(8)" ::: "memory");
        if (fr == 0 && fq == 0) __hip_atomic_fetch_add(rdy + 16 * pend, 1u, __ATOMIC_RELAXED, __HIP_MEMORY_SCOPE_AGENT);
        pend = -1;
    }
    __device__ __forceinline__ void operator()(const AccT& acc, const pg8::Unit& u, int wr, int wc, int fr, int fq) const {
        flush(fr, fq, false);
        const int c8 = wc * 32 + 8 * fq; const float* bp = BGU + (size_t)u.pb * 256 + c8;
        f32x4 bg[2], bu[2];
#pragma unroll
        for (int n = 0; n < 2; ++n) { bg[n] = *(const f32x4*)(bp + 4 * n); bu[n] = *(const f32x4*)(bp + 128 + 4 * n); }
#pragma unroll
        for (int ai = 0; ai < 2; ++ai)
#pragma unroll
            for (int m = 0; m < 4; ++m) {
                bf16* dst = ACT + (size_t)(u.pm * 256 + ai * 128 + wr * 64 + m * 16 + fr) * FF + u.pn * 128 + c8;
                f32x4 o[2];
#pragma unroll
                for (int n = 0; n < 2; ++n) { const f32x4 g = acc[ai][0][m][n] + bg[n], up = acc[ai][1][m][n] + bu[n];
#pragma unroll
                    for (int j = 0; j < 4; j += 2) { f32x2 gg, uu; gg.x = fminf(g[j], 7.0f); gg.y = fminf(g[j + 1], 7.0f); uu.x = __builtin_amdgcn_fmed3f(up[j], -7.0f, 7.0f); uu.y = __builtin_amdgcn_fmed3f(up[j + 1], -7.0f, 7.0f);
                        const f32x2 t = gg * (-1.702f * LOG2E); f32x2 e; e.x = __builtin_amdgcn_exp2f(t.x); e.y = __builtin_amdgcn_exp2f(t.y);
                        const f32x2 d = e + 1.0f; f32x2 r; r.x = __builtin_amdgcn_rcpf(d.x); r.y = __builtin_amdgcn_rcpf(d.y);
                        const f32x2 res = (uu + 1.0f) * (gg * r); o[n][j] = res.x; o[n][j + 1] = res.y; } }
                v4u w; w.x = cvtpk_rne(o[0].x, o[0].y); w.y = cvtpk_rne(o[0].z, o[0].w); w.z = cvtpk_rne(o[1].x, o[1].y); w.w = cvtpk_rne(o[1].z, o[1].w);
                store16_wt(dst, w);
            }
        pend = u.pm;
    }
};
struct EpiMoe2 {
    static constexpr bool PERM = true;
    bf16* YS; const float* BD;
    __device__ __forceinline__ void operator()(const AccT& acc, const pg8::Unit& u, int wr, int wc, int fr, int fq) const {
        const int c8 = wc * 32 + 8 * fq; const float* bp = BD + (size_t)u.pb * 256 + c8;
        f32x4 bv[2][2];
#pragma unroll
        for (int bj = 0; bj < 2; ++bj)
#pragma unroll
            for (int n = 0; n < 2; ++n) bv[bj][n] = *(const f32x4*)(bp + bj * 128 + 4 * n);
#pragma unroll
        for (int ai = 0; ai < 2; ++ai)
#pragma unroll
            for (int m = 0; m < 4; ++m) {
                bf16* dst = YS + (size_t)(u.pm * 256 + ai * 128 + wr * 64 + m * 16 + fr) * D + u.pn * 256 + c8;
#pragma unroll
                for (int bj = 0; bj < 2; ++bj) { const f32x4 v0 = acc[ai][bj][m][0] + bv[bj][0], v1 = acc[ai][bj][m][1] + bv[bj][1];
                    v4u w; w.x = cvtpk_rne(v0.x, v0.y); w.y = cvtpk_rne(v0.z, v0.w); w.z = cvtpk_rne(v1.x, v1.y); w.w = cvtpk_rne(v1.z, v1.w);
                    *(v4u*)(dst + bj * 128) = w; }
                asm volatile("" ::: "memory");
            }
    }
};

struct EpiMoe12 {
    static constexpr bool PERM = true;
    EpiMoe1 e1; EpiMoe2 e2;
    __device__ __forceinline__ void operator()(const AccT& acc, const pg8::Unit& u, int wr, int wc, int fr, int fq) const { if (u.kind == 0) e1(acc, u, wr, wc, fr, fq); else { e1.flush(fr, fq, false); e2(acc, u, wr, wc, fr, fq); } }
};
#ifndef MOE_GM
#define MOE_GM 4
#endif
struct MoeOrder {
    const LAS int* tb; int G, vcu;
    __device__ __forceinline__ bool next(int i, pg8::Unit& u) const {
        const int TM = tb[NE]; int Lx = i * G + vcu; if (Lx >= TM * 12) return false;
        const int kind = Lx >= TM * 8 ? 1 : 0, NT = kind ? 4 : 8; if (kind) Lx -= TM * 8;
        constexpr int GM = MOE_GM;
        const int grp = Lx / (GM * NT), rem = Lx - grp * GM * NT, gs = (TM - GM * grp) < GM ? (TM - GM * grp) : GM;
        const int pn = rem / gs, pm = GM * grp + (rem - pn * gs);
        int e = 0;
#pragma unroll 1
        for (int k = 1; k < NE; ++k) e += (tb[k] <= pm) ? 1 : 0;
        u.pm = pm; u.pn = pn; u.pb = e * NT + pn; u.ko = 0; u.kind = kind; return true;
    }
};
__device__ __forceinline__ void moe_tile_prefix(Frame& F, int l, LAS int* tb) {
    if (F.tid == 0) { int s = 0; for (int e = 0; e < NE; ++e) { tb[e] = s; s += ((int)__hip_atomic_load(F.ctl + CW_CNT + l * 64 + e, RLX_AGENT) + 255) >> 8; } tb[NE] = s; }
    __syncthreads();
}

constexpr int CONV_RUN = 9;
__device__ __forceinline__ void phase_norm_conv(Frame& F, KArgs A, int l) {
    unsigned char* ws = F.ws; int lane = F.lane; asm volatile("" : "+v"(lane));
    LAS float* cw = (LAS float*)(F.lds + RING_OFF);
    const float* cwg = A->in[I_CONVW] + (size_t)l * CONVK * 256;
    for (int i = F.wave * 64 + lane; i < 47 * 256; i += NWAVES * 64) { const int k = (i >> 8) - 8; cw[i] = (k >= 0 && k < CONVK) ? cwg[k * 256 + (i & 255)] : 0.f; }
    __syncthreads();
    const bf16* OATT = (const bf16*)(ws + WS_OATT); const float* U = (const float*)(ws + WS_U); bf16* Y = (bf16*)(ws + WS_Y);
    const f32x4 cb = *(const f32x4*)(A->in[I_CONVB] + l * 256 + 4 * lane), lg = *(const f32x4*)(A->in[I_CLNG] + l * 256 + 4 * lane), lb = *(const f32x4*)(A->in[I_CLNB] + l * 256 + 4 * lane);
    const int gw = F.vcu * NWAVES + F.wave, wpb = (F.G * NWAVES) / BATCH;
    const LAS f32x4* cwl = (const LAS f32x4*)(cw + 4 * lane);
    if (gw < wpb * BATCH) {
        const int b = gw / wpb, wi = gw - b * wpb, ps = (wi * L) / wpb, pe = ((wi + 1) * L) / wpb;
        const size_t rb = (size_t)b * L;
#pragma unroll 1
        for (int p0 = ps; p0 < pe; p0 += CONV_RUN) {
            const int n = (pe - p0) < CONV_RUN ? (pe - p0) : CONV_RUN;
            f32x4 acc[CONV_RUN];
#pragma unroll
            for (int i = 0; i < CONV_RUN; ++i) acc[i] = cb;
#pragma unroll 1
            for (int c = 0; c < 3; ++c) {
                f32x4 u[13];
#pragma unroll
                for (int jj = 0; jj < 13; ++jj) { const int j = -(CONVK - 1) + c * 13 + jj; int pr = p0 + j; const bool ok = pr >= 0; pr = pr < 0 ? 0 : (pr > L - 1 ? L - 1 : pr);
                    u[jj] = *(const f32x4*)(U + (rb + pr) * 256 + 4 * lane); if (!ok) u[jj] = (f32x4){0.f, 0.f, 0.f, 0.f}; }
                const LAS f32x4* wc = cwl + (c * 13) * 64;
#pragma unroll
                for (int jj = 0; jj < 13; ++jj)
#pragma unroll
                    for (int i = 0; i < CONV_RUN; ++i) acc[i] += u[jj] * wc[(jj - i + 8) * 64];
            }
#pragma unroll
            for (int i0 = 0; i0 < CONV_RUN; i0 += 3) {
                f32x4 o[3][3];
#pragma unroll
                for (int ii = 0; ii < 3; ++ii) { const int i = (i0 + ii) < n ? (i0 + ii) : 0;
#pragma unroll
                    for (int j = 0; j < 3; ++j) { const v2u w = *(const v2u*)(OATT + (rb + p0 + i) * 768 + 4 * lane + 256 * j); o[ii][j] = (f32x4){bflo(w.x), bfhi(w.x), bflo(w.y), bfhi(w.y)}; } }
#pragma unroll
                for (int ii = 0; ii < 3; ++ii) {
                    const int i = i0 + ii; const size_t r = rb + p0 + i;
                    f32x4 c = acc[i];
                    const float mu = wave_sum((c.x + c.y) + (c.z + c.w)) * (1.f / 256.f); c = c - mu;
                    const float var = wave_sum((c.x * c.x + c.y * c.y) + (c.z * c.z + c.w * c.w)) * (1.f / 256.f);
                    c = c * __builtin_amdgcn_rsqf(var + LN_EPS) * lg + lb;
#pragma unroll
                    for (int j = 0; j < 4; ++j) c[j] = c[j] * sigmoidf_(c[j]);
                    const float rc = __builtin_amdgcn_rsqf(wave_sum((c.x * c.x + c.y * c.y) + (c.z * c.z + c.w * c.w)) * (1.f / 256.f) + RMS_EPS);
                    const f32x4 o0 = o[ii][0], o1 = o[ii][1], o2 = o[ii][2];
                    const float s0 = wave_sum((o0.x * o0.x + o0.y * o0.y) + (o0.z * o0.z + o0.w * o0.w));
                    const float s1 = wave_sum(((o1.x * o1.x + o1.y * o1.y) + (o1.z * o1.z + o1.w * o1.w)) + ((o2.x * o2.x + o2.y * o2.y) + (o2.z * o2.z + o2.w * o2.w)));
                    const float r0s = __builtin_amdgcn_rsqf(s0 * (1.f / 256.f) + RMS_EPS), r1s = __builtin_amdgcn_rsqf(s1 * (1.f / 512.f) + RMS_EPS);
                    if (i < n) {
                        *(v2u*)(Y + r * D + 768 + 4 * lane) = pk4(c * rc);
                        *(v2u*)(Y + r * D + 4 * lane) = pk4(o0 * r0s);
                        *(v2u*)(Y + r * D + 256 + 4 * lane) = pk4(o1 * r1s);
                        *(v2u*)(Y + r * D + 512 + 4 * lane) = pk4(o2 * r1s);
                    }
                }
            }
        }
    }
    __syncthreads();
}

#ifndef RT_ROWS
#define RT_ROWS 4
#endif
__device__ __forceinline__ void phase_router(Frame& F, KArgs A, int l, bool dry = false) {
    typedef __attribute__((ext_vector_type(16))) float f32x16;
    unsigned char* ws = F.ws; int tid = F.tid; asm volatile("" : "+v"(tid)); const int lane = tid & 63, wave = F.wave;
    LAS float* PART = (LAS float*)(F.lds + RING_OFF);
    LAS int* lcnt = (LAS int*)(F.lds + TAIL_OFF); LAS int* lbase = lcnt + 32; LAS int* sel = lbase + 32;
    if (tid < 32) lcnt[tid] = 0;
    const int start = (int)(((long)F.vcu * T) / F.G), end = (int)(((long)(F.vcu + 1) * T) / F.G);
    const float* Z = (const float*)(ws + WS_Z); bf16* HL = (bf16*)(ws + WS_HL); bf16* HB = (bf16*)(ws + WS_HB);
    int* TOKE = (int*)(ws + WS_TOKE); int* TOKP = (int*)(ws + WS_TOKP); float* TOKG = (float*)(ws + WS_TOKG); int* LIST = (int*)(ws + WS_LIST);
    const float* lng = A->in[I_LNMIX_G] + l * D; const float* lnb = A->in[I_LNMIX_B] + l * D;
#pragma unroll 1
    for (int t0 = start + wave; t0 < end; t0 += RT_ROWS * NWAVES) {
        f32x4 v[RT_ROWS][4];
#pragma unroll
        for (int s = 0; s < RT_ROWS; ++s) { const int t = (t0 + s * NWAVES) < end ? (t0 + s * NWAVES) : t0;
#pragma unroll
            for (int j = 0; j < 4; ++j) v[s][j] = *(const f32x4*)(Z + (size_t)t * D + 4 * lane + 256 * j); }
#pragma unroll
        for (int s = 0; s < RT_ROWS; ++s) { ln_row16(v[s], lng, lnb, lane); const int t = t0 + s * NWAVES;
            if (t < end) {
#pragma unroll
                for (int j = 0; j < 4; ++j) { const v2u hw = (v2u){pk2(v[s][j].x, v[s][j].y), pk2(v[s][j].z, v[s][j].w)};
                    *(v2u*)(HB + (size_t)t * D + 4 * lane + 256 * j) = hw;
                    *(v2u*)(HL + (size_t)t * D + 4 * lane + 256 * j) = (v2u){pk2(v[s][j].x - bflo(hw.x), v[s][j].y - bfhi(hw.x)), pk2(v[s][j].z - bflo(hw.y), v[s][j].w - bfhi(hw.y))}; } } }
    }
    asm volatile("s_waitcnt vmcnt(0)" ::: "memory");
    __syncthreads();
    const bf16* rwh = (const bf16*)(ws + WS_RWT) + (size_t)l * 2 * NE * D; const bf16* rwl = rwh + NE * D;
    const int r32 = lane & 31, hi = lane >> 5;
#pragma unroll 1
    for (int g0 = start; g0 < end; g0 += 96) {
        const int ng = (end - g0) < 96 ? (end - g0) : 96;
        f32x16 acc[3]; acc[0] = f32x16{}; acc[1] = f32x16{}; acc[2] = f32x16{};
        int tok[3];
#pragma unroll
        for (int g = 0; g < 3; ++g) tok[g] = g0 + ((32 * g + r32) < ng ? (32 * g + r32) : 0);
#pragma unroll 2
        for (int ks = 0; ks < 8; ++ks) {
            const int kk = 128 * wave + 16 * ks + 8 * hi;
            const bf16x8 bh = *(const bf16x8*)(rwh + (size_t)r32 * D + kk), bl = *(const bf16x8*)(rwl + (size_t)r32 * D + kk);
#pragma unroll
            for (int g = 0; g < 3; ++g) {
                const v4u aw = *(const v4u*)(HB + (size_t)tok[g] * D + kk), lw = *(const v4u*)(HL + (size_t)tok[g] * D + kk);
                const bf16x8 ah = __builtin_bit_cast(bf16x8, aw), al = __builtin_bit_cast(bf16x8, lw);
                acc[g] = __builtin_amdgcn_mfma_f32_32x32x16_bf16(ah, bh, acc[g], 0, 0, 0);
                acc[g] = __builtin_amdgcn_mfma_f32_32x32x16_bf16(ah, bl, acc[g], 0, 0, 0);
                acc[g] = __builtin_amdgcn_mfma_f32_32x32x16_bf16(al, bh, acc[g], 0, 0, 0);
            }
        }
#pragma unroll
        for (int g = 0; g < 3; ++g)
#pragma unroll
            for (int r = 0; r < 16; ++r) PART[(wave * 96 + 32 * g + (r & 3) + 8 * (r >> 2) + 4 * hi) * 33 + r32] = acc[g][r];
        __syncthreads();
        if (tid < ng) {
            const int t = g0 + tid; float v[32];
#pragma unroll
            for (int e = 0; e < 32; ++e) { float s = A->in[I_RB][l * NE + e];
#pragma unroll
                for (int w = 0; w < 8; ++w) s += PART[(w * 96 + tid) * 33 + e];
                v[e] = s; }
            float tv[4]; int ti[4];
#pragma unroll
            for (int k = 0; k < 4; ++k) {
                float bv = -INFINITY; int bi = 0;
#pragma unroll
                for (int e = 0; e < 32; ++e) if (v[e] > bv) { bv = v[e]; bi = e; }
                tv[k] = bv; ti[k] = bi;
#pragma unroll
                for (int e = 0; e < 32; ++e) if (e == bi) v[e] = -INFINITY;
            }
            float ex[4], sum = 0.f;
#pragma unroll
            for (int k = 0; k < 4; ++k) { ex[k] = __expf(tv[k] - tv[0]); sum += ex[k]; }
            const float inv = 1.0f / sum;
            *(v4u*)(TOKE + t * 4) = (v4u){(unsigned)ti[0], (unsigned)ti[1], (unsigned)ti[2], (unsigned)ti[3]};
            *(f32x4*)(TOKG + t * 4) = (f32x4){ex[0] * inv, ex[1] * inv, ex[2] * inv, ex[3] * inv};
#pragma unroll
            for (int k = 0; k < 4; ++k) { const int rank = __hip_atomic_fetch_add(lcnt + ti[k], 1, __ATOMIC_RELAXED, __HIP_MEMORY_SCOPE_WORKGROUP);
                sel[((t - start) * 4 + k) * 2] = ti[k]; sel[((t - start) * 4 + k) * 2 + 1] = rank; }
        }
        __syncthreads();
    }
    if (tid < 32) lbase[tid] = (int)__hip_atomic_fetch_add(F.ctl + CW_CNT + (dry ? 128 : 0) + l * 64 + tid, (unsigned)lcnt[tid], RLX_AGENT);
    __syncthreads();
    if (!dry) for (int i = tid; i < (end - start) * 4; i += NWAVES * 64) { const int e = sel[i * 2], pos = lbase[e] + sel[i * 2 + 1]; TOKP[(start + (i >> 2)) * 4 + (i & 3)] = pos; LIST[(size_t)e * T + pos] = start + (i >> 2); }
    __syncthreads();
}

__device__ __forceinline__ void phase_combine(Frame& F, KArgs A, int l, bool dry = false) {
    unsigned char* ws = F.ws; int lane = F.lane; asm volatile("" : "+v"(lane));
    bf16* HB = (bf16*)(ws + WS_HB); const bf16* YS = (const bf16*)(ws + WS_YS);
    const int* TOKE = (const int*)(ws + WS_TOKE); const int* TOKP = (const int*)(ws + WS_TOKP); const float* TOKG = (const float*)(ws + WS_TOKG);
    int tiles = 0; if (lane < NE) tiles = ((int)__hip_atomic_load(F.ctl + CW_CNT + l * 64 + lane, RLX_AGENT) + 255) >> 8;
    int incl = tiles;
#pragma unroll
    for (int o = 1; o < 32; o <<= 1) { const int v = __shfl_up(incl, o); if (lane >= o) incl += v; }
    const int tbl = incl - tiles;
    const float* lng = A->in[I_LNFFN_G] + l * D; const float* lnb = A->in[I_LNFFN_B] + l * D;
    f32x4 gg[4], bb[4];
#pragma unroll
    for (int q = 0; q < 4; ++q) { const int c = 8 * lane + 512 * (q >> 1) + 4 * (q & 1); gg[q] = *(const f32x4*)(lng + c); bb[q] = *(const f32x4*)(lnb + c); }
    const int gw = F.vcu * NWAVES + F.wave, NGW = F.G * NWAVES;
#pragma unroll 1
    for (int t0 = gw; t0 < T; t0 += 2 * NGW) {
        int tt[2]; tt[0] = t0; tt[1] = (t0 + NGW) < T ? (t0 + NGW) : t0; const bool ok1 = (t0 + NGW) < T;
        f32x4 v[2][4]; v4u y[2][4][2]; float g[2][4];
#pragma unroll
        for (int s = 0; s < 2; ++s) {
            const int t = tt[s];
            const v4u e4 = *(const v4u*)(TOKE + t * 4), p4 = *(const v4u*)(TOKP + t * 4); const f32x4 g4 = *(const f32x4*)(TOKG + t * 4);
#pragma unroll
            for (int jj = 0; jj < 2; ++jj) { const v4u hw = *(const v4u*)(HB + (size_t)t * D + 8 * lane + 512 * jj); v[s][2 * jj] = (f32x4){bflo(hw.x), bfhi(hw.x), bflo(hw.y), bfhi(hw.y)}; v[s][2 * jj + 1] = (f32x4){bflo(hw.z), bfhi(hw.z), bflo(hw.w), bfhi(hw.w)}; }
#pragma unroll
            for (int k = 0; k < 4; ++k) { const size_t row = (size_t)__shfl(tbl, (int)e4[k]) * 256 + p4[k]; g[s][k] = g4[k];
#pragma unroll
                for (int jj = 0; jj < 2; ++jj) y[s][k][jj] = *(const v4u*)(YS + row * D + 8 * lane + 512 * jj); }
        }
#pragma unroll
        for (int s = 0; s < 2; ++s) {
#pragma unroll
            for (int q = 0; q < 4; ++q) v[s][q] = v[s][q] * ALPHA;
#pragma unroll
            for (int k = 0; k < 4; ++k)
#pragma unroll
                for (int jj = 0; jj < 2; ++jj) { const v4u w = y[s][k][jj]; const float gk = g[s][k];
                    v[s][2 * jj] += (f32x4){bflo(w.x), bfhi(w.x), bflo(w.y), bfhi(w.y)} * gk; v[s][2 * jj + 1] += (f32x4){bflo(w.z), bfhi(w.z), bflo(w.w), bfhi(w.w)} * gk; }
            float sm = 0.f;
#pragma unroll
            for (int q = 0; q < 4; ++q) sm += (v[s][q].x + v[s][q].y) + (v[s][q].z + v[s][q].w);
            const float mean = wave_sum(sm) * (1.f / D); float s2 = 0.f;
#pragma unroll
            for (int q = 0; q < 4; ++q) { v[s][q] = v[s][q] - mean; s2 += (v[s][q].x * v[s][q].x + v[s][q].y * v[s][q].y) + (v[s][q].z * v[s][q].z + v[s][q].w * v[s][q].w); }
            const float rstd = __builtin_amdgcn_rsqf(wave_sum(s2) * (1.f / D) + LN_EPS);
#pragma unroll
            for (int q = 0; q < 4; ++q) v[s][q] = v[s][q] * rstd * gg[q] + bb[q];
            if (s == 0 || ok1) {
                const int t = tt[s];
                if (dry) { bf16* ob = (bf16*)(ws + WS_Z) + (size_t)t * D + 8 * lane;
#pragma unroll
                    for (int jj = 0; jj < 2; ++jj) *(v4u*)(ob + 512 * jj) = (v4u){pk2(v[s][2 * jj].x, v[s][2 * jj].y), pk2(v[s][2 * jj].z, v[s][2 * jj].w), pk2(v[s][2 * jj + 1].x, v[s][2 * jj + 1].y), pk2(v[s][2 * jj + 1].z, v[s][2 * jj + 1].w)};
                } else if (l == DEPTH - 1) {
                    const int bi = t / L, pp = t - bi * L;
                    if (pp >= NMETA) { float* o = F.out + ((size_t)bi * SEQ + (pp - NMETA)) * D + 8 * lane;
#pragma unroll
                        for (int q = 0; q < 4; ++q) *(f32x4*)(o + 512 * (q >> 1) + 4 * (q & 1)) = v[s][q]; }
                } else {
                    bf16* ob = HB + (size_t)t * D + 8 * lane;
#pragma unroll
                    for (int jj = 0; jj < 2; ++jj) *(v4u*)(ob + 512 * jj) = (v4u){pk2(v[s][2 * jj].x, v[s][2 * jj].y), pk2(v[s][2 * jj].z, v[s][2 * jj].w), pk2(v[s][2 * jj + 1].x, v[s][2 * jj + 1].y), pk2(v[s][2 * jj + 1].z, v[s][2 * jj + 1].w)};
                }
            }
        }
    }
}
}
namespace att {
using namespace mk;
typedef __attribute__((ext_vector_type(4))) short s16x4;
typedef __attribute__((ext_vector_type(16))) float f32x16;
typedef short v4i16_t __attribute__((ext_vector_type(4)));
typedef LAS const char* lds_cptr;
constexpr int KSLOT = 12288, VSLOT = 8192;
constexpr int NSLOT = 3;
constexpr int A_K = 0, A_V = NSLOT * KSLOT, A_WS = A_V + NSLOT * VSLOT, A_Q = A_WS + NWAVES * 256, A_BYTES = A_Q + 64;
constexpr float NEGBIG = -1.0e30f;
__device__ __forceinline__ int crow(int r, int hi) { return (r & 3) + 8 * (r >> 2) + 4 * hi; }
__device__ __forceinline__ void glds16(const void* gsrc, unsigned lds_dst) { unsigned keep;
    asm volatile("s_mov_b32 %0, m0\n\ts_mov_b32 m0, %2\n\ts_nop 0\n\tglobal_load_lds_dwordx4 %1, off\n\ts_mov_b32 m0, %0" : "=&s"(keep) : "v"(gsrc), "s"(lds_dst) : "memory"); }
__device__ __forceinline__ s16x4 vtr(lds_cptr p) { return __builtin_bit_cast(s16x4, __builtin_amdgcn_ds_read_tr16_b64_v4i16((LAS v4i16_t*)p)); }
__device__ __forceinline__ unsigned cvtpk(float lo, float hi) { typedef float f2 __attribute__((ext_vector_type(2))); typedef __bf16 b2 __attribute__((ext_vector_type(2))); f2 v = {lo, hi}; b2 b = __builtin_convertvector(v, b2); return __builtin_bit_cast(unsigned, b); }
__device__ __forceinline__ float max3f(float a, float b, float c) { float r; asm("v_max3_f32 %0, %1, %2, %3" : "=v"(r) : "v"(a), "v"(b), "v"(c)); return r; }
__device__ __forceinline__ float min2f(float a, float b) { float r; asm("v_min_f32_e32 %0, %1, %2" : "=v"(r) : "v"(a), "v"(b)); return r; }
#define ATT_WAIT_BAR(N) asm volatile("s_waitcnt vmcnt(" #N ") lgkmcnt(0)\n\ts_barrier" ::: "memory")
#define ATT_WAIT_SW(n) do { switch (n) { case 2: ATT_WAIT_BAR(2); break; case 3: ATT_WAIT_BAR(3); break; case 8: ATT_WAIT_BAR(8); break; case 10: ATT_WAIT_BAR(10); break; case 11: ATT_WAIT_BAR(11); break; \
        case 12: ATT_WAIT_BAR(12); break; case 14: ATT_WAIT_BAR(14); break; case 15: ATT_WAIT_BAR(15); break; default: ATT_WAIT_BAR(0); break; } } while (0)

#ifndef CV_AGE
#define CV_AGE 1
#endif
template <int MODE>
__device__ __forceinline__ void attn_unit(int b, int h, int qb  , const bf16* Q, const bf16* Kg, const bf16* Vg, bf16* OATT, char* shm, const ConvCtx cv, const LAS float* cvT, int& cnext, int& cpend) {
    constexpr int DQK = MODE == 0 ? 64 : 96, NKS = DQK / 16, NCH = DQK / 8;
    constexpr int QP = MODE == 0 ? 256 : 768, VP = MODE == 0 ? 256 : 512;
    int tid = threadIdx.x; asm volatile("" : "+v"(tid));
    const int lane = tid & 63, r32 = lane & 31, hi = lane >> 5; const int wid = __builtin_amdgcn_readfirstlane(tid >> 6);
    const int q0 = qb < 0 ? 0 : 64 + 256 * qb;
    const int NT = qb < 0 ? 1 : 4 * qb + 5;
    const size_t rowbase = (size_t)b * LP;
    const bf16* Qw = Q + (rowbase + q0 + wid * 32) * QP + h * DQK;
    const bf16* Kh = Kg + rowbase * QP + h * DQK; const bf16* Vh = Vg + rowbase * VP + h * 64;
    const unsigned lds0 = (unsigned)(uintptr_t)shm;
    LAS float* wsf = (LAS float*)(shm + A_WS) + wid * 64;
    const bf16* ksrc0 = Kh + (size_t)lane * QP + wid * 8; const bf16* ksrc1 = ksrc0 + 64;
    const bf16* vsrc = Vh + (size_t)(16 * (wid & 3) + (lane >> 2)) * VP + (wid >> 2) * 32 + (lane & 3) * 8;
    const unsigned kdst = lds0 + A_K + wid * 1024, vdst = lds0 + A_V + wid * 1024;
#define DMA_TILE(t, slot) do { glds16(ksrc0 + (size_t)(t) * 64 * QP, (unsigned)__builtin_amdgcn_readfirstlane(kdst + (slot) * KSLOT)); \
        if (NCH > 8 && wid < NCH - 8) glds16(ksrc1 + (size_t)(t) * 64 * QP, (unsigned)__builtin_amdgcn_readfirstlane(kdst + (slot) * KSLOT + 8192)); \
        glds16(vsrc + (size_t)(t) * 64 * VP, (unsigned)__builtin_amdgcn_readfirstlane(vdst + (slot) * VSLOT)); } while (0)
    const lds_cptr shm3 = (lds_cptr)shm;
    const lds_cptr kp0 = shm3 + A_K + hi * 1024 + r32 * 16;
    const lds_cptr vp0 = shm3 + A_V + ((lane >> 4) & 1) * 32 + (lane & 3) * 8 + (4 * hi + ((lane & 15) >> 2)) * 64;
    bf16x8 qr[NKS];
#pragma unroll
    for (int d0 = 0; d0 < NKS; ++d0) qr[d0] = *(const bf16x8*)(Qw + (size_t)r32 * QP + d0 * 16 + hi * 8);
    DMA_TILE(NT - 1, 0);
    if (NT > 1) DMA_TILE(NT - 2, 1);
#pragma unroll
    for (int d0 = 0; d0 < NKS; ++d0) asm volatile("" : "+v"(qr[d0]));
    const bool npt3 = (MODE == 1) && (wid < NCH - 8);
    f32x16 o[2]; o[0] = f32x16{}; o[1] = f32x16{};
    float mrun = NEGBIG, lrun = MODE == 0 ? 1.0f : 0.f;
    const int qpos = q0 + wid * 32 + r32;
    bf16x8 kf[2 * NKS];
#define LOAD_KF(slot_) do { const lds_cptr kb_ = kp0 + (slot_) * KSLOT; _Pragma("unroll") for (int d0 = 0; d0 < NKS; ++d0) { kf[2 * d0] = *(const LAS bf16x8*)(kb_ + d0 * 2048); kf[2 * d0 + 1] = *(const LAS bf16x8*)(kb_ + d0 * 2048 + 512); } } while (0)
    const int NPT = npt3 ? 3 : 2; bool tprev = NT > 1;
    int cur = 0, nx1 = 1, nx2 = 2, cage = 0; bool cst = false;
    for (int i = 0; i < NT; ++i) {
        const int t = NT - 1 - i;
        const bool finstep = cpend >= 0 && cage == CV_AGE;
        { const int allow = (tprev ? NPT : 0) + ((cpend >= 0 && !finstep) ? (cst ? 12 : 8) : 0); ATT_WAIT_SW(allow); }
        tprev = i + 2 < NT;
        __builtin_amdgcn_sched_barrier(0);
        bool fin = false;
        if (cpend >= 0) { if (finstep) fin = true; else ++cage; }
        if (i + 2 < NT) DMA_TILE(t - 2, nx2);
        if (fin) { if (!cv.nofin) cv_finish(cv, cpend, lane, cvT); cpend = -1; }
        cst = fin && !cv.nofin;
        if (i + 2 < NT && cpend < 0 && cnext < CONV_PER_WAVE && (i > 0 || (wid & 1) == 0)) {     LDS_WAIT(); const int g_ = cv.base + 8 * cnext; cv_issue(cv, g_, lane); cpend = g_; ++cnext; cage = 0; }
        __builtin_amdgcn_sched_barrier(0);
        const int slot = cur, slot1 = nx1; cur = nx1; nx1 = nx2; nx2 = nx2 == NSLOT - 1 ? 0 : nx2 + 1;
        const bool band = (64 * t + 63 >= q0);
        const bool skip = band && (64 * t > q0 + wid * 32 + 31 - (MODE == 0 ? 1 : 0));
        if (skip) continue;
        LOAD_KF(slot);
        __builtin_amdgcn_sched_barrier(0);
        f32x16 p0 = f32x16{}, p1 = f32x16{};
#pragma unroll
        for (int d0 = 0; d0 < NKS; ++d0) { p0 = __builtin_amdgcn_mfma_f32_32x32x16_bf16(kf[2 * d0], qr[d0], p0, 0, 0, 0); p1 = __builtin_amdgcn_mfma_f32_32x32x16_bf16(kf[2 * d0 + 1], qr[d0], p1, 0, 0, 0); }
        const lds_cptr vp = vp0 + slot * VSLOT; s16x4 vlo[4], vhh[4];
#pragma unroll
        for (int ks = 0; ks < 4; ++ks) { vlo[ks] = vtr(vp + ks * 1024); vhh[ks] = vtr(vp + ks * 1024 + 512); }
        __builtin_amdgcn_sched_barrier(0);
        if (band || t == 0) {
            const int kb0 = 64 * t + 4 * hi;
#pragma unroll
            for (int r = 0; r < 16; ++r) { const int kv = kb0 + (r & 3) + 8 * (r >> 2);
                const bool m0 = (MODE == 0 ? kv >= qpos : kv > qpos) || kv < PADF, m1 = (MODE == 0 ? kv + 32 >= qpos : kv + 32 > qpos) || (kv + 32) < PADF;
                if (m0) p0[r] = NEGBIG; if (m1) p1[r] = NEGBIG; }
        }
        if (MODE == 1) {
            float rm = max3f(p0[0], p1[0], p0[1]), rm2 = max3f(p1[1], p0[2], p1[2]);
#pragma unroll
            for (int r = 3; r < 15; r += 2) { rm = max3f(rm, p0[r], p1[r]); rm2 = max3f(rm2, p0[r + 1], p1[r + 1]); }
            rm = max3f(rm, p0[15], p1[15]); rm = max3f(rm, rm2, rm2);
            { auto rr = __builtin_amdgcn_permlane32_swap(__float_as_uint(rm), __float_as_uint(rm), false, false); rm = fmaxf(__uint_as_float(rr[0]), __uint_as_float(rr[1])); }
            if (__any(rm > mrun + 8.0f)) {
                const float mn = fmaxf(mrun, rm), f = __builtin_amdgcn_exp2f(mrun - mn); mrun = mn; lrun *= f;
                if (hi == 0) wsf[r32] = f;
                LDS_WAIT();
#pragma unroll
                for (int r = 0; r < 16; ++r) { const float fr_ = wsf[crow(r, hi)]; o[0][r] *= fr_; o[1][r] *= fr_; }
            }
            float sacc = 0.f;
#pragma unroll
            for (int r = 0; r < 16; ++r) { p0[r] = __builtin_amdgcn_exp2f(p0[r] - mrun); p1[r] = __builtin_amdgcn_exp2f(p1[r] - mrun); sacc += p0[r] + p1[r]; }
            lrun += sacc;
        } else {
            f32x16 a0, a1;
#pragma unroll
            for (int r = 0; r < 16; ++r) { p0[r] = __builtin_amdgcn_exp2f(min2f(p0[r], 80.0f)); p1[r] = __builtin_amdgcn_exp2f(min2f(p1[r], 80.0f));
                a0[r] = __builtin_amdgcn_rcpf(1.0f + p0[r]); a1[r] = __builtin_amdgcn_rcpf(1.0f + p1[r]); }
            float seg[16];
#pragma unroll
            for (int k = 0; k < 4; ++k) {
                const float s0 = (a0[4 * k] * a0[4 * k + 1]) * (a0[4 * k + 2] * a0[4 * k + 3]), s1 = (a1[4 * k] * a1[4 * k + 1]) * (a1[4 * k + 2] * a1[4 * k + 3]);
                auto r0 = __builtin_amdgcn_permlane32_swap(__float_as_uint(s0), __float_as_uint(s0), false, false);
                auto r1 = __builtin_amdgcn_permlane32_swap(__float_as_uint(s1), __float_as_uint(s1), false, false);
                seg[2 * k] = __uint_as_float(r0[0]); seg[2 * k + 1] = __uint_as_float(r0[1]); seg[8 + 2 * k] = __uint_as_float(r1[0]); seg[8 + 2 * k + 1] = __uint_as_float(r1[1]);
            }
            float run = lrun; float sfx[16];
#pragma unroll
            for (int g = 15; g >= 0; --g) { sfx[g] = run; run *= seg[g]; }
            lrun = run;
#pragma unroll
            for (int k = 0; k < 4; ++k) {
                float c0 = hi ? sfx[2 * k + 1] : sfx[2 * k], c1 = hi ? sfx[8 + 2 * k + 1] : sfx[8 + 2 * k];
#pragma unroll
                for (int j = 3; j >= 0; --j) { c0 *= a0[4 * k + j]; p0[4 * k + j] *= c0; c1 *= a1[4 * k + j]; p1[4 * k + j] *= c1; }
            }
        }
        v4u pw[4];
        pw[0] = (v4u){cvtpk(p0[0], p0[1]), cvtpk(p0[2], p0[3]), cvtpk(p0[4], p0[5]), cvtpk(p0[6], p0[7])};
        pw[1] = (v4u){cvtpk(p0[8], p0[9]), cvtpk(p0[10], p0[11]), cvtpk(p0[12], p0[13]), cvtpk(p0[14], p0[15])};
        pw[2] = (v4u){cvtpk(p1[0], p1[1]), cvtpk(p1[2], p1[3]), cvtpk(p1[4], p1[5]), cvtpk(p1[6], p1[7])};
        pw[3] = (v4u){cvtpk(p1[8], p1[9]), cvtpk(p1[10], p1[11]), cvtpk(p1[12], p1[13]), cvtpk(p1[14], p1[15])};
        __builtin_amdgcn_sched_barrier(0);
        s16x4 wlo[4], whh[4];
#pragma unroll
        for (int ks = 0; ks < 4; ++ks) { wlo[ks] = vtr(vp + 4096 + ks * 1024); whh[ks] = vtr(vp + 4096 + ks * 1024 + 512); }
#pragma unroll
        for (int ks = 0; ks < 4; ++ks) { const bf16x8 vf = (bf16x8){vlo[ks][0], vlo[ks][1], vlo[ks][2], vlo[ks][3], vhh[ks][0], vhh[ks][1], vhh[ks][2], vhh[ks][3]};
            o[0] = __builtin_amdgcn_mfma_f32_32x32x16_bf16(__builtin_bit_cast(bf16x8, pw[ks]), vf, o[0], 0, 0, 0); }
        __builtin_amdgcn_sched_barrier(0);
#pragma unroll
        for (int ks = 0; ks < 4; ++ks) { const bf16x8 vf = (bf16x8){wlo[ks][0], wlo[ks][1], wlo[ks][2], wlo[ks][3], whh[ks][0], whh[ks][1], whh[ks][2], whh[ks][3]};
            o[1] = __builtin_amdgcn_mfma_f32_32x32x16_bf16(__builtin_bit_cast(bf16x8, pw[ks]), vf, o[1], 0, 0, 0); }
    }
#undef LOAD_KF
    if (MODE == 1) {
        { auto rr = __builtin_amdgcn_permlane32_swap(__float_as_uint(lrun), __float_as_uint(lrun), false, false); lrun = __uint_as_float(rr[0]) + __uint_as_float(rr[1]); }
        if (hi == 0) wsf[32 + r32] = lrun;
        LDS_WAIT();
    }
    bf16* Ow = OATT + (size_t)(MODE == 0 ? 0 : 256) + h * 64 + r32;
#pragma unroll
    for (int r = 0; r < 16; ++r) {
        const int pp = q0 + wid * 32 + crow(r, hi);
        const float sc = MODE == 1 ? __builtin_amdgcn_rcpf(wsf[32 + crow(r, hi)]) : 1.0f;
        const bool valid = qb < 0 ? (pp >= PADF && pp < 64) : true;
        if (valid) { bf16* dst = Ow + ((size_t)b * L + (pp - PADF)) * 768; dst[0] = (bf16)f2bf(o[0][r] * sc); dst[32] = (bf16)f2bf(o[1][r] * sc); }
    }
    asm volatile("s_waitcnt lgkmcnt(0)\n\ts_barrier" ::: "memory");
#undef DMA_TILE
}

constexpr int A_CONV = 63616;
static_assert(A_BYTES <= A_CONV && A_CONV + NWAVES * CV_SLOT <= 131072, "attention scratch vs conversion slots");
__device__ __forceinline__ void attn_phase(Frame& F, KArgs A, int l, int qi  , char* shm) {
    unsigned char* ws = F.ws;
    LAS int* qw = (LAS int*)((LAS char*)F.lds + A_Q);
    bf16* OATT = (bf16*)(ws + WS_OATT);
    int lane = F.tid & 63; asm volatile("" : "+v"(lane));
    const LAS float* cvT = (const LAS float*)(F.lds + RING_OFF + A_CONV + F.wave * CV_SLOT);
    ConvCtx cv; cv.wgu = A->in[I_WGU] + (size_t)l * NE * D * 2 * FF; cv.wdn = A->in[I_WD] + (size_t)l * NE * FF * D;
    cv.tgu = (bf16*)(ws + WS_WGU) + (size_t)l * NE * 2 * FF * D; cv.tdn = (bf16*)(ws + WS_WD) + (size_t)l * NE * D * FF;
    cv.base = F.vcu * CONV_PER_WG + F.wave; cv.rot = (F.vcu & 7) * 8;
#ifndef MK_RIDER_VAR
#define MK_RIDER_VAR 0
#endif
    cv.nofin = ((qi & 3) && MK_RIDER_VAR == 2) ? 1 : 0;
    int cnext = ((qi & 3) && MK_RIDER_VAR == 0) ? CONV_PER_WAVE : 0, cpend = -1;
    cv.slot = (unsigned)__builtin_amdgcn_readfirstlane((int)(unsigned)(size_t)(F.lds + RING_OFF + A_CONV + F.wave * CV_SLOT));
    for (;;) {
        if (F.tid == 0) *qw = (int)__hip_atomic_fetch_add(F.ctl + CW_AQ + qi * 64, 1u, RLX_AGENT);
        __syncthreads();
        const int u = __builtin_amdgcn_readfirstlane(*qw);
        if (u >= 9 * 96) break;
        const int level = u / 96, w = u - level * 96, qb = 7 - level;
        if (w < 64) attn_unit<1>(w >> 3, w & 7, qb, (const bf16*)(ws + WS_QM), (const bf16*)(ws + WS_KM), (const bf16*)(ws + WS_VM), OATT, shm, cv, cvT, cnext, cpend);
        else attn_unit<0>((w - 64) >> 2, (w - 64) & 3, qb, (const bf16*)(ws + WS_SBQ), (const bf16*)(ws + WS_SBK), (const bf16*)(ws + WS_SBV), OATT, shm, cv, cvT, cnext, cpend);
    }
    while (cpend >= 0 || cnext < CONV_PER_WAVE) {
        if (cpend >= 0) { asm volatile("s_waitcnt vmcnt(0)" ::: "memory"); if (!cv.nofin) cv_finish(cv, cpend, lane, cvT); cpend = -1; }
        if (cnext < CONV_PER_WAVE) { LDS_WAIT(); const int g_ = cv.base + 8 * cnext; cv_issue(cv, g_, lane); cpend = g_; ++cnext; }
    }
    __syncthreads();
}
}
namespace mk {
constexpr int PH_PER_LAYER = 9, N_PHASES = 1 + DEPTH * PH_PER_LAYER;

__global__ void __launch_bounds__(NWAVES * 64, 2) mega_fwd(Args args) {
    extern __shared__ __attribute__((aligned(16))) unsigned char lds[];
    Frame F;
    F.lds = (LAS unsigned char*)lds;
    F.MISC = (volatile LAS unsigned*)(F.lds + MISC_OFF);
    F.tid = threadIdx.x; F.lane = F.tid & 63; F.wave = __builtin_amdgcn_readfirstlane(F.tid >> 6);
    F.G = gridDim.x; { const int bx = blockIdx.x; F.vcu = (F.G % 8 == 0) ? (bx % 8) * (F.G / 8) + bx / 8 : bx; }
    F.ws = args.ws; F.ctl = (gu32*)(args.ws + WS_CTL); F.out = args.out;
    unsigned char* ws = args.ws;
    for (int u = F.tid; u < (TAIL_OFF - LDSCTL_OFF) / 4; u += NWAVES * 64) ((LAS unsigned*)(F.lds + LDSCTL_OFF))[u] = 0u;
    __syncthreads();
    const int lo = args.ph_lo, hi = args.ph_hi;
    const bool use_bar = (hi - lo) > 1;
    XcdBarrier bar; bar.bar = (unsigned*)(F.ctl + CW_BAR); bar.x = 0; bar.st = nullptr;
    if (use_bar) bar = xcd_barrier_post((unsigned*)(F.ctl + CW_BAR), F.MISC + 8);
#ifndef MK_PT_MASK
#define MK_PT_MASK 0x3ff
#endif
#define IN(k) (lo <= (k) && (k) < hi)
#define PT(b) ((MK_PT_MASK >> (b)) & 1)
#ifndef MK_REP
#define MK_REP 0
#endif
#define REPS(b) (1 + ((MK_REP >> (b)) & 1))
#define SEAM(k) do { if (IN(k) && IN((k) + 1)) xcd_barrier(bar); } while (0)

    if (PT(0) && IN(0)) { _Pragma("unroll") for (int rep = 0; rep < REPS(0); ++rep) p0_prologue(F, kargs()); SEAM(0); }
#pragma unroll 1
    for (int l = 0; l < DEPTH; ++l) {
        const int pb = 1 + l * PH_PER_LAYER;
        const f32x2* ROPE = (const f32x2*)(ws + WS_ROPE);
        if (PT(1) && IN(pb + 0)) _Pragma("unroll") for (int rep = 0; rep < REPS(1); ++rep) {
            pg8::Gemm g{(const bf16*)(ws + WS_HB), (const bf16*)(ws + WS_WIN) + (size_t)l * NINP * D, TP, NINP, D};
            pg8::StaticOrder S; S.init(TP, NINP, F.G, (int)blockIdx.x);
            EpiInProj E{(bf16*)(ws + WS_SBQ), (bf16*)(ws + WS_SBK), (bf16*)(ws + WS_SBV), (bf16*)(ws + WS_CQ), (bf16*)(ws + WS_CKV2), (bf16*)(ws + WS_KM), (float*)(ws + WS_U), (float*)(ws + WS_STQ), (float*)(ws + WS_STKV), ROPE};
            { const pg8::ListOrder LO = pg8::make_list(S, (LAS int*)(F.lds + TAIL_OFF + 14336), nullptr); pg8::gemm_phase<EpiInProj, pg8::ListOrder, true, false>(F.lds + RING_OFF, g, LO, E); }
            SEAM(pb + 0);
        }
        if (PT(2) && IN(pb + 1)) _Pragma("unroll") for (int rep = 0; rep < REPS(2); ++rep) {
            { pg8::Gemm g{(const bf16*)(ws + WS_CQ), (const bf16*)(ws + WS_WUQ) + (size_t)l * 768 * 256, TP, 768, 256, 0, (const bf16*)(ws + WS_CKV2), (const bf16*)(ws + WS_WUKV2) + (size_t)l * 1024 * 256};
              MlaOrder S; S.sq.init(TP, 768, 1, 0); S.sk.init(TP, 1024, 1, 0); S.G = F.G; S.c = (int)blockIdx.x;
              EpiMla E{EpiMlaQ{(bf16*)(ws + WS_QM), (const float*)(ws + WS_STQ), ROPE}, EpiMlaKV{(bf16*)(ws + WS_KM), (bf16*)(ws + WS_VM), (const float*)(ws + WS_STKV)}};
              const pg8::ListOrder LO = pg8::make_list(S, (LAS int*)(F.lds + TAIL_OFF + 14336), nullptr);
              pg8::gemm_phase<EpiMla, pg8::ListOrder, true, false>(F.lds + RING_OFF, g, LO, E); }
            SEAM(pb + 1);
        }
        if (PT(3) && IN(pb + 2)) _Pragma("unroll") for (int rep = 0; rep < REPS(3); ++rep) { att::attn_phase(F, kargs(), l, l * 4 + rep, (char*)lds + RING_OFF); SEAM(pb + 2); }
        if (PT(4) && IN(pb + 3)) _Pragma("unroll") for (int rep = 0; rep < REPS(4); ++rep) { phase_norm_conv(F, kargs(), l); SEAM(pb + 3); }
        if (PT(5) && IN(pb + 4)) _Pragma("unroll") for (int rep = 0; rep < REPS(5); ++rep) {
            pg8::Gemm g{(const bf16*)(ws + WS_Y), (const bf16*)(ws + WS_WOUT) + (size_t)l * D * D, TP, D, D};
            pg8::StaticOrder S; S.init(64 * 256, D, F.G, (int)blockIdx.x);
            EpiOut E{(const bf16*)(ws + WS_HB), (float*)(ws + WS_Z)};
            { const pg8::ListOrder LO = pg8::make_list(S, (LAS int*)(F.lds + TAIL_OFF + 14336), nullptr); pg8::gemm_phase<EpiOut, pg8::ListOrder, true, false>(F.lds + RING_OFF, g, LO, E); }
            { pg8::Gemm gt{(const bf16*)(ws + WS_Y), (const bf16*)(ws + WS_WOUT) + (size_t)l * D * D, TP, D, 256, D};
              TailOrder ST{F.vcu}; EpiOutTail ET{(float*)(ws + WS_ZP)};
              pg8::gemm_phase<EpiOutTail, TailOrder, true, false>(F.lds + RING_OFF, gt, ST, ET);
              if ((F.vcu & 15) == 0) {
                  asm volatile("s_waitcnt vmcnt(0)" ::: "memory"); __syncthreads();
                  if (F.tid == 0) {
                      __builtin_amdgcn_fence(__ATOMIC_RELEASE, "agent"); asm volatile("s_waitcnt vmcnt(0)" ::: "memory");
                      unsigned* cw = (unsigned*)(F.ctl + CW_TAIL + l * 64); (void)xb_add(cw, 1u);
                      unsigned sp = 0; while (xb_ld(cw) < 16u * (unsigned)(rep + 1) && ++sp < (1u << 22)) __builtin_amdgcn_s_sleep(1);
                      __builtin_amdgcn_fence(__ATOMIC_ACQUIRE, "agent"); asm volatile("s_waitcnt vmcnt(0)" ::: "memory");
                  }
                  __syncthreads();
                  int tid_ = F.tid; asm volatile("" : "+v"(tid_));
                  const int row = (F.vcu >> 4) * 8 + (tid_ >> 6), c4 = (tid_ & 63) * 4; const float* ZP = (const float*)(ws + WS_ZP);
                  const bf16* hb = (const bf16*)(ws + WS_HB) + (size_t)(64 * 256 + row) * D; float* zr = (float*)(ws + WS_Z) + (size_t)(64 * 256 + row) * D;
#pragma unroll
                  for (int q = 0; q < 4; ++q) { const int c = c4 + 256 * q; const v2u hw = *(const v2u*)(hb + c); f32x4 a = (f32x4){bflo(hw.x), bfhi(hw.x), bflo(hw.y), bfhi(hw.y)} * ALPHA;
#pragma unroll
                      for (int k = 0; k < 4; ++k) a += *(const f32x4*)(ZP + ((size_t)k * 128 + row) * D + c);
                      *(f32x4*)(zr + c) = a; }
              } }
            SEAM(pb + 4);
        }
        if (PT(6) && IN(pb + 5)) { if (REPS(6) > 1) { phase_router(F, kargs(), l, true); SEAM(pb + 5); } phase_router(F, kargs(), l); SEAM(pb + 5); }
        if (PT(7) && IN(pb + 6)) _Pragma("unroll") for (int rep = 0; rep < REPS(7); ++rep) {
            LAS int* tb = (LAS int*)(F.lds + TAIL_OFF); LAS int* rows = tb + 64;
            moe_tile_prefix(F, l, tb);
            MoeOrder S{tb, F.G, F.vcu};
            { pg8::Unit u; const int* LIST = (const int*)(ws + WS_LIST); int tid_ = F.tid; asm volatile("" : "+v"(tid_));
              for (int i = 0; i < 13 && S.next(i, u) && u.kind == 0; ++i) {
                  const int e = u.pb / 8, mt = u.pm - tb[e], cnt = (int)__hip_atomic_load(F.ctl + CW_CNT + l * 64 + e, RLX_AGENT);
                  if (tid_ < 256) { const int idx = mt * 256 + tid_; rows[i * 256 + tid_] = idx < cnt ? LIST[(size_t)e * T + idx] : 0; }
              } }
            __syncthreads();
            pg8::Gemm g{(const bf16*)(ws + WS_HB), (const bf16*)(ws + WS_WGU) + (size_t)l * NE * 2 * FF * D, RP, 2 * FF, D, 0, (const bf16*)(ws + WS_ACT), (const bf16*)(ws + WS_WD) + (size_t)l * NE * D * FF};
            unsigned* rdy = (unsigned*)(F.ctl + CW_RDY + (l * 2 + rep) * 320 * 16);
            EpiMoe12 E{EpiMoe1{(bf16*)(ws + WS_ACT), (const float*)(ws + WS_BGU) + (size_t)l * NE * 2 * FF, rdy}, EpiMoe2{(bf16*)(ws + WS_YS), kargs()->in[I_BD] + (size_t)l * NE * D}};
            { pg8::ListOrder LO = pg8::make_list(S, (LAS int*)(F.lds + TAIL_OFF + 14336), rows); LO.rdy = rdy; LO.need = 64u;
              pg8::gemm_phase<EpiMoe12, pg8::ListOrder, true, true>(F.lds + RING_OFF, g, LO, E);
              { int t2 = F.tid; asm volatile("" : "+v"(t2)); E.e1.flush(t2 & 15, (t2 & 63) >> 4, true); } }
            SEAM(pb + 6);
        }
        if (PT(9) && IN(pb + 8)) { if (REPS(9) > 1) { phase_combine(F, kargs(), l, true); xcd_barrier(bar); } phase_combine(F, kargs(), l); SEAM(pb + 8); }
    }
#undef IN
#undef SEAM
}
}
#ifndef MK_DEBUG
#define MK_DEBUG 0
#endif
#if MK_DEBUG
namespace dbg {
using namespace mk;
struct CkSpec {
    const void* M; const float* N; const float* mgain; long ldm, ldn;
    int mtype  , mrowmap  , mcol0, mhstride, ncol0, nhstride, hc, nh; float scale; int pad;
};
__device__ __forceinline__ void blk_acc(float d2, float r2, double* acc) {
    __shared__ float sd[4], sr[4];
#pragma unroll
    for (int o = 32; o > 0; o >>= 1) { d2 += __shfl_xor(d2, o); r2 += __shfl_xor(r2, o); }
    if ((threadIdx.x & 63) == 0) { sd[threadIdx.x >> 6] = d2; sr[threadIdx.x >> 6] = r2; }
    __syncthreads();
    if (threadIdx.x == 0) { atomicAdd(acc, (double)(sd[0] + sd[1] + sd[2] + sd[3])); atomicAdd(acc + 1, (double)(sr[0] + sr[1] + sr[2] + sr[3])); }
}
__global__ void __launch_bounds__(256) check_k(CkSpec s, double* acc) {
    const long n = (long)T * s.nh * s.hc; float d2 = 0.f, r2 = 0.f;
    for (long i = (long)blockIdx.x * 256 + threadIdx.x; i < n; i += (long)gridDim.x * 256) {
        const long r = i / (s.nh * s.hc); const int cc = (int)(i % (s.nh * s.hc)), h = cc / s.hc, j = cc % s.hc;
        const int mcol = s.mcol0 + h * s.mhstride + j, ncol = s.ncol0 + h * s.nhstride + j;
        long mr = r; if (s.mrowmap) { const long bb = r / L; mr = bb * LP + (r - bb * L) + PADF; }
        float a = s.mtype ? ((const float*)s.M)[mr * s.ldm + mcol] : bf2f(((const bf16*)s.M)[mr * s.ldm + mcol]);
        if (s.mgain) a *= s.mgain[mcol];
        const float b = s.N[r * s.ldn + ncol] * s.scale;
        float d = a - b; if (!(d == d)) d = 1e18f; d2 += d * d; r2 += b * b;
    }
    blk_acc(d2, r2, acc);
}
__global__ void __launch_bounds__(256) check_u_k(const float* U, const float* P, double* acc) {
    const long n = (long)T * 256; float d2 = 0.f, r2 = 0.f;
    for (long i = (long)blockIdx.x * 256 + threadIdx.x; i < n; i += (long)gridDim.x * 256) {
        const long r = i >> 8; const int c = (int)(i & 255);
        const float a = U[i], g = P[r * NIN + 1440 + c], b = P[r * NIN + 1184 + c] / (1.f + expf(-g));
        float d = a - b; if (!(d == d)) d = 1e18f; d2 += d * d; r2 += b * b;
    }
    blk_acc(d2, r2, acc);
}
__global__ void __launch_bounds__(256) check_route_k(const int* TOKE, const float* TOKG, const int* te, const float* tg, double* acc, double* acc2) {
    float mm = 0.f, d2 = 0.f, r2 = 0.f;
    for (int t = blockIdx.x * 256 + threadIdx.x; t < T; t += gridDim.x * 256) {
        bool same = true;
        for (int k = 0; k < 4; ++k) same = same && (TOKE[t * 4 + k] == te[t * 4 + k]);
        if (!same) mm += 1.f; else for (int k = 0; k < 4; ++k) { const float d = TOKG[t * 4 + k] - tg[t * 4 + k]; d2 += d * d; r2 += tg[t * 4 + k] * tg[t * 4 + k]; }
    }
    blk_acc(mm, threadIdx.x == 0 && blockIdx.x == 0 ? (float)T : 0.f, acc);
    __syncthreads();
    blk_acc(d2, r2, acc2);
}
__global__ void tb_k(const unsigned* cnt, int* tb) { if (threadIdx.x == 0) { int s = 0; for (int e = 0; e < NE; ++e) { tb[e] = s; s += ((int)cnt[e] + 255) >> 8; } tb[NE] = s; } }
__global__ void __launch_bounds__(256) check_rows_k(const bf16* Mg, const int* tb, const int* TOKE, const int* TOKP, const float* Nv, const int* slot, const int* te, double* acc) {
    float d2 = 0.f, r2 = 0.f;
    for (long i = (long)blockIdx.x * 256 + threadIdx.x; i < (long)T * 4 * 1024; i += (long)gridDim.x * 256) {
        const int tk = (int)(i >> 10), c = (int)(i & 1023), t = tk >> 2;
        bool same = true;
        for (int k = 0; k < 4; ++k) same = same && (TOKE[t * 4 + k] == te[t * 4 + k]);
        if (!same) continue;
        const float a = bf2f(Mg[((size_t)tb[TOKE[tk]] * 256 + TOKP[tk]) * 1024 + c]), b = Nv[(size_t)slot[tk] * 1024 + c];
        float d = a - b; if (!(d == d)) d = 1e18f; d2 += d * d; r2 += b * b;
    }
    blk_acc(d2, r2, acc);
}
__global__ void __launch_bounds__(256) check_out_k(const float* out, const float* H, double* acc) {
    float d2 = 0.f, r2 = 0.f;
    for (long i = (long)blockIdx.x * 256 + threadIdx.x; i < (long)BATCH * SEQ * D; i += (long)gridDim.x * 256) {
        const long row = i >> 10; const int c = (int)(i & 1023); const long bb = row / SEQ, p = row - bb * SEQ;
        const float a = out[i], b = H[(bb * L + p + NMETA) * D + c]; float d = a - b; if (!(d == d)) d = 1e18f; d2 += d * d; r2 += b * b;
    }
    blk_acc(d2, r2, acc);
}
__global__ void __launch_bounds__(256) verdict_k(const double* acc, int nck, float tol, float* out, long nout) {
    int bad = -1; float cls = 0.f;
    for (int k = 0; k < nck; ++k) { const double d = acc[2 * k], r = acc[2 * k + 1]; if (r == 0.0 && d == 0.0) continue; const double q = r > 0.0 ? d / r : 1e30;
        const double tl = (k < 38 && (k - 2) % 18 == 14) ? 0.06 : (double)tol;
        if (!(q <= tl)) { bad = k; cls = q < 1e-3 ? 0.f : q < 1e-2 ? 1.f : q < 1e-1 ? 2.f : q < 1.0 ? 3.f : 4.f; break; } }
    if (bad < 0) return;
    const float c = sqrtf((10.f + (float)bad) * powf(10.f, cls));
    for (long i = (long)blockIdx.x * 256 + threadIdx.x; i < nout; i += (long)gridDim.x * 256) out[i] += c;
}
}
#endif

static void run_gemm(hipStream_t s, const float* A, int lda, const int* arow, const float* B, int ldb, long strideB, const float* bias, long strideBias, float* C, int ldc,
                     int M, int N, int K, const int* cnt, const int* base, int groups, int swiglu = 0) {
#if MK_DEBUG
    nv::GemmP p{A, arow, B, bias, C, cnt, base, strideB, strideBias, lda, ldb, ldc, M, N, K, swiglu, 0};
    dim3 grid((N + 63) / 64, (M + 63) / 64, groups);
    hipLaunchKernelGGL(nv::sgemm_k, grid, dim3(256), 0, s, p);
#endif
}

extern "C" void kernel_launch(void* const* d_in, const int* in_sizes, int n_in, void* d_out, int out_size, void* d_ws, size_t ws_size, hipStream_t stream) {
    using namespace mk;
    static int grid = 0;
    if (grid == 0) {
        int dev = 0, cus = 0;
        if (n_in != 25 || out_size != BATCH * SEQ * D || ws_size < (size_t)2040 * MiB) { fprintf(stderr, "kernel_launch: unexpected shapes (n_in %d out %d ws %zu)\n", n_in, out_size, ws_size); grid = -1; return; }
        if (hipGetDevice(&dev) != hipSuccess || hipDeviceGetAttribute(&cus, hipDeviceAttributeMultiprocessorCount, dev) != hipSuccess) { grid = -1; return; }
        if (hipFuncSetAttribute((const void*)mega_fwd, hipFuncAttributeMaxDynamicSharedMemorySize, LDS_BYTES) != hipSuccess) { fprintf(stderr, "kernel_launch: hipFuncSetAttribute failed\n"); grid = -1; return; }
        int per_cu = 0;
        if (hipOccupancyMaxActiveBlocksPerMultiprocessor(&per_cu, (const void*)mega_fwd, NWAVES * 64, LDS_BYTES) != hipSuccess || per_cu < 1) fprintf(stderr, "kernel_launch: occupancy query says %d\n", per_cu);
        (void)hipGetLastError();
        grid = cus;
    }
    if (grid < 0) return;
    (void)hipMemsetAsync((char*)d_ws + WS_CTL, 0, CTL_ZERO_BYTES, stream);
    Args a{};
    for (int i = 0; i < 25; ++i) a.in[i] = (const float*)d_in[i];
    a.out = (float*)d_out; a.ws = (unsigned char*)d_ws;
#if !MK_DEBUG
    a.ph_lo = 0; a.ph_hi = N_PHASES;
    hipLaunchKernelGGL(mega_fwd, dim3(grid), dim3(NWAVES * 64), LDS_BYTES, stream, a);
#else
    using namespace nv;
    auto mega = [&](int ph) { a.ph_lo = ph; a.ph_hi = ph + 1; hipLaunchKernelGGL(mega_fwd, dim3(grid), dim3(NWAVES * 64), LDS_BYTES, stream, a); };
    const float* x = (const float*)d_in[0]; const float* meta = (const float*)d_in[1];
    const float* ln_in_g = (const float*)d_in[2]; const float* ln_in_b = (const float*)d_in[3];
    const float* w_in = (const float*)d_in[4]; const float* q_norm_g = (const float*)d_in[5]; const float* w_uq = (const float*)d_in[6];
    const float* kv_norm_g = (const float*)d_in[7]; const float* w_ukv = (const float*)d_in[8]; const float* conv_w = (const float*)d_in[9];
    const float* conv_b = (const float*)d_in[10]; const float* conv_ln_g = (const float*)d_in[11]; const float* conv_ln_b = (const float*)d_in[12];
    const float* grp_norm_g = (const float*)d_in[13]; const float* w_out = (const float*)d_in[14]; const float* ln_mix_g = (const float*)d_in[15];
    const float* ln_mix_b = (const float*)d_in[16]; const float* router_w = (const float*)d_in[17]; const float* router_b = (const float*)d_in[18];
    const float* w_gate_up = (const float*)d_in[19]; const float* b_gate_up = (const float*)d_in[20]; const float* w_down = (const float*)d_in[21];
    const float* b_down = (const float*)d_in[22]; const float* ln_ffn_g = (const float*)d_in[23]; const float* ln_ffn_b = (const float*)d_in[24];
    float* out = (float*)d_out;
    unsigned char* mw = (unsigned char*)d_ws;
    char* w = (char*)d_ws; size_t off = (size_t)1088 * MiB;
    auto take = [&](size_t bytes) { char* p = w + off; off += (bytes + 255) & ~(size_t)255; return p; };
    double* acc = (double*)take(64 * 16); int* tbd = (int*)take(256);
    int* cnt = (int*)take(256); int* base = (int*)take(256);
    int* te = (int*)take((size_t)R * 4); int* tp = (int*)take((size_t)R * 4); float* tg = (float*)take((size_t)R * 4);
    int* list = (int*)take((size_t)R * 4); int* slot = (int*)take((size_t)R * 4);
    float* H = (float*)take((size_t)T * D * 4);
    float* MIX = (float*)take((size_t)T * D * 4);
    float* LOG = (float*)take((size_t)T * NE * 4);
    float* ACT = (float*)take((size_t)R * FF * 4);
    char* alias0 = w + off;
    float* P = (float*)take((size_t)T * NIN * 4);
    float* CQN = (float*)take((size_t)T * 256 * 4); float* CKVN = (float*)take((size_t)T * 128 * 4);
    float* QM = (float*)take((size_t)T * 768 * 4); float* KVM = (float*)take((size_t)T * 1024 * 4); float* KROT = (float*)take((size_t)T * 32 * 4);
    float* SBO = (float*)take((size_t)T * 256 * 4); float* MLAO = (float*)take((size_t)T * 512 * 4);
    float* Y = (float*)take((size_t)T * D * 4);
    float* YS = (float*)alias0;
    if ((size_t)(w + off - alias0) < (size_t)R * D * 4) { fprintf(stderr, "alias too small\n"); return; }
    if (off > ws_size) { fprintf(stderr, "workspace too small: need %zu have %zu\n", off, ws_size); return; }
    (void)hipMemsetAsync(acc, 0, 64 * 16, stream);
    const int CG = 1024;
    auto ck = [&](int id, const void* M, int mtype, int mrowmap, long ldm, int mcol0, int mhstride, const float* N, long ldn, int ncol0, int nhstride, int hc, int nh, float scale, const float* mgain) {
        dbg::CkSpec s{M, N, mgain, ldm, ldn, mtype, mrowmap, mcol0, mhstride, ncol0, nhstride, hc, nh, scale, 0};
        hipLaunchKernelGGL(dbg::check_k, dim3(CG), dim3(256), 0, stream, s, acc + 2 * id);
    };
    mega(0);
    hipLaunchKernelGGL(ln_in_k, dim3(T), dim3(256), 0, stream, x, meta, ln_in_g, ln_in_b, H);
    ck(1, mw + WS_HB, 0, 0, D, 0, 0, H, D, 0, 0, D, 1, 1.f, nullptr);
    for (int l = 0; l < DEPTH; ++l) {
        const int pb = 1 + l * PH_PER_LAYER, cb = 2 + 18 * l;
        mega(pb + 0);
        run_gemm(stream, H, D, nullptr, w_in + (size_t)l * D * NIN, NIN, 0, nullptr, 0, P, NIN, T, NIN, D, nullptr, nullptr, 1);
        ck(cb + 0, mw + WS_SBQ, 0, 1, 256, 0, 0, P, NIN, 0, 0, 256, 1, SBQ_SCALE, nullptr);
        ck(cb + 1, mw + WS_SBK, 0, 1, 256, 0, 0, P, NIN, 256, 0, 256, 1, 1.f, nullptr);
        ck(cb + 2, mw + WS_SBV, 0, 1, 256, 0, 0, P, NIN, 512, 0, 256, 1, 1.f, nullptr);
        ck(cb + 3, mw + WS_CQ, 0, 0, 256, 0, 0, P, NIN, 768, 0, 256, 1, 1.f, nullptr);
        ck(cb + 4, mw + WS_CKV2, 0, 0, 256, 0, 0, P, NIN, 1024, 0, 128, 1, 1.f, nullptr);
        hipLaunchKernelGGL(dbg::check_u_k, dim3(CG), dim3(256), 0, stream, (const float*)(mw + WS_U), P, acc + 2 * (cb + 5));
        mega(pb + 1);
        hipLaunchKernelGGL(rms_cols_k, dim3(T), dim3(256), 0, stream, P, NIN, 768, 256, q_norm_g + l * 256, CQN);
        hipLaunchKernelGGL(rms_cols_k, dim3(T), dim3(256), 0, stream, P, NIN, 1024, 128, kv_norm_g + l * 128, CKVN);
        run_gemm(stream, CQN, 256, nullptr, w_uq + (size_t)l * 256 * 768, 768, 0, nullptr, 0, QM, 768, T, 768, 256, nullptr, nullptr, 1);
        run_gemm(stream, CKVN, 128, nullptr, w_ukv + (size_t)l * 128 * 1024, 1024, 0, nullptr, 0, KVM, 1024, T, 1024, 128, nullptr, nullptr, 1);
        hipLaunchKernelGGL(rotary_k, dim3(T), dim3(256), 0, stream, QM, P, KROT);
        ck(cb + 6, mw + WS_QM, 0, 1, 768, 0, 0, QM, 768, 0, 0, 768, 1, MLAQ_SCALE, nullptr);
        ck(cb + 7, mw + WS_KM, 0, 1, 768, 0, 96, KVM, 1024, 0, 128, 64, 8, 1.f, nullptr);
        ck(cb + 8, mw + WS_KM, 0, 1, 768, 64, 96, KROT, 32, 0, 0, 32, 8, 1.f, nullptr);
        ck(cb + 9, mw + WS_VM, 0, 1, 512, 0, 64, KVM, 1024, 64, 128, 64, 8, 1.f, nullptr);
        mega(pb + 2);
        hipLaunchKernelGGL(attn_k<0>, dim3((L + 3) / 4, 4, BATCH), dim3(256), 0, stream, P, QM, KVM, KROT, SBO);
        hipLaunchKernelGGL(attn_k<1>, dim3((L + 3) / 4, 8, BATCH), dim3(256), 0, stream, P, QM, KVM, KROT, MLAO);
        ck(cb + 10, mw + WS_OATT, 0, 0, 768, 0, 0, SBO, 256, 0, 0, 256, 1, 1.f, nullptr);
        ck(cb + 11, mw + WS_OATT, 0, 0, 768, 256, 0, MLAO, 512, 0, 0, 512, 1, 1.f, nullptr);
        mega(pb + 3);
        hipLaunchKernelGGL(mix_norm_k, dim3(T), dim3(256), 0, stream, P, SBO, MLAO, conv_w + (size_t)l * CONVK * 256, conv_b + l * 256, conv_ln_g + l * 256, conv_ln_b + l * 256,
                           grp_norm_g + l * D, Y);
        ck(cb + 12, mw + WS_Y, 0, 0, D, 0, 0, Y, D, 0, 0, D, 1, 1.f, grp_norm_g + l * D);
        mega(pb + 4);
        mega(pb + 5);
        run_gemm(stream, Y, D, nullptr, w_out + (size_t)l * D * D, D, 0, nullptr, 0, MIX, D, T, D, D, nullptr, nullptr, 1);
        hipLaunchKernelGGL(res_ln_k, dim3(T), dim3(256), 0, stream, H, MIX, ln_mix_g + l * D, ln_mix_b + l * D, (float*)nullptr);
        ck(cb + 13, mw + WS_HB, 0, 0, D, 0, 0, H, D, 0, 0, D, 1, 1.f, nullptr);
        run_gemm(stream, H, D, nullptr, router_w + (size_t)l * D * NE, NE, 0, router_b + l * NE, 0, LOG, NE, T, NE, D, nullptr, nullptr, 1);
        (void)hipMemsetAsync(cnt, 0, 256, stream);
        hipLaunchKernelGGL(route_k, dim3((T + 255) / 256), dim3(256), 0, stream, LOG, cnt, te, tp, tg);
        hipLaunchKernelGGL(prefix_k, dim3(1), dim3(64), 0, stream, cnt, base);
        hipLaunchKernelGGL(scatter_k, dim3((R + 255) / 256), dim3(256), 0, stream, te, tp, base, list, slot);
        hipLaunchKernelGGL(dbg::check_route_k, dim3(64), dim3(256), 0, stream, (const int*)(mw + WS_TOKE), (const float*)(mw + WS_TOKG), te, tg, acc + 2 * (cb + 14), acc + 2 * (38 + l));
        hipLaunchKernelGGL(dbg::tb_k, dim3(1), dim3(64), 0, stream, (const unsigned*)(mw + WS_CTL) + CW_CNT + l * 64, tbd);
        mega(pb + 6);
        run_gemm(stream, H, D, list, w_gate_up + (size_t)l * NE * D * 2 * FF, 2 * FF, (long)D * 2 * FF, b_gate_up + (size_t)l * NE * 2 * FF, 2 * FF, ACT, FF, T, FF, D, cnt, base, NE, 1);
        hipLaunchKernelGGL(dbg::check_rows_k, dim3(CG), dim3(256), 0, stream, (const bf16*)(mw + WS_ACT), tbd, (const int*)(mw + WS_TOKE), (const int*)(mw + WS_TOKP), ACT, slot, te, acc + 2 * (cb + 15));
        mega(pb + 7);
        run_gemm(stream, ACT, FF, nullptr, w_down + (size_t)l * NE * FF * D, D, (long)FF * D, b_down + (size_t)l * NE * D, D, YS, D, T, D, FF, cnt, base, NE);
        hipLaunchKernelGGL(dbg::check_rows_k, dim3(CG), dim3(256), 0, stream, (const bf16*)(mw + WS_YS), tbd, (const int*)(mw + WS_TOKE), (const int*)(mw + WS_TOKP), YS, slot, te, acc + 2 * (cb + 16));
        mega(pb + 8);
        hipLaunchKernelGGL(combine_k, dim3(T), dim3(256), 0, stream, YS, slot, tg, MIX);
        hipLaunchKernelGGL(res_ln_k, dim3(T), dim3(256), 0, stream, H, MIX, ln_ffn_g + l * D, ln_ffn_b + l * D, (float*)nullptr);
        if (l < DEPTH - 1) ck(cb + 17, mw + WS_HB, 0, 0, D, 0, 0, H, D, 0, 0, D, 1, 1.f, nullptr);
        else hipLaunchKernelGGL(dbg::check_out_k, dim3(CG), dim3(256), 0, stream, (const float*)out, (const float*)H, acc + 2 * (cb + 17));
    }
    hipLaunchKernelGGL(dbg::verdict_k, dim3(1024), dim3(256), 0, stream, acc, 40, MK_TOL, out, (long)BATCH * SEQ * D);
#endif
}
```
